# Optimizing an MI355X kernel written in HIP

```python
import math, functools
import jax, jax.numpy as jnp
from jax import lax
import numpy as np

D_MODEL = 1024
BATCH = 2
SEQ = 8192
DEPTH = 1
DEC_BATCH = 128
DEC_SEQ = 4
PAST_LEN = 8192
PAGE_SIZE = 128

D_MIX = D_MODEL
D_ATT = D_MIX // 2
D_MLSTM = D_MIX - D_ATT
ATT_HEAD_DIM = 64
N_Q_HEADS = D_ATT // ATT_HEAD_DIM
N_KV_HEADS = max(1, N_Q_HEADS // 4)
Q_PER_KV = N_Q_HEADS // N_KV_HEADS
KV_DIM = N_KV_HEADS * ATT_HEAD_DIM
WINDOW = 128
ROPE_DIM = ATT_HEAD_DIM // 4
ROPE_THETA = 500000.0
M_HEADS = 4
M_HEAD_DIM = D_MLSTM // M_HEADS
CONV_W = 4
CHUNK = 64
EPS = 1e-6
PAD_LOG_I = -1e30
D_IN = 2 * D_ATT + 2 * KV_DIM + 5 * D_MLSTM + 2 * M_HEADS

kernel_name = 'hymba_swa_sink_mlstm_step'


def _rmsnorm(x, w):
    xf = x.astype(jnp.float32)
    y = xf * lax.rsqrt(jnp.mean(xf * xf, axis=-1, keepdims=True) + EPS)
    return (y * w.astype(jnp.float32)).astype(x.dtype)


def _rope(x, pos):
    half = ROPE_DIM // 2
    inv_freq = jnp.power(jnp.float32(ROPE_THETA), -jnp.arange(half, dtype=jnp.float32) * (2.0 / ROPE_DIM))
    ang = pos.astype(jnp.float32)[:, None] * inv_freq[None, :]
    cos = jnp.cos(ang)[:, None, :]
    sin = jnp.sin(ang)[:, None, :]
    xf = x.astype(jnp.float32)
    x1 = xf[..., :half]
    x2 = xf[..., half:ROPE_DIM]
    out = jnp.concatenate([x1 * cos - x2 * sin, x2 * cos + x1 * sin, xf[..., ROPE_DIM:]], axis=-1)
    return out.astype(x.dtype)


def _window_mask(qpos, kpos):
    d = qpos[:, :, None] - kpos[:, None, :]
    return (d >= 0) & (d < WINDOW) & (kpos[:, None, :] >= 0)


def _sink_attention(q, k, v, mask, sinks):
    scale = ATT_HEAD_DIM ** -0.5
    s = jnp.einsum('bnqkgd,bnskd->bnkgqs', q, k).astype(jnp.float32) * scale
    s = jnp.where(mask[None, :, None, None], s, -jnp.inf)
    sink = sinks.astype(jnp.float32).reshape(1, 1, N_KV_HEADS, Q_PER_KV, 1, 1)
    m = jnp.maximum(jnp.max(s, axis=-1, keepdims=True), sink)
    p = jnp.exp(s - m)
    p = p / (jnp.sum(p, axis=-1, keepdims=True) + jnp.exp(sink - m))
    return jnp.einsum('bnkgqs,bnskd->bnqkgd', p.astype(v.dtype), v)


def _attn_prompt(q, k, v, sinks):
    B, L, H, hd = q.shape
    nb = L // WINDOW
    qb = q.reshape(B, nb, WINDOW, N_KV_HEADS, Q_PER_KV, hd)
    kb = k.reshape(B, nb, WINDOW, N_KV_HEADS, hd)
    vb = v.reshape(B, nb, WINDOW, N_KV_HEADS, hd)
    kk = jnp.concatenate([jnp.concatenate([jnp.zeros_like(kb[:, :1]), kb[:, :-1]], axis=1), kb], axis=2)
    vv = jnp.concatenate([jnp.concatenate([jnp.zeros_like(vb[:, :1]), vb[:, :-1]], axis=1), vb], axis=2)
    blk = jnp.arange(nb, dtype=jnp.int32)[:, None]
    qpos = blk * WINDOW + jnp.arange(WINDOW, dtype=jnp.int32)[None, :]
    kpos = (blk - 1) * WINDOW + jnp.arange(2 * WINDOW, dtype=jnp.int32)[None, :]
    o = _sink_attention(qb, kk, vv, _window_mask(qpos, kpos), sinks)
    return o.reshape(B, L, H, hd), k[:, -WINDOW:], v[:, -WINDOW:]


def _attn_sample(q, k, v, sinks, k_buf, v_buf):
    Bd, T, H, hd = q.shape
    Wb = k_buf.shape[1]
    kk = jnp.concatenate([k_buf.astype(k.dtype), k], axis=1)
    vv = jnp.concatenate([v_buf.astype(v.dtype), v], axis=1)
    qb = q.reshape(Bd, 1, T, N_KV_HEADS, Q_PER_KV, hd)
    qpos = (PAST_LEN + jnp.arange(T, dtype=jnp.int32))[None, :]
    kpos = jnp.concatenate([PAST_LEN - Wb + jnp.arange(Wb, dtype=jnp.int32),
                            PAST_LEN + jnp.arange(T, dtype=jnp.int32)])[None, :]
    o = _sink_attention(qb, kk[:, None], vv[:, None], _window_mask(qpos, kpos), sinks)
    return o.reshape(Bd, T, H, hd), kk[:, -Wb:], vv[:, -Wb:]


def _causal_conv(x, prev, w, b):
    L = x.shape[1]
    xp = jnp.concatenate([prev.astype(x.dtype), x], axis=1)
    y = b[None, None, :]
    for j in range(CONV_W):
        y = y + xp[:, j:j + L] * w[j]
    return y, xp[:, -(CONV_W - 1):]


def _mlstm_chunkwise(q, k, v, log_i, log_f, S0, n0, m0):
    B, L, H, dk = q.shape
    dv = v.shape[-1]
    c = min(CHUNK, L)
    Lp = -(-L // c) * c
    pad = Lp - L
    if pad:
        q = jnp.pad(q, ((0, 0), (0, pad), (0, 0), (0, 0)))
        k = jnp.pad(k, ((0, 0), (0, pad), (0, 0), (0, 0)))
        v = jnp.pad(v, ((0, 0), (0, pad), (0, 0), (0, 0)))
        log_i = jnp.pad(log_i, ((0, 0), (0, pad), (0, 0)), constant_values=PAD_LOG_I)
        log_f = jnp.pad(log_f, ((0, 0), (0, pad), (0, 0)), constant_values=0.0)
    nc = Lp // c
    to_c = lambda a: a.reshape(B, nc, c, H, a.shape[-1]).transpose(1, 0, 3, 2, 4)
    to_g = lambda a: a.reshape(B, nc, c, H).transpose(1, 0, 3, 2)
    causal = jnp.tril(jnp.ones((c, c), dtype=bool))

    def step(carry, inp):
        S, n, m = carry
        qc, kc, vc, li, lf = inp
        b = jnp.cumsum(lf, axis=-1)
        D = jnp.where(causal, b[..., :, None] - b[..., None, :] + li[..., None, :], -jnp.inf)
        inter = b + m[..., None]
        m_t = jnp.maximum(inter, jnp.max(D, axis=-1))
        w_intra = jnp.exp(D - m_t[..., None])
        w_inter = jnp.exp(inter - m_t)
        qk = jnp.einsum('bhtd,bhsd->bhts', qc, kc) * w_intra
        num = w_inter[..., None] * jnp.einsum('bhtd,bhde->bhte', qc, S) + jnp.einsum('bhts,bhse->bhte', qk, vc)
        den = w_inter * jnp.einsum('bhtd,bhd->bht', qc, n) + jnp.sum(qk, axis=-1)
        h = num / jnp.maximum(jnp.abs(den), jnp.exp(-m_t))[..., None]
        bL = b[..., -1]
        g = bL[..., None] - b + li
        m_new = jnp.maximum(bL + m, jnp.max(g, axis=-1))
        wk = jnp.exp(g - m_new[..., None])
        decay = jnp.exp(bL + m - m_new)
        S_new = decay[..., None, None] * S + jnp.einsum('bhs,bhsd,bhse->bhde', wk, kc, vc)
        n_new = decay[..., None] * n + jnp.einsum('bhs,bhsd->bhd', wk, kc)
        return (S_new, n_new, m_new), h

    (S1, n1, m1), hs = lax.scan(step, (S0, n0, m0), (to_c(q), to_c(k), to_c(v), to_g(log_i), to_g(log_f)))
    h = hs.transpose(1, 0, 3, 2, 4).reshape(B, Lp, H, dv)[:, :L]
    return h, S1, n1, m1


def _hybrid_layer(x, pos, attend, conv_prev, S0, n0, m0, norm_w, w_in, b_gates, conv_w, conv_b,
                  q_norm_w, k_norm_w, sinks, mh_norm_w, w_out):
    B, L, _ = x.shape
    h = _rmsnorm(x, norm_w)
    proj = jnp.einsum('bld,de->ble', h, w_in)
    sizes = (D_ATT, KV_DIM, KV_DIM, D_ATT, 2 * D_MLSTM, D_MLSTM, D_MLSTM, M_HEADS, M_HEADS, D_MLSTM)
    cuts = [int(s) for s in np.cumsum(sizes)[:-1]]
    aq, ak, av, ag, mqk, mv, mo, mi, mf, mz = jnp.split(proj, cuts, axis=-1)
    q = _rope(_rmsnorm(aq.reshape(B, L, N_Q_HEADS, ATT_HEAD_DIM), q_norm_w), pos)
    k = _rope(_rmsnorm(ak.reshape(B, L, N_KV_HEADS, ATT_HEAD_DIM), k_norm_w), pos)
    v = av.reshape(B, L, N_KV_HEADS, ATT_HEAD_DIM)
    att, new_k, new_v = attend(q, k, v, sinks)
    att = att.reshape(B, L, D_ATT) * jax.nn.silu(ag)
    qk, new_conv = _causal_conv(mqk, conv_prev, conv_w, conv_b)
    qk = jax.nn.silu(qk).astype(jnp.float32)
    mq = qk[..., :D_MLSTM].reshape(B, L, M_HEADS, M_HEAD_DIM)
    mk = qk[..., D_MLSTM:].reshape(B, L, M_HEADS, M_HEAD_DIM) * (M_HEAD_DIM ** -0.5)
    mvv = mv.astype(jnp.float32).reshape(B, L, M_HEADS, M_HEAD_DIM)
    bg = b_gates.astype(jnp.float32)
    log_i = mi.astype(jnp.float32) + bg[:M_HEADS]
    log_f = jax.nn.log_sigmoid(mf.astype(jnp.float32) + bg[M_HEADS:])
    hm, S1, n1, m1 = _mlstm_chunkwise(mq, mk, mvv, log_i, log_f, S0.astype(jnp.float32),
                                      n0.astype(jnp.float32), m0.astype(jnp.float32))
    o_gate = jax.nn.sigmoid(mo.astype(jnp.float32)).reshape(B, L, M_HEADS, M_HEAD_DIM)
    hm = _rmsnorm(hm, mh_norm_w.reshape(M_HEADS, M_HEAD_DIM)) * o_gate
    mix_m = hm.reshape(B, L, D_MLSTM).astype(x.dtype) * jax.nn.silu(mz)
    mixed = jnp.concatenate([att.astype(x.dtype), mix_m], axis=-1)
    out = jnp.einsum('ble,ed->bld', mixed, w_out)
    return x + out.astype(x.dtype), new_k, new_v, new_conv, S1, n1, m1


def setup_inputs(seed: int = 0) -> dict:
    key = jax.random.key(seed)
    ks = jax.random.split(key, 20)
    wb = min(WINDOW, PAST_LEN)
    f32 = jnp.float32
    nrm = lambda k, s: jax.random.normal(k, s, dtype=f32)
    b_i = 0.1 * nrm(ks[14], (DEPTH, M_HEADS))
    b_f = jnp.linspace(3.0, 6.0, M_HEADS, dtype=f32)[None, :] + 0.01 * nrm(ks[15], (DEPTH, M_HEADS))
    return {
        'x_prompt': nrm(ks[0], (BATCH, SEQ, D_MODEL)),
        'x_sample': nrm(ks[1], (DEC_BATCH, DEC_SEQ, D_MODEL)),
        'cache_k_win': nrm(ks[2], (DEPTH, DEC_BATCH, wb, N_KV_HEADS, ATT_HEAD_DIM)),
        'cache_v_win': nrm(ks[3], (DEPTH, DEC_BATCH, wb, N_KV_HEADS, ATT_HEAD_DIM)),
        'state_conv': nrm(ks[4], (DEPTH, DEC_BATCH, CONV_W - 1, 2 * D_MLSTM)),
        'state_C': 0.1 * nrm(ks[5], (DEPTH, DEC_BATCH, M_HEADS, M_HEAD_DIM, M_HEAD_DIM)),
        'state_n': 0.5 * jnp.abs(nrm(ks[6], (DEPTH, DEC_BATCH, M_HEADS, M_HEAD_DIM))),
        'state_m': nrm(ks[7], (DEPTH, DEC_BATCH, M_HEADS)),
        'norm_w': 1.0 + 0.02 * nrm(ks[8], (DEPTH, D_MODEL)),
        'w_in': nrm(ks[9], (DEPTH, D_MODEL, D_IN)) * D_MODEL ** -0.5,
        'b_gates': jnp.concatenate([b_i, b_f], axis=-1),
        'conv_w': nrm(ks[10], (DEPTH, CONV_W, 2 * D_MLSTM)) * CONV_W ** -0.5,
        'conv_b': 0.02 * nrm(ks[11], (DEPTH, 2 * D_MLSTM)),
        'q_norm_w': 1.0 + 0.02 * nrm(ks[12], (DEPTH, ATT_HEAD_DIM)),
        'k_norm_w': 1.0 + 0.02 * nrm(ks[13], (DEPTH, ATT_HEAD_DIM)),
        'sinks': 0.5 * nrm(ks[16], (DEPTH, N_Q_HEADS)),
        'mh_norm_w': 1.0 + 0.02 * nrm(ks[17], (DEPTH, D_MLSTM)),
        'w_out': nrm(ks[18], (DEPTH, D_MIX, D_MODEL)) * D_MIX ** -0.5,
    }


def reference(x_prompt, x_sample, cache_k_win, cache_v_win, state_conv, state_C, state_n, state_m,
              norm_w, w_in, b_gates, conv_w, conv_b, q_norm_w, k_norm_w, sinks, mh_norm_w, w_out):
    B, L, _ = x_prompt.shape
    T = x_sample.shape[1]
    pos_p = jnp.arange(L, dtype=jnp.int32)
    pos_s = PAST_LEN + jnp.arange(T, dtype=jnp.int32)
    yp, ys = x_prompt, x_sample
    kp_l, vp_l, cp_l, Sp_l, np_l, mp_l = [], [], [], [], [], []
    ks_l, vs_l, cs_l, Ss_l, ns_l, ms_l = [], [], [], [], [], []
    for layer in range(DEPTH):
        wts = (norm_w[layer], w_in[layer], b_gates[layer], conv_w[layer], conv_b[layer],
               q_norm_w[layer], k_norm_w[layer], sinks[layer], mh_norm_w[layer], w_out[layer])
        conv0 = jnp.zeros((B, CONV_W - 1, 2 * D_MLSTM), x_prompt.dtype)
        S0 = jnp.zeros((B, M_HEADS, M_HEAD_DIM, M_HEAD_DIM), jnp.float32)
        n0 = jnp.zeros((B, M_HEADS, M_HEAD_DIM), jnp.float32)
        m0 = jnp.zeros((B, M_HEADS), jnp.float32)
        yp, kp, vp, cp, Sp, npp, mp = _hybrid_layer(yp, pos_p, _attn_prompt, conv0, S0, n0, m0, *wts)
        attend_s = functools.partial(_attn_sample, k_buf=cache_k_win[layer], v_buf=cache_v_win[layer])
        ys, kss, vss, css, Sss, nss, mss = _hybrid_layer(ys, pos_s, attend_s, state_conv[layer], state_C[layer],
                                                         state_n[layer], state_m[layer], *wts)
        kp_l.append(kp); vp_l.append(vp); cp_l.append(cp); Sp_l.append(Sp); np_l.append(npp); mp_l.append(mp)
        ks_l.append(kss.astype(cache_k_win.dtype)); vs_l.append(vss.astype(cache_v_win.dtype))
        cs_l.append(css.astype(state_conv.dtype)); Ss_l.append(Sss.astype(state_C.dtype))
        ns_l.append(nss.astype(state_n.dtype)); ms_l.append(mss.astype(state_m.dtype))
    st = lambda xs: jnp.stack(xs, axis=0)
    return (yp, ys, st(kp_l), st(vp_l), st(cp_l), st(Sp_l), st(np_l), st(mp_l),
            st(ks_l), st(vs_l), st(cs_l), st(Ss_l), st(ns_l), st(ms_l))
```

```cpp
#include <hip/hip_runtime.h>
#include <hip/hip_cooperative_groups.h>
#include <cstdio>
namespace cg = cooperative_groups;
namespace pg8 {
#define PG8_LAS __attribute__((address_space(3)))
typedef unsigned short bf16_t;
typedef short bf16x8 __attribute__((ext_vector_type(8)));
typedef float f32x4 __attribute__((ext_vector_type(4)));
typedef unsigned u32x4 __attribute__((ext_vector_type(4)));
constexpr int BM = 256, BK = 64, HALF = 128, HTB = HALF * BK * 2  , STAGE_BYTES = 8 * HTB, NXCD = 8, WGM = 8;

__host__ __device__ __forceinline__ int lds_byte(int r, int c) { const int st = (r >> 4) * 2 + (c >> 5), rr = r & 15, cc = c & 31, ob = rr * 64 + cc * 2; return st * 1024 + (ob ^ (((ob >> 9) & 1) << 5)); }
__host__ __device__ __forceinline__ void stage_rc(int b, int& R, int& C) { const int st = b / 1024, sb = b % 1024, swz = sb ^ (((sb >> 9) & 1) << 5); R = (st >> 1) * 16 + swz / 64; C = (st & 1) * 32 + (swz % 64) / 2; }
__host__ __device__ __forceinline__ int perm32(int rho) { const int n = rho >> 4, i = rho & 15; return 8 * (i >> 2) + 4 * n + (i & 3); }

struct Unit { int pm, pn; };
struct Gemm { const bf16_t* A; const bf16_t* Bt; int M, N, K; };

struct StaticOrder {
    int nM, nN, nwg, G, c;
    __host__ __device__ void init(int M, int N, int G_, int c_) { nM = M / BM; nN = N / BM; nwg = nM * nN; G = G_; c = c_; }
    __host__ __device__ bool next(int i, Unit& u) const {
        const long L = (long)i * G + c; if (L >= nwg) return false;
        int wgid = (int)L; { const int q = nwg / NXCD, r = nwg % NXCD, xcd = wgid % NXCD, off = wgid / NXCD; wgid = (xcd < r ? xcd * (q + 1) : r * (q + 1) + (xcd - r) * q) + off; }
        const int nig = WGM * nN, gid = wgid / nig, fm = gid * WGM, gsz = (nM - fm) < WGM ? (nM - fm) : WGM;
        u.pm = fm + ((wgid % nig) % gsz); u.pn = (wgid % nig) / gsz; return true;
    }
    __device__ __forceinline__ void a_ready(const Unit&) const {}
    __device__ __forceinline__ void done(const Unit&) const {}
};
__device__ __forceinline__ unsigned cvt_pk_bf16(float lo, float hi) { unsigned r; asm volatile("v_cvt_pk_bf16_f32 %0, %1, %2" : "=v"(r) : "v"(lo), "v"(hi)); return r; }
template <class Epi, class Sched, bool STAMP = false>
__device__ __forceinline__ void gemm_phase(PG8_LAS unsigned char* lds, const Gemm g, const Sched& S, const Epi& E, unsigned long long* stamps) {
    const int tid = threadIdx.x, wid = __builtin_amdgcn_readfirstlane(tid >> 6), lane = tid & 63, wr = wid >> 2, wc = wid & 3, fr = lane & 15, fq = lane >> 4;
    const int K = g.K, nt = K / BK;
    int ts_lo = 0, ts_hi = 0, nts = 0; const unsigned long long rt_entry = STAMP ? (unsigned long long)wall_clock64() : 0ull;
#define PG8_STAMP() do { if (STAMP && wid == 0 && nts < 64) { const unsigned long long _c = (unsigned long long)clock64(); \
        ts_lo = (lane == nts) ? (int)(unsigned)_c : ts_lo; ts_hi = (lane == nts) ? (int)(unsigned)(_c >> 32) : ts_hi; ++nts; } } while (0)
    PG8_STAMP();
    unsigned voffA[2], voffB[2];
#pragma unroll
    for (int i = 0; i < 2; ++i) { int R, C; stage_rc(tid * 16 + i * 8192, R, C); const int Rb = Epi::PERM ? ((R & ~31) + perm32(R & 31)) : R;
        voffA[i] = (unsigned)(R * K + C) * 2u; voffB[i] = (unsigned)(Rb * K + C) * 2u; }
    const size_t kstep = (size_t)(BK * 2);
    const size_t hstep = (size_t)HALF * K * 2;
    const size_t tstep = 2 * hstep;
    const unsigned ldsw = (unsigned)wid * 1024u;
    const int aoff = lds_byte(wr * 64 + fr, fq * 8), boff = lds_byte(wc * 32 + fr, fq * 8);
#define PG8_SA(b, h) (((b) * 2 + (h)) * HTB)
#define PG8_SB(b, h) ((4 + (b) * 2 + (h)) * HTB)
#define PG8_STAGE(bufoff, gbase, voff) do { _Pragma("unroll") for (int _i = 0; _i < 2; ++_i) \
        __builtin_amdgcn_global_load_lds((const unsigned*)((const char*)(gbase) + (voff)[_i]), (PG8_LAS unsigned*)(lds + (bufoff) + ldsw + _i * 8192), 16, 0, 0); } while (0)
#define PG8_LDA(dst, b, h) do { _Pragma("unroll") for (int m = 0; m < 4; ++m) _Pragma("unroll") for (int k = 0; k < 2; ++k) dst[m][k] = *(const PG8_LAS bf16x8*)(lds + PG8_SA(b, h) + aoff + m * 2048 + k * 1024); } while (0)
#define PG8_LDB(dst, b, h) do { _Pragma("unroll") for (int n = 0; n < 2; ++n) _Pragma("unroll") for (int k = 0; k < 2; ++k) dst[n][k] = *(const PG8_LAS bf16x8*)(lds + PG8_SB(b, h) + boff + n * 2048 + k * 1024); } while (0)
#define PG8_MMA(ai, bj, At, Bt) do { __builtin_amdgcn_s_setprio(1); _Pragma("unroll") for (int m = 0; m < 4; ++m) _Pragma("unroll") for (int n = 0; n < 2; ++n) _Pragma("unroll") for (int k = 0; k < 2; ++k) \
        acc[ai][bj][m][n] = __builtin_amdgcn_mfma_f32_16x16x32_bf16(Bt[n][k], At[m][k], acc[ai][bj][m][n], 0, 0, 0); __builtin_amdgcn_s_setprio(0); } while (0)
#define PG8_WAIT_V(n) asm volatile("s_waitcnt vmcnt(" #n ")" ::: "memory")
#define PG8_WAIT_L(n) asm volatile("s_waitcnt lgkmcnt(" #n ")" ::: "memory")
#define PG8_BAR __builtin_amdgcn_s_barrier()
#define PG8_SCHED __builtin_amdgcn_sched_barrier(0)
    Unit cur, nxt; int ui = 0;
    if (!S.next(0, cur)) return;
    f32x4 acc[2][2][4][2];
#pragma unroll
    for (int a = 0; a < 2; ++a)
#pragma unroll
        for (int b = 0; b < 2; ++b)
#pragma unroll
            for (int m = 0; m < 4; ++m)
#pragma unroll
                for (int n = 0; n < 2; ++n) acc[a][b][m][n] = (f32x4){0.f, 0.f, 0.f, 0.f};
    bf16x8 At[4][2], B0[2][2], B1[2][2];
    const char* cA = (const char*)g.A + (size_t)cur.pm * tstep; const char* cB = (const char*)g.Bt + (size_t)cur.pn * tstep;
    S.a_ready(cur);
    PG8_STAGE(PG8_SB(0, 0), cB, voffB); PG8_STAGE(PG8_SA(0, 0), cA, voffA); PG8_STAGE(PG8_SB(0, 1), cB + hstep, voffB); PG8_STAGE(PG8_SA(0, 1), cA + hstep, voffA);
    if (wr == 1) PG8_BAR;
    PG8_WAIT_V(4); PG8_BAR;
    PG8_STAGE(PG8_SB(1, 0), cB + kstep, voffB); PG8_STAGE(PG8_SA(1, 0), cA + kstep, voffA); PG8_STAGE(PG8_SB(1, 1), cB + hstep + kstep, voffB);
    PG8_WAIT_V(6); PG8_BAR;
    PG8_STAMP();
    for (;;) {
        const bool has_next = S.next(ui + 1, nxt);
        const char* nA = has_next ? (const char*)g.A + (size_t)nxt.pm * tstep : cA; const char* nB = has_next ? (const char*)g.Bt + (size_t)nxt.pn * tstep : cB;
        for (int t = 0; t < nt; t += 2) {
            const bool last = (t == nt - 2);
            const char* a1 = cA + (size_t)(t + 1) * kstep;
            const char* a2 = last ? nA : cA + (size_t)(t + 2) * kstep; const char* b2 = last ? nB : cB + (size_t)(t + 2) * kstep;
            const char* a3 = a2 + kstep; const char* b3 = b2 + kstep;
            if (last && has_next) S.a_ready(nxt);
            PG8_LDB(B0, 0, 0); PG8_SCHED; PG8_LDA(At, 0, 0); PG8_STAGE(PG8_SA(1, 1), a1 + hstep, voffA);
            PG8_WAIT_L(8); PG8_BAR; PG8_WAIT_L(0); PG8_MMA(0, 0, At, B0); PG8_BAR; PG8_SCHED;
            PG8_LDB(B1, 0, 1); PG8_STAGE(PG8_SB(0, 0), b2, voffB);
            PG8_BAR; PG8_WAIT_L(0); PG8_MMA(0, 1, At, B1); PG8_BAR;
            PG8_LDA(At, 0, 1); PG8_STAGE(PG8_SA(0, 0), a2, voffA);
            PG8_BAR; PG8_WAIT_L(0); PG8_MMA(1, 0, At, B0); PG8_BAR; PG8_SCHED;
            PG8_STAGE(PG8_SB(0, 1), b2 + hstep, voffB);
            PG8_WAIT_V(6); PG8_BAR; PG8_MMA(1, 1, At, B1); PG8_BAR;
            PG8_LDB(B0, 1, 0); PG8_SCHED; PG8_LDA(At, 1, 0); PG8_STAGE(PG8_SA(0, 1), a2 + hstep, voffA);
            PG8_WAIT_L(8); PG8_BAR; PG8_WAIT_L(0); PG8_MMA(0, 0, At, B0); PG8_BAR; PG8_SCHED;
            PG8_LDB(B1, 1, 1); PG8_STAGE(PG8_SB(1, 0), b3, voffB);
            PG8_BAR; PG8_WAIT_L(0); PG8_MMA(0, 1, At, B1); PG8_BAR;
            PG8_LDA(At, 1, 1); PG8_STAGE(PG8_SA(1, 0), a3, voffA);
            PG8_BAR; PG8_WAIT_L(0); PG8_MMA(1, 0, At, B0); PG8_BAR; PG8_SCHED;
            PG8_STAGE(PG8_SB(1, 1), b3 + hstep, voffB);
            PG8_WAIT_V(6); PG8_BAR; PG8_MMA(1, 1, At, B1); PG8_BAR;
        }
        PG8_STAMP();
        if constexpr (!Epi::AFTER_DRAIN) { E(acc, cur, wr, wc, fr, fq); S.done(cur); }
        PG8_STAMP();
        if (!has_next) break;
#pragma unroll
        for (int a = 0; a < 2; ++a)
#pragma unroll
            for (int b = 0; b < 2; ++b)
#pragma unroll
                for (int m = 0; m < 4; ++m)
#pragma unroll
                    for (int n = 0; n < 2; ++n) acc[a][b][m][n] = (f32x4){0.f, 0.f, 0.f, 0.f};
        cur = nxt; cA = nA; cB = nB; ++ui;
    }
    PG8_WAIT_V(0);
    if (wr == 0) PG8_BAR;
    PG8_BAR;
    if constexpr (Epi::AFTER_DRAIN) { E.fused(acc, cur, wr, wc, fr, fq, lds, wid, lane); S.done(cur); }
    PG8_STAMP();
    if (STAMP && wid == 0) { stamps[lane] = lane < nts ? (((unsigned long long)(unsigned)ts_hi << 32) | (unsigned)ts_lo) : 0ull;
        if (lane == 62) stamps[62] = rt_entry; if (lane == 63) stamps[63] = (unsigned long long)wall_clock64(); }
#undef PG8_STAMP
#undef PG8_SA
#undef PG8_SB
#undef PG8_STAGE
#undef PG8_LDA
#undef PG8_LDB
#undef PG8_MMA
#undef PG8_WAIT_V
#undef PG8_WAIT_L
#undef PG8_BAR
#undef PG8_SCHED
}
}

using pg8::bf16_t; using pg8::bf16x8; using pg8::f32x4; using pg8::u32x4;
#define LAS __attribute__((address_space(3)))
#define DI __device__ __forceinline__
typedef unsigned char uchar;
typedef unsigned u32x2 __attribute__((ext_vector_type(2)));

constexpr int NTP = 16384, NTS = 512, NTOK = 16896, DM = 1024, DIN = 3848, NPJ = 3840, SEQ = 8192;
constexpr int C_AQ = 0, C_AK = 512, C_AV = 640, C_AG = 768, C_MQ = 1280, C_MK = 1792, C_MV = 2304, C_MO = 2816, C_MZ = 3328;
constexpr int NCH = 64, CH = 128, USZ = 129 * 128;
constexpr size_t O_Y = 0, O_KWP = 17301504, O_VWP = 17334272, O_CONVP = 17367040, O_CP = 17373184, O_NP = 17504256, O_MP = 17505280,
                 O_KWS = 17505288, O_VWS = 19602440, O_CONVS = 21699592, O_CS = 22092808, O_NS = 30481416, O_MS = 30546952;
constexpr size_t WS_WTIN = 0, WS_WTOUT = 7864320, WS_H = 9961472, WS_GATES = 44564480, WS_ROPE = 45105152, WS_FM = 45637632,
                 WS_PROJ = 46161920, WS_UST = 175923200, WS_MIXED = 209739776, WS_END = 244342784;
constexpr int LDS_BYTES = 131072;

struct Params {
    const float *x_p, *x_s, *ck, *cv, *sconv, *sC, *sn, *sm, *norm_w, *w_in, *b_gates, *conv_w, *conv_b, *qnw, *knw, *sinks, *mhw, *w_out;
    float* out; uchar* ws;
};

DI float bflo(unsigned w) { return __uint_as_float(w << 16); }
DI float bfhi(unsigned w) { return __uint_as_float(w & 0xffff0000u); }
DI unsigned pk2(float a, float b) { return pg8::cvt_pk_bf16(a, b); }
DI bf16_t f2bf(float f) { unsigned u = __float_as_uint(f); u += 0x7fffu + ((u >> 16) & 1u); return (bf16_t)(u >> 16); }
DI void unpack8(const u32x4 w, float (&f)[8]) { f[0] = bflo(w.x); f[1] = bfhi(w.x); f[2] = bflo(w.y); f[3] = bfhi(w.y); f[4] = bflo(w.z); f[5] = bfhi(w.z); f[6] = bflo(w.w); f[7] = bfhi(w.w); }
DI u32x4 pack8(const float (&f)[8]) { u32x4 w; w.x = pk2(f[0], f[1]); w.y = pk2(f[2], f[3]); w.z = pk2(f[4], f[5]); w.w = pk2(f[6], f[7]); return w; }
DI float wsum(float v) { for (int o = 32; o; o >>= 1) v += __shfl_xor(v, o); return v; }
DI float silu(float x) { return x / (1.0f + __expf(-x)); }
DI float sigm(float x) { return 1.0f / (1.0f + __expf(-x)); }
DI f32x4 mfma16(bf16x8 a, bf16x8 b, f32x4 c) { return __builtin_amdgcn_mfma_f32_16x16x32_bf16(a, b, c, 0, 0, 0); }

DI void phase0(const Params& p, LAS uchar* lds) {
    const int tid = threadIdx.x, lane = tid & 63, wid = tid >> 6, nb = gridDim.x, bid = blockIdx.x;
    LAS float* tile = (LAS float*)lds;
    for (int t = bid; t < 960 + 256; t += nb) {
        const float* src; bf16_t* dst; int ld, k0, n0, sc0;
        if (t < 960) { const int nt = t % 60, kt = t / 60; n0 = nt * 64; k0 = kt * 64; sc0 = n0 + (n0 >= 3328 ? 8 : 0); src = p.w_in; ld = DIN; dst = (bf16_t*)(p.ws + WS_WTIN); }
        else { const int t2 = t - 960, nt = t2 % 16, kt = t2 / 16; n0 = nt * 64; k0 = kt * 64; sc0 = n0; src = p.w_out; ld = DM; dst = (bf16_t*)(p.ws + WS_WTOUT); }
#pragma unroll
        for (int ps = 0; ps < 2; ++ps) { const int kk = (tid >> 4) + 32 * ps, nn4 = (tid & 15) * 4;
            const float4 v = *(const float4*)(src + (size_t)(k0 + kk) * ld + sc0 + nn4);
            tile[kk * 65 + nn4] = v.x; tile[kk * 65 + nn4 + 1] = v.y; tile[kk * 65 + nn4 + 2] = v.z; tile[kk * 65 + nn4 + 3] = v.w; }
        __syncthreads();
        { const int nn = tid >> 3, kk8 = (tid & 7) * 8; float f[8];
#pragma unroll
          for (int j = 0; j < 8; ++j) f[j] = tile[(kk8 + j) * 65 + nn];
          *(u32x4*)(dst + (size_t)(n0 + nn) * DM + k0 + kk8) = pack8(f); }
        __syncthreads();
    }
    { float2* rope = (float2*)(p.ws + WS_ROPE);
      for (int idx = bid * 512 + tid; idx < 8200 * 8; idx += nb * 512) { const int pos = idx >> 3, i = idx & 7;
          const float invf = (float)exp(-(double)i * 0.125 * 13.122363377404328);
          const float ang = (float)pos * invf;
          const double q = rint((double)ang * 0.6366197723675814), r = (double)ang - q * 1.5707963267948966, r2 = r * r;
          const double s = r * (1.0 + r2 * (-1.0 / 6 + r2 * (1.0 / 120 + r2 * (-1.0 / 5040 + r2 * (1.0 / 362880 + r2 * (-1.0 / 39916800 + r2 * (1.0 / 6227020800.0)))))));
          const double c = 1.0 + r2 * (-0.5 + r2 * (1.0 / 24 + r2 * (-1.0 / 720 + r2 * (1.0 / 40320 + r2 * (-1.0 / 3628800 + r2 * (1.0 / 479001600.0))))));
          const int qi = ((int)q) & 3; double cs, sn;
          if (qi == 0) { sn = s; cs = c; } else if (qi == 1) { sn = c; cs = -s; } else if (qi == 2) { sn = -s; cs = -c; } else { sn = -c; cs = s; }
          rope[idx] = make_float2((float)cs, (float)sn); } }
    LAS float* wg = (LAS float*)(lds + 32768);
    for (int d = tid; d < DM; d += 512) { const float4 a = *(const float4*)(p.w_in + (size_t)d * DIN + 3328), b = *(const float4*)(p.w_in + (size_t)d * DIN + 3332);
        wg[d] = a.x; wg[1024 + d] = a.y; wg[2048 + d] = a.z; wg[3072 + d] = a.w; wg[4096 + d] = b.x; wg[5120 + d] = b.y; wg[6144 + d] = b.z; wg[7168 + d] = b.w; }
    __syncthreads();
    bf16_t* H = (bf16_t*)(p.ws + WS_H); float* gates = (float*)(p.ws + WS_GATES);
    for (int row = bid * 8 + wid; row < NTOK; row += nb * 8) {
        const float* xr = row < NTP ? p.x_p + (size_t)row * DM : p.x_s + (size_t)(row - NTP) * DM;
        float4 xv[4]; float ss = 0.f;
#pragma unroll
        for (int i = 0; i < 4; ++i) { xv[i] = *(const float4*)(xr + i * 256 + lane * 4); ss += xv[i].x * xv[i].x + xv[i].y * xv[i].y + xv[i].z * xv[i].z + xv[i].w * xv[i].w; }
        ss = wsum(ss); const float rstd = rsqrtf(ss * (1.0f / DM) + 1e-6f);
        float g[8];
#pragma unroll
        for (int j = 0; j < 8; ++j) g[j] = 0.f;
#pragma unroll
        for (int i = 0; i < 4; ++i) { const int d0 = i * 256 + lane * 4; const float4 nw = *(const float4*)(p.norm_w + d0);
            const float h0 = xv[i].x * rstd * nw.x, h1 = xv[i].y * rstd * nw.y, h2 = xv[i].z * rstd * nw.z, h3 = xv[i].w * rstd * nw.w;
            u32x2 w; w.x = pk2(h0, h1); w.y = pk2(h2, h3); *(u32x2*)(H + (size_t)row * DM + d0) = w;
#pragma unroll
            for (int j = 0; j < 8; ++j) { const f32x4 wv = *(const LAS f32x4*)(wg + j * 1024 + d0); g[j] += h0 * wv[0] + h1 * wv[1] + h2 * wv[2] + h3 * wv[3]; } }
#pragma unroll
        for (int j = 0; j < 8; ++j) g[j] = wsum(g[j]);
        if (lane == 0) {
#pragma unroll
            for (int j = 0; j < 4; ++j) gates[(size_t)row * 8 + j] = g[j] + p.b_gates[j];
#pragma unroll
            for (int j = 4; j < 8; ++j) { const float z = g[j] + p.b_gates[j]; gates[(size_t)row * 8 + j] = fminf(z, 0.f) - log1pf(expf(-fabsf(z))); } }
    }
}

DI float block_excl_sum(float v, LAS float* red, int tid) {
    const int lane = tid & 63, wid = tid >> 6; float inc = v;
#pragma unroll
    for (int o = 1; o < 64; o <<= 1) { const float t = __shfl_up(inc, o); if (lane >= o) inc += t; }
    __syncthreads(); if (lane == 63) red[wid] = inc; __syncthreads();
    float base = 0.f;
#pragma unroll
    for (int w = 0; w < 8; ++w) base += (w < wid) ? red[w] : 0.f;
    return base + inc - v;
}
DI float block_excl_max(float v, LAS float* red, int tid) {
    const int lane = tid & 63, wid = tid >> 6; float inc = v;
#pragma unroll
    for (int o = 1; o < 64; o <<= 1) { const float t = __shfl_up(inc, o); if (lane >= o) inc = fmaxf(inc, t); }
    __syncthreads(); if (lane == 63) red[wid] = inc; __syncthreads();
    float base = -INFINITY;
#pragma unroll
    for (int w = 0; w < 8; ++w) base = fmaxf(base, (w < wid) ? red[w] : -INFINITY);
    float ex = __shfl_up(inc, 1); if (lane == 0) ex = -INFINITY;
    return fmaxf(base, ex);
}
DI void gate_scan(const Params& p, LAS uchar* lds, int bh) {
    const int tid = threadIdx.x, b = bh >> 2, h = bh & 3, t0 = tid * 16;
    const float* gates = (const float*)(p.ws + WS_GATES); float2* FM = (float2*)(p.ws + WS_FM) + (size_t)bh * SEQ;
    LAS float* red = (LAS float*)lds;
    float li[16], F[16];
    float run = 0.f;
#pragma unroll
    for (int j = 0; j < 16; ++j) { const float* g = gates + (size_t)(b * SEQ + t0 + j) * 8; li[j] = g[h]; run += g[4 + h]; F[j] = run; }
    const float base = block_excl_sum(run, red, tid);
    float mx = -INFINITY, ml[16];
#pragma unroll
    for (int j = 0; j < 16; ++j) { F[j] += base; mx = fmaxf(mx, li[j] - F[j]); ml[j] = mx; }
    const float mb = fmaxf(block_excl_max(mx, red, tid), 0.0f);
#pragma unroll
    for (int j = 0; j < 16; ++j) FM[t0 + j] = make_float2(F[j], F[j] + fmaxf(ml[j], mb));
    __syncthreads();
}

struct EpiProj {
    static constexpr bool PERM = true, AFTER_DRAIN = false;
    bf16_t* O;
    __device__ __forceinline__ void operator()(const f32x4 (&acc)[2][2][4][2], const pg8::Unit& u, int wr, int wc, int fr, int fq) const {
        const int row0 = u.pm * 256 + wr * 64 + fr, col0 = u.pn * 256 + wc * 32 + 8 * fq;
#pragma unroll
        for (int ai = 0; ai < 2; ++ai)
#pragma unroll
            for (int m = 0; m < 4; ++m) { bf16_t* rowp = O + (size_t)(row0 + ai * 128 + m * 16) * NPJ + col0;
#pragma unroll
                for (int bj = 0; bj < 2; ++bj) { const f32x4 v0 = acc[ai][bj][m][0], v1 = acc[ai][bj][m][1];
                    u32x4 w; w.x = pk2(v0[0], v0[1]); w.y = pk2(v0[2], v0[3]); w.z = pk2(v1[0], v1[1]); w.w = pk2(v1[2], v1[3]);
                    *(u32x4*)(rowp + bj * 128) = w; } }
    }
};
struct EpiOut {
    static constexpr bool PERM = false, AFTER_DRAIN = false;
    float* Y; const float* xp; const float* xs;
    __device__ __forceinline__ void operator()(const f32x4 (&acc)[2][2][4][2], const pg8::Unit& u, int wr, int wc, int fr, int fq) const {
        const int row0 = u.pm * 256 + wr * 64 + fr, col0 = u.pn * 256 + wc * 32 + 4 * fq;
#pragma unroll
        for (int ai = 0; ai < 2; ++ai)
#pragma unroll
            for (int m = 0; m < 4; ++m) { const int row = row0 + ai * 128 + m * 16;
                const float* xr = (row < NTP ? xp + (size_t)row * DM : xs + (size_t)(row - NTP) * DM) + col0; float* yr = Y + (size_t)row * DM + col0;
#pragma unroll
                for (int bj = 0; bj < 2; ++bj)
#pragma unroll
                    for (int n = 0; n < 2; ++n) *(f32x4*)(yr + bj * 128 + n * 16) = acc[ai][bj][m][n] + *(const f32x4*)(xr + bj * 128 + n * 16); }
    }
};
DI void phase1(const Params& p, LAS uchar* lds) {
    const int nb = gridDim.x, bid = blockIdx.x;
    if (bid >= nb - 8) gate_scan(p, lds, bid - (nb - 8));
    pg8::Gemm g; g.A = (const bf16_t*)(p.ws + WS_H); g.Bt = (const bf16_t*)(p.ws + WS_WTIN); g.M = NTOK; g.N = NPJ; g.K = DM;
    pg8::StaticOrder S; S.init(g.M, g.N, nb, bid);
    EpiProj E; E.O = (bf16_t*)(p.ws + WS_PROJ);
    pg8::gemm_phase<EpiProj, pg8::StaticOrder, false>(lds, g, S, E, nullptr);
}
DI void phase5(const Params& p, LAS uchar* lds) {
    const int nb = gridDim.x, bid = blockIdx.x;
    pg8::Gemm g; g.A = (const bf16_t*)(p.ws + WS_MIXED); g.Bt = (const bf16_t*)(p.ws + WS_WTOUT); g.M = NTOK; g.N = DM; g.K = DM;
    pg8::StaticOrder S; S.init(g.M, g.N, nb, bid);
    EpiOut E; E.Y = p.out + O_Y; E.xp = p.x_p; E.xs = p.x_s;
    pg8::gemm_phase<EpiOut, pg8::StaticOrder, false>(lds, g, S, E, nullptr);
}

constexpr int KSTR = 144, VSTR = 560, AT_K = 0, AT_V = 272 * KSTR;

DI void qk_norm_rope16(float (&x)[16], int pt, const float* nw, const float2* rope_row) {
    float ss = 0.f;
#pragma unroll
    for (int j = 0; j < 16; ++j) ss += x[j] * x[j];
    ss += __shfl_xor(ss, 1); ss += __shfl_xor(ss, 2);
    const float rstd = rsqrtf(ss * (1.0f / 64) + 1e-6f);
#pragma unroll
    for (int j = 0; j < 16; ++j) x[j] = x[j] * rstd * nw[pt * 16 + j];
    if (pt == 0) {
#pragma unroll
        for (int i = 0; i < 8; ++i) { const float2 cs = rope_row[i]; const float a = x[i], b = x[i + 8]; x[i] = a * cs.x - b * cs.y; x[i + 8] = b * cs.x + a * cs.y; } }
}
DI void kv_to_lds(LAS uchar* lds, int ki, int pt, const float (&xk)[16], const float (&xv)[16]) {
    float a[8], b[8];
#pragma unroll
    for (int j = 0; j < 8; ++j) { a[j] = xk[j]; b[j] = xk[8 + j]; }
    *(LAS u32x4*)(lds + AT_K + ki * KSTR + pt * 32) = pack8(a); *(LAS u32x4*)(lds + AT_K + ki * KSTR + pt * 32 + 16) = pack8(b);
#pragma unroll
    for (int j = 0; j < 16; ++j) *(LAS bf16_t*)(lds + AT_V + (pt * 16 + j) * VSTR + ki * 2) = f2bf(xv[j]);
}
DI void load16bf(const bf16_t* src, float (&x)[16]) { const u32x4 w0 = *(const u32x4*)src, w1 = *(const u32x4*)(src + 8); float a[8], b[8]; unpack8(w0, a); unpack8(w1, b);
#pragma unroll
    for (int j = 0; j < 8; ++j) { x[j] = a[j]; x[8 + j] = b[j]; } }
DI void load16f(const float* src, float (&x)[16]) {
#pragma unroll
    for (int j = 0; j < 4; ++j) { const float4 v = *(const float4*)(src + 4 * j); x[4 * j] = v.x; x[4 * j + 1] = v.y; x[4 * j + 2] = v.z; x[4 * j + 3] = v.w; } }
DI void store16f(float* dst, const float (&x)[16]) {
#pragma unroll
    for (int j = 0; j < 4; ++j) *(float4*)(dst + 4 * j) = make_float4(x[4 * j], x[4 * j + 1], x[4 * j + 2], x[4 * j + 3]); }

DI void attn_q_tile(const Params& p, LAS uchar* lds, int row, int pos, int hqa, int qi, int kt0, int kmin) {
    const int lane = threadIdx.x & 63, r = lane & 15, quad = lane >> 4;
    const bf16_t* proj = (const bf16_t*)(p.ws + WS_PROJ); const float2* rope = (const float2*)(p.ws + WS_ROPE);
    const bf16_t* rowp = proj + (size_t)row * NPJ;
    float x0[8], x1[8];
    unpack8(*(const u32x4*)(rowp + C_AQ + hqa * 64 + 8 * quad), x0); unpack8(*(const u32x4*)(rowp + C_AQ + hqa * 64 + 32 + 8 * quad), x1);
    float ss = 0.f;
#pragma unroll
    for (int j = 0; j < 8; ++j) ss += x0[j] * x0[j] + x1[j] * x1[j];
    ss += __shfl_xor(ss, 16); ss += __shfl_xor(ss, 32);
    const float rstd = rsqrtf(ss * (1.0f / 64) + 1e-6f) ;
#pragma unroll
    for (int j = 0; j < 8; ++j) { x0[j] = x0[j] * rstd * p.qnw[8 * quad + j]; x1[j] = x1[j] * rstd * p.qnw[32 + 8 * quad + j]; }
#pragma unroll
    for (int j = 0; j < 8; ++j) { const float pj = __shfl_xor(x0[j], 16); const float2 cs = rope[(size_t)pos * 8 + j];
        const float rot = x0[j] * cs.x + (quad == 0 ? -pj : pj) * cs.y; x0[j] = (quad < 2) ? rot : x0[j]; }
#pragma unroll
    for (int j = 0; j < 8; ++j) { x0[j] *= 0.125f; x1[j] *= 0.125f; }
    const bf16x8 qf0 = __builtin_bit_cast(bf16x8, pack8(x0)), qf1 = __builtin_bit_cast(bf16x8, pack8(x1));
    const float sink = p.sinks[hqa];
    f32x4 s[10];
#pragma unroll
    for (int kt = 0; kt < 10; ++kt) { const int krow = (kt0 + kt) * 16 + r;
        const bf16x8 a0 = *(const LAS bf16x8*)(lds + AT_K + krow * KSTR + quad * 16), a1 = *(const LAS bf16x8*)(lds + AT_K + krow * KSTR + 64 + quad * 16);
        f32x4 acc = {0.f, 0.f, 0.f, 0.f}; acc = mfma16(a0, qf0, acc); acc = mfma16(a1, qf1, acc); s[kt] = acc; }
    float mx = sink;
#pragma unroll
    for (int kt = 0; kt < 10; ++kt)
#pragma unroll
        for (int v = 0; v < 4; ++v) { const int ki = (kt0 + kt) * 16 + quad * 4 + v; const bool ok = (ki > qi) && (ki <= qi + 128) && (ki >= kmin);
            s[kt][v] = ok ? s[kt][v] : -INFINITY; mx = fmaxf(mx, s[kt][v]); }
    mx = fmaxf(mx, __shfl_xor(mx, 16)); mx = fmaxf(mx, __shfl_xor(mx, 32));
    float sum = 0.f;
#pragma unroll
    for (int kt = 0; kt < 10; ++kt)
#pragma unroll
        for (int v = 0; v < 4; ++v) { const float e = __expf(s[kt][v] - mx); s[kt][v] = e; sum += e; }
    sum += __shfl_xor(sum, 16); sum += __shfl_xor(sum, 32);
    sum += __expf(sink - mx);
    const float inv = 1.0f / sum;
    f32x4 o[4];
#pragma unroll
    for (int mt = 0; mt < 4; ++mt) o[mt] = (f32x4){0.f, 0.f, 0.f, 0.f};
#pragma unroll
    for (int ks = 0; ks < 5; ++ks) {
        u32x4 pw; pw.x = pk2(s[2 * ks][0], s[2 * ks][1]); pw.y = pk2(s[2 * ks][2], s[2 * ks][3]); pw.z = pk2(s[2 * ks + 1][0], s[2 * ks + 1][1]); pw.w = pk2(s[2 * ks + 1][2], s[2 * ks + 1][3]);
        const bf16x8 pb = __builtin_bit_cast(bf16x8, pw);
#pragma unroll
        for (int mt = 0; mt < 4; ++mt) { const int d = 16 * mt + r; const LAS uchar* vp = lds + AT_V + d * VSTR + ((kt0 + 2 * ks) * 16 + 4 * quad) * 2;
            u32x4 aw; const u32x2 lo = *(const LAS u32x2*)vp, hi = *(const LAS u32x2*)(vp + 32); aw.x = lo.x; aw.y = lo.y; aw.z = hi.x; aw.w = hi.y;
            o[mt] = mfma16(__builtin_bit_cast(bf16x8, aw), pb, o[mt]); } }
    bf16_t* mixed = (bf16_t*)(p.ws + WS_MIXED) + (size_t)row * DM;
#pragma unroll
    for (int mt = 0; mt < 4; ++mt) { const int col = hqa * 64 + 16 * mt + 4 * quad; const u32x2 gw = *(const u32x2*)(rowp + C_AG + col);
        u32x2 w; w.x = pk2(o[mt][0] * inv * silu(bflo(gw.x)), o[mt][1] * inv * silu(bfhi(gw.x))); w.y = pk2(o[mt][2] * inv * silu(bflo(gw.y)), o[mt][3] * inv * silu(bfhi(gw.y)));
        *(u32x2*)(mixed + col) = w; }
}

DI void attn_prompt_item(const Params& p, LAS uchar* lds, int item) {
    const int tid = threadIdx.x, wid = tid >> 6, lane = tid & 63, r = lane & 15;
    const int g = item & 1, blk = (item >> 1) & 63, b = item >> 7;
    const bf16_t* proj = (const bf16_t*)(p.ws + WS_PROJ); const float2* rope = (const float2*)(p.ws + WS_ROPE);
    __syncthreads();
    for (int u = tid; u < 1088; u += 512) { const int ki = u >> 2, pt = u & 3, tk = (blk - 1) * 128 + ki; const bool valid = (ki < 256) && (tk >= 0);
        float xk[16], xv[16];
#pragma unroll
        for (int j = 0; j < 16; ++j) { xk[j] = 0.f; xv[j] = 0.f; }
        if (valid) { const bf16_t* rowp = proj + (size_t)(b * SEQ + tk) * NPJ; load16bf(rowp + C_AK + g * 64 + pt * 16, xk); load16bf(rowp + C_AV + g * 64 + pt * 16, xv); }
        qk_norm_rope16(xk, pt, p.knw, rope + (size_t)(tk < 0 ? 0 : tk) * 8);
        kv_to_lds(lds, ki, pt, xk, xv);
        if (blk == 63 && ki >= 128 && ki < 256) { const size_t o = ((size_t)(b * 128 + ki - 128) * 2 + g) * 64 + pt * 16; store16f(p.out + O_KWP + o, xk); store16f(p.out + O_VWP + o, xv); }
    }
    __syncthreads();
    const int hqa = g * 4 + (wid >> 1), qh = wid & 1;
    for (int i = 0; i < 4; ++i) { const int qt = qh * 4 + i, qi = qt * 16 + r, tq = blk * 128 + qi;
        attn_q_tile(p, lds, b * SEQ + tq, tq, hqa, qi, qt, blk == 0 ? 128 : 0); }
}
DI void attn_sample_item(const Params& p, LAS uchar* lds, int item) {
    const int tid = threadIdx.x, wid = tid >> 6, lane = tid & 63, r = lane & 15;
    const int g = item & 1, b = item >> 1;
    const bf16_t* proj = (const bf16_t*)(p.ws + WS_PROJ); const float2* rope = (const float2*)(p.ws + WS_ROPE);
    __syncthreads();
    for (int u = tid; u < 640; u += 512) { const int ki = u >> 2, pt = u & 3;
        float xk[16], xv[16];
#pragma unroll
        for (int j = 0; j < 16; ++j) { xk[j] = 0.f; xv[j] = 0.f; }
        if (ki < 128) { const size_t o = ((size_t)(b * 128 + ki) * 2 + g) * 64 + pt * 16; load16f(p.ck + o, xk); load16f(p.cv + o, xv); }
        else { if (ki < 132) { const bf16_t* rowp = proj + (size_t)(NTP + b * 4 + ki - 128) * NPJ; load16bf(rowp + C_AK + g * 64 + pt * 16, xk); load16bf(rowp + C_AV + g * 64 + pt * 16, xv); }
               qk_norm_rope16(xk, pt, p.knw, rope + (size_t)(SEQ + (ki < 132 ? ki - 128 : 0)) * 8); }
        kv_to_lds(lds, ki, pt, xk, xv);
        if (ki >= 4 && ki < 132) { const size_t o = ((size_t)(b * 128 + ki - 4) * 2 + g) * 64 + pt * 16; store16f(p.out + O_KWS + o, xk); store16f(p.out + O_VWS + o, xv); }
    }
    __syncthreads();
    if (wid == 0) { const int t = r >> 2, hqa = g * 4 + (r & 3); attn_q_tile(p, lds, NTP + b * 4 + t, SEQ + t, hqa, t, 0, 0); }
}

constexpr int TSTR = 272;
constexpr int ML_R1 = 0, ML_R2 = 144 * TSTR, ML_R3 = ML_R2 + 128 * TSTR, ML_AS = ML_R3 + 144 * TSTR, ML_CW = ML_AS + 512, ML_END = ML_CW + 5 * 256 * 4;
static_assert(ML_END <= LDS_BYTES, "lds");

DI void stage_conv_w(const Params& p, LAS uchar* lds, int h) {
    LAS float* cw = (LAS float*)(lds + ML_CW);
    for (int i = threadIdx.x; i < 1280; i += 512) { const int j = i >> 8, lc = i & 255, ch = (lc < 128 ? 0 : 512) + h * 128 + (lc & 127);
        cw[i] = j < 4 ? p.conv_w[j * 1024 + ch] : p.conv_b[ch]; }
}
DI void conv8_prompt(const bf16_t* proj, LAS uchar* lds, int b, int t, int lc0, int col0, float (&y)[8]) {
    const LAS float* cw = (const LAS float*)(lds + ML_CW);
#pragma unroll
    for (int e = 0; e < 8; ++e) y[e] = cw[4 * 256 + lc0 + e];
#pragma unroll
    for (int j = 0; j < 4; ++j) { const int tt = t - 3 + j;
        if (tt >= 0) { float x[8]; unpack8(*(const u32x4*)(proj + (size_t)(b * SEQ + tt) * NPJ + col0), x);
#pragma unroll
            for (int e = 0; e < 8; ++e) y[e] += cw[j * 256 + lc0 + e] * x[e]; } }
#pragma unroll
    for (int e = 0; e < 8; ++e) y[e] = silu(y[e]);
}

DI void mlstm_u_item(const Params& p, LAS uchar* lds, int item) {
    const int tid = threadIdx.x, wid = tid >> 6, lane = tid & 63, r = lane & 15, quad = lane >> 4;
    const int c = item & 63, bh = item >> 6, b = bh >> 2, h = bh & 3;
    const bf16_t* proj = (const bf16_t*)(p.ws + WS_PROJ); const float* gates = (const float*)(p.ws + WS_GATES); const float2* FM = (const float2*)(p.ws + WS_FM) + (size_t)bh * SEQ;
    __syncthreads();
    stage_conv_w(p, lds, h);
    __syncthreads();
    { const int s = tid >> 2, pt = tid & 3, t = c * CH + s; const float2 fe = FM[c * CH + CH - 1], fs = FM[t];
      const float wk = __expf(fe.x - fs.x + gates[(size_t)(b * SEQ + t) * 8 + h] - fe.y) * 0.08838834764831845f;
#pragma unroll
      for (int dd = 0; dd < 4; ++dd) { const int dl = pt * 32 + dd * 8; float y[8]; conv8_prompt(proj, lds, b, t, 128 + dl, C_MK + h * 128 + dl, y);
#pragma unroll
          for (int e = 0; e < 8; ++e) *(LAS bf16_t*)(lds + ML_R2 + (dl + e) * TSTR + s * 2) = f2bf(y[e] * wk);
          const u32x4 vw = *(const u32x4*)(proj + (size_t)(b * SEQ + t) * NPJ + C_MV + h * 128 + dl);
          const unsigned vv[4] = {vw.x, vw.y, vw.z, vw.w};
#pragma unroll
          for (int e = 0; e < 4; ++e) { *(LAS bf16_t*)(lds + ML_R3 + (dl + 2 * e) * TSTR + s * 2) = (bf16_t)(vv[e] & 0xffffu); *(LAS bf16_t*)(lds + ML_R3 + (dl + 2 * e + 1) * TSTR + s * 2) = (bf16_t)(vv[e] >> 16); } }
      if (tid < 128) {
#pragma unroll
          for (int rr = 0; rr < 16; ++rr) *(LAS bf16_t*)(lds + ML_R3 + (128 + rr) * TSTR + tid * 2) = rr == 0 ? (bf16_t)0x3F80 : (bf16_t)0; } }
    __syncthreads();
    f32x4 acc[9];
#pragma unroll
    for (int mt = 0; mt < 9; ++mt) acc[mt] = (f32x4){0.f, 0.f, 0.f, 0.f};
#pragma unroll
    for (int ks = 0; ks < 4; ++ks) { const bf16x8 bk = *(const LAS bf16x8*)(lds + ML_R2 + (16 * wid + r) * TSTR + ks * 64 + quad * 16);
#pragma unroll
        for (int mt = 0; mt < 9; ++mt) { const bf16x8 av = *(const LAS bf16x8*)(lds + ML_R3 + (16 * mt + r) * TSTR + ks * 64 + quad * 16); acc[mt] = mfma16(av, bk, acc[mt]); } }
    float* U = (float*)(p.ws + WS_UST) + (size_t)item * USZ;
#pragma unroll
    for (int mt = 0; mt < 9; ++mt)
#pragma unroll
        for (int v = 0; v < 4; ++v) { const int dv = 16 * mt + 4 * quad + v; if (dv <= 128) U[dv * 128 + 16 * wid + r] = acc[mt][v]; }
}

DI void mlstm_scan(const Params& p) {
    const int tid = threadIdx.x, nb = gridDim.x, bid = blockIdx.x;
    float* UST = (float*)(p.ws + WS_UST);
    for (int e = bid * 512 + tid; e < 8 * USZ; e += nb * 512) { const int bh = e / USZ, idx = e - bh * USZ;
        const float2* FM = (const float2*)(p.ws + WS_FM) + (size_t)bh * SEQ; float* U = UST + (size_t)bh * NCH * USZ + idx;
        float S = 0.f; float2 prev = make_float2(0.f, 0.f);
        for (int c0 = 0; c0 < NCH; c0 += 8) { float u[8];
#pragma unroll
            for (int j = 0; j < 8; ++j) u[j] = U[(size_t)(c0 + j) * USZ];
#pragma unroll
            for (int j = 0; j < 8; ++j) { const float2 fe = FM[(c0 + j) * CH + CH - 1]; const float d = __expf(fe.x - prev.x + prev.y - fe.y);
                U[(size_t)(c0 + j) * USZ] = S; S = d * S + u[j]; prev = fe; } }
        if (idx < 16384) { const int dv = idx >> 7, dk = idx & 127; p.out[O_CP + (size_t)bh * 16384 + dk * 128 + dv] = S; } else p.out[O_NP + bh * 128 + idx - 16384] = S;
        if (idx == 0) p.out[O_MP + bh] = prev.y;
    }
}

DI void mlstm_out_item(const Params& p, LAS uchar* lds, int item) {
    const int tid = threadIdx.x, wid = tid >> 6, lane = tid & 63, r = lane & 15, quad = lane >> 4;
    const int c = item & 63, bh = item >> 6, b = bh >> 2, h = bh & 3;
    const bf16_t* proj = (const bf16_t*)(p.ws + WS_PROJ); const float* gates = (const float*)(p.ws + WS_GATES); const float2* FM = (const float2*)(p.ws + WS_FM) + (size_t)bh * SEQ;
    __syncthreads();
    stage_conv_w(p, lds, h);
    if (tid < 128) { const int t = c * CH + tid; ((LAS float*)(lds + ML_AS))[tid] = gates[(size_t)(b * SEQ + t) * 8 + h] - FM[t].x; }
    __syncthreads();
    { const int s = tid >> 2, pt = tid & 3, t = c * CH + s;
#pragma unroll
      for (int dd = 0; dd < 4; ++dd) { const int dl = pt * 32 + dd * 8; float y[8];
          conv8_prompt(proj, lds, b, t, dl, C_MQ + h * 128 + dl, y); *(LAS u32x4*)(lds + ML_R1 + s * TSTR + dl * 2) = pack8(y);
          conv8_prompt(proj, lds, b, t, 128 + dl, C_MK + h * 128 + dl, y);
#pragma unroll
          for (int e = 0; e < 8; ++e) y[e] *= 0.08838834764831845f;
          *(LAS u32x4*)(lds + ML_R2 + s * TSTR + dl * 2) = pack8(y);
          const u32x4 vw = *(const u32x4*)(proj + (size_t)(b * SEQ + t) * NPJ + C_MV + h * 128 + dl);
          const unsigned vv[4] = {vw.x, vw.y, vw.z, vw.w};
#pragma unroll
          for (int e = 0; e < 4; ++e) { *(LAS bf16_t*)(lds + ML_R3 + (dl + 2 * e) * TSTR + s * 2) = (bf16_t)(vv[e] & 0xffffu); *(LAS bf16_t*)(lds + ML_R3 + (dl + 2 * e + 1) * TSTR + s * 2) = (bf16_t)(vv[e] >> 16); } }
      if (tid < 128) {
#pragma unroll
          for (int rr = 0; rr < 16; ++rr) *(LAS bf16_t*)(lds + ML_R3 + (128 + rr) * TSTR + tid * 2) = rr == 0 ? (bf16_t)0x3F80 : (bf16_t)0; } }
    __syncthreads();
    bf16x8 qf[4];
#pragma unroll
    for (int ks = 0; ks < 4; ++ks) qf[ks] = *(const LAS bf16x8*)(lds + ML_R1 + (16 * wid + r) * TSTR + ks * 64 + quad * 16);
    __syncthreads();
    { const float* St = (const float*)(p.ws + WS_UST) + (size_t)item * USZ;
      for (int u = tid; u < 144 * 16; u += 512) { const int dv = u >> 4, d8 = (u & 15) * 8; float f[8];
#pragma unroll
          for (int e = 0; e < 8; ++e) f[e] = 0.f;
          if (dv <= 128) { const float4 a = *(const float4*)(St + dv * 128 + d8), bb = *(const float4*)(St + dv * 128 + d8 + 4); f[0] = a.x; f[1] = a.y; f[2] = a.z; f[3] = a.w; f[4] = bb.x; f[5] = bb.y; f[6] = bb.z; f[7] = bb.w; }
          *(LAS u32x4*)(lds + ML_R1 + dv * TSTR + d8 * 2) = pack8(f); } }
    __syncthreads();
    const int ti = 16 * wid + r, t = c * CH + ti; const float2 ft = FM[t]; float2 f0 = make_float2(0.f, 0.f); if (c > 0) f0 = FM[c * CH - 1];
    const float winter = __expf(ft.x - f0.x + f0.y - ft.y), bt = ft.x - ft.y;
    f32x4 acc[9];
#pragma unroll
    for (int mt = 0; mt < 9; ++mt) acc[mt] = (f32x4){0.f, 0.f, 0.f, 0.f};
#pragma unroll
    for (int ks = 0; ks < 4; ++ks)
#pragma unroll
        for (int mt = 0; mt < 9; ++mt) { const bf16x8 a = *(const LAS bf16x8*)(lds + ML_R1 + (16 * mt + r) * TSTR + ks * 64 + quad * 16); acc[mt] = mfma16(a, qf[ks], acc[mt]); }
#pragma unroll
    for (int mt = 0; mt < 9; ++mt) acc[mt] *= winter;
    const LAS float* as = (const LAS float*)(lds + ML_AS);
    for (int sp = 0; sp <= (wid >> 1); ++sp) {
        u32x4 pw;
#pragma unroll
        for (int half = 0; half < 2; ++half) { const int st = 2 * sp + half; f32x4 c4 = {0.f, 0.f, 0.f, 0.f};
            if (st <= wid) {
#pragma unroll
                for (int ks = 0; ks < 4; ++ks) { const bf16x8 a = *(const LAS bf16x8*)(lds + ML_R2 + (16 * st + r) * TSTR + ks * 64 + quad * 16); c4 = mfma16(a, qf[ks], c4); }
                const f32x4 av = *(const LAS f32x4*)(as + 16 * st + 4 * quad);
#pragma unroll
                for (int v = 0; v < 4; ++v) { const int si = 16 * st + 4 * quad + v; c4[v] = (si <= ti) ? c4[v] * __expf(bt + av[v]) : 0.f; } }
            if (half == 0) { pw.x = pk2(c4[0], c4[1]); pw.y = pk2(c4[2], c4[3]); } else { pw.z = pk2(c4[0], c4[1]); pw.w = pk2(c4[2], c4[3]); } }
        const bf16x8 pb = __builtin_bit_cast(bf16x8, pw);
#pragma unroll
        for (int mt = 0; mt < 9; ++mt) { const LAS uchar* vp = lds + ML_R3 + (16 * mt + r) * TSTR + (32 * sp + 4 * quad) * 2;
            u32x4 aw; const u32x2 lo = *(const LAS u32x2*)vp, hi = *(const LAS u32x2*)(vp + 32); aw.x = lo.x; aw.y = lo.y; aw.z = hi.x; aw.w = hi.y;
            acc[mt] = mfma16(__builtin_bit_cast(bf16x8, aw), pb, acc[mt]); } }
    const float den = __shfl(acc[8][0], r);
    const float inv = 1.0f / fmaxf(fabsf(den), __expf(-ft.y));
    float ss = 0.f;
#pragma unroll
    for (int mt = 0; mt < 8; ++mt)
#pragma unroll
        for (int v = 0; v < 4; ++v) { acc[mt][v] *= inv; ss += acc[mt][v] * acc[mt][v]; }
    ss += __shfl_xor(ss, 16); ss += __shfl_xor(ss, 32);
    const float rstd = rsqrtf(ss * (1.0f / 128) + 1e-6f);
    const bf16_t* rowp = proj + (size_t)(b * SEQ + t) * NPJ; bf16_t* mixed = (bf16_t*)(p.ws + WS_MIXED) + (size_t)(b * SEQ + t) * DM + 512 + h * 128;
#pragma unroll
    for (int mt = 0; mt < 8; ++mt) { const int dv = 16 * mt + 4 * quad; const u32x2 ow = *(const u32x2*)(rowp + C_MO + h * 128 + dv), zw = *(const u32x2*)(rowp + C_MZ + h * 128 + dv);
        const float4 nw = *(const float4*)(p.mhw + h * 128 + dv);
        const float y0 = acc[mt][0] * rstd * nw.x * sigm(bflo(ow.x)), y1 = acc[mt][1] * rstd * nw.y * sigm(bfhi(ow.x)), y2 = acc[mt][2] * rstd * nw.z * sigm(bflo(ow.y)), y3 = acc[mt][3] * rstd * nw.w * sigm(bfhi(ow.y));
        u32x2 w; w.x = pk2(y0 * silu(bflo(zw.x)), y1 * silu(bfhi(zw.x))); w.y = pk2(y2 * silu(bflo(zw.y)), y3 * silu(bfhi(zw.y)));
        *(u32x2*)(mixed + dv) = w; }
}

DI void mlstm_sample_item(const Params& p, LAS uchar* lds, int item) {
    const int tid = threadIdx.x, wid = tid >> 6, lane = tid & 63;
    const int h = item & 3, b = item >> 2;
    const bf16_t* proj = (const bf16_t*)(p.ws + WS_PROJ); const float* gates = (const float*)(p.ws + WS_GATES);
    LAS float* qs = (LAS float*)lds;
    LAS float* ks = qs + 512;
    LAS float* vs = ks + 512;
    LAS float* red = vs + 512;
    LAS float* dred = red + 2048;
    LAS float* sred = dred + 8;
    __syncthreads();
    for (int i = tid; i < 1024; i += 512) { const int t = i >> 8, lc = i & 255, ch = (lc < 128 ? 0 : 512) + h * 128 + (lc & 127);
        float y = p.conv_b[ch];
#pragma unroll
        for (int j = 0; j < 4; ++j) { const int tt = t - 3 + j; float x;
            if (tt < 0) x = p.sconv[(size_t)(b * 3 + 3 + tt) * 1024 + ch];
            else { x = __uint_as_float((unsigned)proj[(size_t)(NTP + b * 4 + tt) * NPJ + C_MQ + ch] << 16); if (j == 3 && t >= 1) p.out[O_CONVS + (size_t)(b * 3 + t - 1) * 1024 + ch] = x; }
            y += p.conv_w[j * 1024 + ch] * x; }
        y = silu(y);
        if (lc < 128) qs[t * 128 + lc] = y; else ks[t * 128 + (lc - 128)] = y * 0.08838834764831845f; }
    { const int t = tid >> 7, dv = tid & 127; vs[tid] = __uint_as_float((unsigned)proj[(size_t)(NTP + b * 4 + t) * NPJ + C_MV + h * 128 + dv] << 16); }
    float mt_[4], fd[4], iw[4];
    { float mprev = p.sm[b * 4 + h];
#pragma unroll
      for (int t = 0; t < 4; ++t) { const float* g = gates + (size_t)(NTP + b * 4 + t) * 8; const float li = g[h], lf = g[4 + h];
          const float m = fmaxf(lf + mprev, li); fd[t] = __expf(lf + mprev - m); iw[t] = __expf(li - m); mt_[t] = m; mprev = m; } }
    const int dv = tid & 127, dkq = tid >> 7;
    const float* S0 = p.sC + ((size_t)(b * 4 + h) * 128 + dkq * 32) * 128 + dv;
    float S[32];
#pragma unroll
    for (int i = 0; i < 32; ++i) S[i] = S0[(size_t)i * 128];
    float nn = 0.f; if (tid < 128) nn = p.sn[(size_t)(b * 4 + h) * 128 + tid];
    __syncthreads();
#pragma unroll
    for (int t = 0; t < 4; ++t) { const float vt = vs[t * 128 + dv] * iw[t]; float part = 0.f;
#pragma unroll
        for (int i = 0; i < 32; ++i) { const int dk = dkq * 32 + i; S[i] = fd[t] * S[i] + ks[t * 128 + dk] * vt; part += qs[t * 128 + dk] * S[i]; }
        red[(dkq * 4 + t) * 128 + dv] = part;
        if (tid < 128) { nn = fd[t] * nn + iw[t] * ks[t * 128 + tid]; const float dp = wsum(qs[t * 128 + tid] * nn); if (lane == 0) dred[t * 2 + wid] = dp; } }
    float* Sout = p.out + O_CS + ((size_t)(b * 4 + h) * 128 + dkq * 32) * 128 + dv;
#pragma unroll
    for (int i = 0; i < 32; ++i) Sout[(size_t)i * 128] = S[i];
    if (tid < 128) p.out[O_NS + (size_t)(b * 4 + h) * 128 + tid] = nn;
    if (tid == 0) p.out[O_MS + b * 4 + h] = mt_[3];
    __syncthreads();
    { const int t = tid >> 7; const float num = red[(0 * 4 + t) * 128 + dv] + red[(1 * 4 + t) * 128 + dv] + red[(2 * 4 + t) * 128 + dv] + red[(3 * 4 + t) * 128 + dv];
      const float den = dred[t * 2] + dred[t * 2 + 1];
      const float mtv = t == 0 ? mt_[0] : t == 1 ? mt_[1] : t == 2 ? mt_[2] : mt_[3];
      const float hv = num / fmaxf(fabsf(den), __expf(-mtv));
      const float sq = wsum(hv * hv); if (lane == 0) sred[t * 2 + (wid & 1)] = sq;
      __syncthreads();
      const float rstd = rsqrtf((sred[t * 2] + sred[t * 2 + 1]) * (1.0f / 128) + 1e-6f);
      const size_t row = (size_t)(NTP + b * 4 + t); const bf16_t* rowp = proj + row * NPJ;
      const float og = sigm(__uint_as_float((unsigned)rowp[C_MO + h * 128 + dv] << 16)), zg = silu(__uint_as_float((unsigned)rowp[C_MZ + h * 128 + dv] << 16));
      ((bf16_t*)(p.ws + WS_MIXED))[row * DM + 512 + h * 128 + dv] = f2bf(hv * rstd * p.mhw[h * 128 + dv] * og * zg); }
}

DI void phase2(const Params& p, LAS uchar* lds) {
    const int nb = gridDim.x, bid = blockIdx.x, tid = threadIdx.x;
    for (int it = bid; it < 256; it += nb) attn_prompt_item(p, lds, it);
    for (int it = bid; it < 512; it += nb) mlstm_u_item(p, lds, it);
    for (int it = bid; it < 256; it += nb) attn_sample_item(p, lds, it);
    for (int it = bid; it < 512; it += nb) mlstm_sample_item(p, lds, it);
    for (int i = bid * 512 + tid; i < 6144; i += nb * 512) { const int ch = i & 1023, rr = (i >> 10) % 3, b = i / 3072;
        p.out[O_CONVP + i] = __uint_as_float((unsigned)((const bf16_t*)(p.ws + WS_PROJ))[(size_t)(b * SEQ + SEQ - 3 + rr) * NPJ + C_MQ + ch] << 16); }
}
DI void phase4(const Params& p, LAS uchar* lds) {
    const int nb = gridDim.x, bid = blockIdx.x;
    for (int it = bid; it < 512; it += nb) mlstm_out_item(p, lds, it);
}

__global__ __launch_bounds__(512, 2) void hymba_mega(Params p, int ph_lo, int ph_hi) {
    extern __shared__ __attribute__((aligned(16))) unsigned char shm[];
    LAS uchar* lds = (LAS uchar*)shm;
#define RUNPH(n, call) if (ph_lo <= n && n < ph_hi) { if (ph_lo < n) cg::this_grid().sync(); call; }
    RUNPH(0, phase0(p, lds)) RUNPH(1, phase1(p, lds)) RUNPH(2, phase2(p, lds)) RUNPH(3, mlstm_scan(p)) RUNPH(4, phase4(p, lds)) RUNPH(5, phase5(p, lds))
}

#ifndef N_LAUNCHES
#define N_LAUNCHES 6
#endif
extern "C" void kernel_launch(void* const* d_in, const int* in_sizes, int n_in, void* d_out, int out_size, void* d_ws, size_t ws_size, hipStream_t stream) {
    static int grid = 0;
    if (grid == 0) {
        int dev = 0, cus = 0, per_cu = 0;
        hipGetDevice(&dev); hipDeviceGetAttribute(&cus, hipDeviceAttributeMultiprocessorCount, dev);
        if (hipFuncSetAttribute((const void*)hymba_mega, hipFuncAttributeMaxDynamicSharedMemorySize, LDS_BYTES) != hipSuccess) { fprintf(stderr, "hipFuncSetAttribute failed\n"); }
        if (hipOccupancyMaxActiveBlocksPerMultiprocessor(&per_cu, (const void*)hymba_mega, 512, LDS_BYTES) != hipSuccess || per_cu < 1) { fprintf(stderr, "occupancy query: %d\n", per_cu); per_cu = 1; }
        (void)hipGetLastError();
        grid = cus * per_cu;
        if (ws_size < WS_END || n_in != 18) { fprintf(stderr, "bad ws/n_in\n"); grid = -1; }
    }
    if (grid < 0) return;
    Params p{};
    p.x_p = (const float*)d_in[0]; p.x_s = (const float*)d_in[1]; p.ck = (const float*)d_in[2]; p.cv = (const float*)d_in[3]; p.sconv = (const float*)d_in[4];
    p.sC = (const float*)d_in[5]; p.sn = (const float*)d_in[6]; p.sm = (const float*)d_in[7]; p.norm_w = (const float*)d_in[8]; p.w_in = (const float*)d_in[9];
    p.b_gates = (const float*)d_in[10]; p.conv_w = (const float*)d_in[11]; p.conv_b = (const float*)d_in[12]; p.qnw = (const float*)d_in[13]; p.knw = (const float*)d_in[14];
    p.sinks = (const float*)d_in[15]; p.mhw = (const float*)d_in[16]; p.w_out = (const float*)d_in[17];
    p.out = (float*)d_out; p.ws = (uchar*)d_ws;
    if (N_LAUNCHES == 1) {
        int lo = 0, hi = 6; void* args[] = {&p, &lo, &hi};
        hipError_t e = hipLaunchCooperativeKernel((const void*)hymba_mega, dim3(grid), dim3(512), args, LDS_BYTES, stream);
        if (e != hipSuccess) fprintf(stderr, "cooperative launch failed: %s (grid %d)\n", hipGetErrorString(e), grid);
    } else {
        for (int ph = 0; ph < 6; ++ph) hipLaunchKernelGGL(hymba_mega, dim3(grid), dim3(512), LDS_BYTES, stream, p, ph, ph + 1);
    }
}
```

```cpp
#define N_LAUNCHES 1
#include <hip/hip_runtime.h>
#include <hip/hip_cooperative_groups.h>
#include <cstdio>
namespace cg = cooperative_groups;
#define LAS __attribute__((address_space(3)))
namespace pg8 {
#define PG8_LAS __attribute__((address_space(3)))
typedef unsigned short bf16_t;
typedef short bf16x8 __attribute__((ext_vector_type(8)));
typedef float f32x4 __attribute__((ext_vector_type(4)));
typedef unsigned u32x4 __attribute__((ext_vector_type(4)));
constexpr int BM = 256, BK = 64, HALF = 128, HTB = HALF * BK * 2  , STAGE_BYTES = 8 * HTB, NXCD = 8, WGM = 8;

__host__ __device__ __forceinline__ int lds_byte(int r, int c) { const int st = (r >> 4) * 2 + (c >> 5), rr = r & 15, cc = c & 31, ob = rr * 64 + cc * 2; return st * 1024 + (ob ^ (((ob >> 9) & 1) << 5)); }
__host__ __device__ __forceinline__ void stage_rc(int b, int& R, int& C) { const int st = b / 1024, sb = b % 1024, swz = sb ^ (((sb >> 9) & 1) << 5); R = (st >> 1) * 16 + swz / 64; C = (st & 1) * 32 + (swz % 64) / 2; }
__host__ __device__ __forceinline__ int perm32(int rho) { const int n = rho >> 4, i = rho & 15; return 8 * (i >> 2) + 4 * n + (i & 3); }

struct Unit { int pm, pn; };
struct Gemm { const bf16_t* A; const bf16_t* Bt; int M, N, K; };

struct StaticOrder {
    int nM, nN, nwg, G, c;
    __host__ __device__ void init(int M, int N, int G_, int c_) { nM = M / BM; nN = N / BM; nwg = nM * nN; G = G_; c = c_; }
    __host__ __device__ bool next(int i, Unit& u) const {
        const long L = (long)i * G + c; if (L >= nwg) return false;
        int wgid = (int)L; { const int q = nwg / NXCD, r = nwg % NXCD, xcd = wgid % NXCD, off = wgid / NXCD; wgid = (xcd < r ? xcd * (q + 1) : r * (q + 1) + (xcd - r) * q) + off; }
        const int nig = WGM * nN, gid = wgid / nig, fm = gid * WGM, gsz = (nM - fm) < WGM ? (nM - fm) : WGM;
        u.pm = fm + ((wgid % nig) % gsz); u.pn = (wgid % nig) / gsz; return true;
    }
    __device__ __forceinline__ void a_ready(const Unit&) const {}
    __device__ __forceinline__ void done(const Unit&) const {}
};
__device__ __forceinline__ unsigned cvt_pk_bf16(float lo, float hi) { unsigned r; asm volatile("v_cvt_pk_bf16_f32 %0, %1, %2" : "=v"(r) : "v"(lo), "v"(hi)); return r; }
template <class Epi, class Sched, bool STAMP = false>
__device__ __forceinline__ void gemm_phase(PG8_LAS unsigned char* lds, const Gemm g, const Sched& S, const Epi& E, unsigned long long* stamps) {
    const int tid = threadIdx.x, wid = __builtin_amdgcn_readfirstlane(tid >> 6), lane = tid & 63, wr = wid >> 2, wc = wid & 3, fr = lane & 15, fq = lane >> 4;
    const int K = g.K, nt = K / BK;
    int ts_lo = 0, ts_hi = 0, nts = 0; const unsigned long long rt_entry = STAMP ? (unsigned long long)wall_clock64() : 0ull;
#define PG8_STAMP() do { if (STAMP && wid == 0 && nts < 64) { const unsigned long long _c = (unsigned long long)clock64(); \
        ts_lo = (lane == nts) ? (int)(unsigned)_c : ts_lo; ts_hi = (lane == nts) ? (int)(unsigned)(_c >> 32) : ts_hi; ++nts; } } while (0)
    PG8_STAMP();
    unsigned voffA[2], voffB[2];
#pragma unroll
    for (int i = 0; i < 2; ++i) { int R, C; stage_rc(tid * 16 + i * 8192, R, C); const int Rb = Epi::PERM ? ((R & ~31) + perm32(R & 31)) : R;
        voffA[i] = (unsigned)(R * K + C) * 2u; voffB[i] = (unsigned)(Rb * K + C) * 2u; }
    const size_t kstep = (size_t)(BK * 2);
    const size_t hstep = (size_t)HALF * K * 2;
    const size_t tstep = 2 * hstep;
    const unsigned ldsw = (unsigned)wid * 1024u;
    const int aoff = lds_byte(wr * 64 + fr, fq * 8), boff = lds_byte(wc * 32 + fr, fq * 8);
#define PG8_SA(b, h) (((b) * 2 + (h)) * HTB)
#define PG8_SB(b, h) ((4 + (b) * 2 + (h)) * HTB)
#define PG8_STAGE(bufoff, gbase, voff) do { _Pragma("unroll") for (int _i = 0; _i < 2; ++_i) \
        __builtin_amdgcn_global_load_lds((const unsigned*)((const char*)(gbase) + (voff)[_i]), (PG8_LAS unsigned*)(lds + (bufoff) + ldsw + _i * 8192), 16, 0, 0); } while (0)
#define PG8_LDA(dst, b, h) do { _Pragma("unroll") for (int m = 0; m < 4; ++m) _Pragma("unroll") for (int k = 0; k < 2; ++k) dst[m][k] = *(const PG8_LAS bf16x8*)(lds + PG8_SA(b, h) + aoff + m * 2048 + k * 1024); } while (0)
#define PG8_LDB(dst, b, h) do { _Pragma("unroll") for (int n = 0; n < 2; ++n) _Pragma("unroll") for (int k = 0; k < 2; ++k) dst[n][k] = *(const PG8_LAS bf16x8*)(lds + PG8_SB(b, h) + boff + n * 2048 + k * 1024); } while (0)
#define PG8_MMA(ai, bj, At, Bt) do { __builtin_amdgcn_s_setprio(1); _Pragma("unroll") for (int m = 0; m < 4; ++m) _Pragma("unroll") for (int n = 0; n < 2; ++n) _Pragma("unroll") for (int k = 0; k < 2; ++k) \
        acc[ai][bj][m][n] = __builtin_amdgcn_mfma_f32_16x16x32_bf16(Bt[n][k], At[m][k], acc[ai][bj][m][n], 0, 0, 0); __builtin_amdgcn_s_setprio(0); } while (0)
#define PG8_WAIT_V(n) asm volatile("s_waitcnt vmcnt(" #n ")" ::: "memory")
#define PG8_WAIT_L(n) asm volatile("s_waitcnt lgkmcnt(" #n ")" ::: "memory")
#define PG8_BAR __builtin_amdgcn_s_barrier()
#define PG8_SCHED __builtin_amdgcn_sched_barrier(0)
    Unit cur, nxt; int ui = 0;
    if (!S.next(0, cur)) return;
    f32x4 acc[2][2][4][2];
#pragma unroll
    for (int a = 0; a < 2; ++a)
#pragma unroll
        for (int b = 0; b < 2; ++b)
#pragma unroll
            for (int m = 0; m < 4; ++m)
#pragma unroll
                for (int n = 0; n < 2; ++n) acc[a][b][m][n] = (f32x4){0.f, 0.f, 0.f, 0.f};
    bf16x8 At[4][2], B0[2][2], B1[2][2];
    const char* cA = (const char*)g.A + (size_t)cur.pm * tstep; const char* cB = (const char*)g.Bt + (size_t)cur.pn * tstep;
    S.a_ready(cur);
    PG8_STAGE(PG8_SB(0, 0), cB, voffB); PG8_STAGE(PG8_SA(0, 0), cA, voffA); PG8_STAGE(PG8_SB(0, 1), cB + hstep, voffB); PG8_STAGE(PG8_SA(0, 1), cA + hstep, voffA);
    if (wr == 1) PG8_BAR;
    PG8_WAIT_V(4); PG8_BAR;
    PG8_STAGE(PG8_SB(1, 0), cB + kstep, voffB); PG8_STAGE(PG8_SA(1, 0), cA + kstep, voffA); PG8_STAGE(PG8_SB(1, 1), cB + hstep + kstep, voffB);
    PG8_WAIT_V(6); PG8_BAR;
    PG8_STAMP();
    for (;;) {
        const bool has_next = S.next(ui + 1, nxt);
        const char* nA = has_next ? (const char*)g.A + (size_t)nxt.pm * tstep : cA; const char* nB = has_next ? (const char*)g.Bt + (size_t)nxt.pn * tstep : cB;
        for (int t = 0; t < nt; t += 2) {
            const bool last = (t == nt - 2);
            const char* a1 = cA + (size_t)(t + 1) * kstep;
            const char* a2 = last ? nA : cA + (size_t)(t + 2) * kstep; const char* b2 = last ? nB : cB + (size_t)(t + 2) * kstep;
            const char* a3 = a2 + kstep; const char* b3 = b2 + kstep;
            if (last && has_next) S.a_ready(nxt);
            PG8_LDB(B0, 0, 0); PG8_SCHED; PG8_LDA(At, 0, 0); PG8_STAGE(PG8_SA(1, 1), a1 + hstep, voffA);
            PG8_WAIT_L(8); PG8_BAR; PG8_WAIT_L(0); PG8_MMA(0, 0, At, B0); PG8_BAR; PG8_SCHED;
            PG8_LDB(B1, 0, 1); PG8_STAGE(PG8_SB(0, 0), b2, voffB);
            PG8_BAR; PG8_WAIT_L(0); PG8_MMA(0, 1, At, B1); PG8_BAR;
            PG8_LDA(At, 0, 1); PG8_STAGE(PG8_SA(0, 0), a2, voffA);
            PG8_BAR; PG8_WAIT_L(0); PG8_MMA(1, 0, At, B0); PG8_BAR; PG8_SCHED;
            PG8_STAGE(PG8_SB(0, 1), b2 + hstep, voffB);
            PG8_WAIT_V(6); PG8_BAR; PG8_MMA(1, 1, At, B1); PG8_BAR;
            PG8_LDB(B0, 1, 0); PG8_SCHED; PG8_LDA(At, 1, 0); PG8_STAGE(PG8_SA(0, 1), a2 + hstep, voffA);
            PG8_WAIT_L(8); PG8_BAR; PG8_WAIT_L(0); PG8_MMA(0, 0, At, B0); PG8_BAR; PG8_SCHED;
            PG8_LDB(B1, 1, 1); PG8_STAGE(PG8_SB(1, 0), b3, voffB);
            PG8_BAR; PG8_WAIT_L(0); PG8_MMA(0, 1, At, B1); PG8_BAR;
            PG8_LDA(At, 1, 1); PG8_STAGE(PG8_SA(1, 0), a3, voffA);
            PG8_BAR; PG8_WAIT_L(0); PG8_MMA(1, 0, At, B0); PG8_BAR; PG8_SCHED;
            PG8_STAGE(PG8_SB(1, 1), b3 + hstep, voffB);
            PG8_WAIT_V(6); PG8_BAR; PG8_MMA(1, 1, At, B1); PG8_BAR;
        }
        PG8_STAMP();
        if constexpr (!Epi::AFTER_DRAIN) { E(acc, cur, wr, wc, fr, fq); S.done(cur); }
        PG8_STAMP();
        if (!has_next) break;
#pragma unroll
        for (int a = 0; a < 2; ++a)
#pragma unroll
            for (int b = 0; b < 2; ++b)
#pragma unroll
                for (int m = 0; m < 4; ++m)
#pragma unroll
                    for (int n = 0; n < 2; ++n) acc[a][b][m][n] = (f32x4){0.f, 0.f, 0.f, 0.f};
        cur = nxt; cA = nA; cB = nB; ++ui;
    }
    PG8_WAIT_V(0);
    if (wr == 0) PG8_BAR;
    PG8_BAR;
    if constexpr (Epi::AFTER_DRAIN) { E.fused(acc, cur, wr, wc, fr, fq, lds, wid, lane); S.done(cur); }
    PG8_STAMP();
    if (STAMP && wid == 0) { stamps[lane] = lane < nts ? (((unsigned long long)(unsigned)ts_hi << 32) | (unsigned)ts_lo) : 0ull;
        if (lane == 62) stamps[62] = rt_entry; if (lane == 63) stamps[63] = (unsigned long long)wall_clock64(); }
#undef PG8_STAMP
#undef PG8_SA
#undef PG8_SB
#undef PG8_STAGE
#undef PG8_LDA
#undef PG8_LDB
#undef PG8_MMA
#undef PG8_WAIT_V
#undef PG8_WAIT_L
#undef PG8_BAR
#undef PG8_SCHED
}
}

#define XB_TMO      128
#define XB_XCNT(j)  (256  + 64 * (j))
#define XB_XSUB(j)  (1280 + 64 * (j))
#define XB_XGEN(j)  (2304 + 64 * (j))
#define XB_TOP      3328
#define XB_TOPGEN   3392
#define XCD_BAR_WORDS 3456
#define XB_SPIN_CAP (1u << 18)

__device__ __forceinline__ unsigned xb_ld(unsigned* p)              { return __hip_atomic_load(p, __ATOMIC_RELAXED, __HIP_MEMORY_SCOPE_AGENT); }
__device__ __forceinline__ unsigned xb_add(unsigned* p, unsigned v) { return __hip_atomic_fetch_add(p, v, __ATOMIC_RELAXED, __HIP_MEMORY_SCOPE_AGENT); }
__device__ __forceinline__ unsigned xb_xcc_id() { return (unsigned)__builtin_amdgcn_s_getreg((3 << 11) | 20) & 0xFu; }
#define XB_SPIN(cond, bar) do { unsigned _sp = 0; while (cond) { __builtin_amdgcn_s_sleep(1); \
    if ((++_sp & 255u) == 0u) { if (xb_ld(&(bar)[XB_TMO])) break; if (_sp > XB_SPIN_CAP) { atomicAdd(&(bar)[XB_TMO], 1u); break; } } } } while (0)

struct XcdBarrier {
    unsigned* bar; unsigned x;
    volatile LAS unsigned* st;
};

__device__ __forceinline__ XcdBarrier xcd_barrier_post(unsigned* bar, volatile LAS unsigned* st) {
    XcdBarrier b; b.bar = bar; b.x = xb_xcc_id(); b.st = st;
    if (threadIdx.x == 0) (void)xb_add(&bar[XB_XCNT(b.x)], 1u);
    return b;
}
__device__ __forceinline__ void xcd_barrier_complete(unsigned* bar, unsigned x, unsigned& nloc, unsigned& nx) {
    const unsigned G = gridDim.x * gridDim.y * gridDim.z;
    unsigned sum, cnt, mine, sp = 0u;
    for (;;) {
        sum = 0u; cnt = 0u; mine = 0u;
#pragma unroll
        for (unsigned j = 0; j < 16; ++j) { const unsigned c = xb_ld(&bar[XB_XCNT(j)]); sum += c; cnt += (c > 0u) ? 1u : 0u; mine = (j == x) ? c : mine; }
        if (sum == G) break;
        __builtin_amdgcn_s_sleep(1);
        if ((++sp & 255u) == 0u) { if (xb_ld(&bar[XB_TMO])) break; if (sp > XB_SPIN_CAP) { atomicAdd(&bar[XB_TMO], 1u); break; } }
    }
    nloc = mine > 0u ? mine : 1u; nx = cnt > 0u ? cnt : 1u;
}

__device__ __forceinline__ void xcd_barrier(const XcdBarrier& b) {
    asm volatile("s_waitcnt vmcnt(0)" ::: "memory");
    __syncthreads();
    if (threadIdx.x == 0) {
        unsigned* bar = b.bar;
        __builtin_amdgcn_s_waitcnt(0);
        unsigned nloc = b.st[0], nx = b.st[1];
        if (nloc == 0u) { xcd_barrier_complete(bar, b.x, nloc, nx); b.st[0] = nloc; b.st[1] = nx; }
        const unsigned old = xb_add(&bar[XB_XSUB(b.x)], 1u);
        const unsigned gen = old / nloc;
        if (old + 1u == (gen + 1u) * nloc) {
            __builtin_amdgcn_fence(__ATOMIC_RELEASE, "agent");
            asm volatile("s_waitcnt vmcnt(0)" ::: "memory");
            const unsigned og = xb_add(&bar[XB_TOP], 1u);
            const unsigned tg = og / nx;
            if (og + 1u == (tg + 1u) * nx) xb_add(&bar[XB_TOPGEN], 1u);
            else XB_SPIN(xb_ld(&bar[XB_TOPGEN]) == tg, bar);
            __builtin_amdgcn_fence(__ATOMIC_ACQUIRE, "agent");
            xb_add(&bar[XB_XGEN(b.x)], 1u);
            asm volatile("s_waitcnt vmcnt(0)" ::: "memory");
        } else {
            XB_SPIN(xb_ld(&bar[XB_XGEN(b.x)]) == gen, bar);
            __builtin_amdgcn_fence(__ATOMIC_ACQUIRE, "agent");
            asm volatile("s_waitcnt vmcnt(0)" ::: "memory");
        }
    }
    __syncthreads();
}

using pg8::bf16_t; using pg8::bf16x8; using pg8::f32x4; using pg8::u32x4;
#define DI __device__ __forceinline__
typedef unsigned char uchar;
typedef unsigned u32x2 __attribute__((ext_vector_type(2)));

constexpr int NTP = 16384, NTS = 512, NTOK = 16896, DM = 1024, DIN = 3848, NPJ = 3840, SEQ = 8192;
constexpr int C_AQ = 0, C_AK = 512, C_AV = 640, C_AG = 768, C_MQ = 1280, C_MK = 1792, C_MV = 2304, C_MO = 2816, C_MZ = 3328;
constexpr int NCH = 64, CH = 128, USZ = 129 * 128;
constexpr size_t O_Y = 0, O_KWP = 17301504, O_VWP = 17334272, O_CONVP = 17367040, O_CP = 17373184, O_NP = 17504256, O_MP = 17505280,
                 O_KWS = 17505288, O_VWS = 19602440, O_CONVS = 21699592, O_CS = 22092808, O_NS = 30481416, O_MS = 30546952;
constexpr size_t WS_WTIN = 0, WS_WTOUT = 7864320, WS_H = 9961472, WS_GATES = 44564480, WS_ROPE = 45105152, WS_FM = 45637632,
                 WS_PROJ = 46161920, WS_UST = 175923200, WS_MIXED = 209739776, WS_BAR = 244342784, WS_SB = 244342784 + 16384, WS_END = WS_SB + 16908288;
constexpr int LDS_MAIN = 151552, LDS_BYTES = LDS_MAIN + 16;

struct Params {
    const float *x_p, *x_s, *ck, *cv, *sconv, *sC, *sn, *sm, *norm_w, *w_in, *b_gates, *conv_w, *conv_b, *qnw, *knw, *sinks, *mhw, *w_out;
    float* out; uchar* ws;
};

DI float bflo(unsigned w) { return __uint_as_float(w << 16); }
DI float bfhi(unsigned w) { return __uint_as_float(w & 0xffff0000u); }
DI unsigned pk2(float a, float b) { return pg8::cvt_pk_bf16(a, b); }
DI bf16_t f2bf(float f) { unsigned u = __float_as_uint(f); u += 0x7fffu + ((u >> 16) & 1u); return (bf16_t)(u >> 16); }
DI void unpack8(const u32x4 w, float (&f)[8]) { f[0] = bflo(w.x); f[1] = bfhi(w.x); f[2] = bflo(w.y); f[3] = bfhi(w.y); f[4] = bflo(w.z); f[5] = bfhi(w.z); f[6] = bflo(w.w); f[7] = bfhi(w.w); }
DI u32x4 pack8(const float (&f)[8]) { u32x4 w; w.x = pk2(f[0], f[1]); w.y = pk2(f[2], f[3]); w.z = pk2(f[4], f[5]); w.w = pk2(f[6], f[7]); return w; }
DI float wsum(float v) { for (int o = 32; o; o >>= 1) v += __shfl_xor(v, o); return v; }
DI float silu(float x) { return x * __builtin_amdgcn_rcpf(1.0f + __builtin_amdgcn_exp2f(-1.4426950408889634f * x)); }
DI float sigm(float x) { return __builtin_amdgcn_rcpf(1.0f + __builtin_amdgcn_exp2f(-1.4426950408889634f * x)); }
DI f32x4 mfma16(bf16x8 a, bf16x8 b, f32x4 c) { return __builtin_amdgcn_mfma_f32_16x16x32_bf16(a, b, c, 0, 0, 0); }

typedef float f32x2g __attribute__((ext_vector_type(2)));
DI void norm_row(const Params& p, const LAS float* wg, int row, const float4 (&xv)[4], const float4 (&nw)[4], float bgl, int lane) {
    bf16_t* H = (bf16_t*)(p.ws + WS_H); float* gates = (float*)(p.ws + WS_GATES);
    float ss = 0.f;
#pragma unroll
    for (int i = 0; i < 4; ++i) ss += xv[i].x * xv[i].x + xv[i].y * xv[i].y + xv[i].z * xv[i].z + xv[i].w * xv[i].w;
    ss = wsum(ss); const float rstd = rsqrtf(ss * (1.0f / DM) + 1e-6f);
    f32x2g g2[8];
#pragma unroll
    for (int j = 0; j < 8; ++j) g2[j] = (f32x2g){0.f, 0.f};
    u32x2 hw[4];
#pragma unroll
    for (int i = 0; i < 4; ++i) { const int d0 = i * 256 + lane * 4;
        const f32x2g ha = (f32x2g){xv[i].x, xv[i].y} * rstd * (f32x2g){nw[i].x, nw[i].y}, hb = (f32x2g){xv[i].z, xv[i].w} * rstd * (f32x2g){nw[i].z, nw[i].w};
        hw[i].x = pk2(ha.x, ha.y); hw[i].y = pk2(hb.x, hb.y);
#pragma unroll
        for (int j = 0; j < 8; ++j) { const f32x4 wv = *(const LAS f32x4*)(wg + j * 1024 + d0); g2[j] += ha * (f32x2g){wv[0], wv[1]}; g2[j] += hb * (f32x2g){wv[2], wv[3]}; } }
#pragma unroll
    for (int i = 0; i < 4; ++i) *(u32x2*)(H + (size_t)row * DM + i * 256 + lane * 4) = hw[i];
    float g[8];
#pragma unroll
    for (int j = 0; j < 8; ++j) g[j] = g2[j].x + g2[j].y;
    const bool b5 = lane & 32, b4 = lane & 16, b3 = lane & 8;
    float r1[4], r2[2], r3;
#pragma unroll
    for (int j = 0; j < 4; ++j) { const float mine = b5 ? g[4 + j] : g[j], other = b5 ? g[j] : g[4 + j]; r1[j] = mine + __shfl_xor(other, 32); }
#pragma unroll
    for (int j = 0; j < 2; ++j) { const float mine = b4 ? r1[2 + j] : r1[j], other = b4 ? r1[j] : r1[2 + j]; r2[j] = mine + __shfl_xor(other, 16); }
    { const float mine = b3 ? r2[1] : r2[0], other = b3 ? r2[0] : r2[1]; r3 = mine + __shfl_xor(other, 8); }
    r3 += __shfl_xor(r3, 4); r3 += __shfl_xor(r3, 2); r3 += __shfl_xor(r3, 1);
    const float z = r3 + bgl; const int gi = lane >> 3;
    const float lf = fminf(z, 0.f) - __logf(1.0f + __expf(-fabsf(z)));
    if ((lane & 7) == 0) gates[(size_t)row * 8 + gi] = gi < 4 ? z : lf;
}
DI void phase0(const Params& p, LAS uchar* lds) {
    const int tid = threadIdx.x, lane = tid & 63, wid = tid >> 6, nb = gridDim.x, bid = blockIdx.x;
    LAS float* tile = (LAS float*)lds;
#ifndef REP_TR
#define REP_TR 1
#define REP_ROW 1
#define REP_ROPE 1
#endif
    for (int rp = 0; rp < REP_TR; ++rp)
    for (int t0 = bid * 2; t0 < 960 + 256; t0 += nb * 2) {
        const float* src[2]; bf16_t* dst[2]; int ld[2], k0[2], n0[2], sc0[2];
#pragma unroll
        for (int q = 0; q < 2; ++q) { const int t = t0 + q;
            if (t < 960) { const int nt = t % 60, kt = t / 60; n0[q] = nt * 64; k0[q] = kt * 64; sc0[q] = n0[q] + (n0[q] >= 3328 ? 8 : 0); src[q] = p.w_in; ld[q] = DIN; dst[q] = (bf16_t*)(p.ws + WS_WTIN); }
            else { const int t2 = t - 960, nt = t2 % 16, kt = t2 / 16; n0[q] = nt * 64; k0[q] = kt * 64; sc0[q] = n0[q]; src[q] = p.w_out; ld[q] = DM; dst[q] = (bf16_t*)(p.ws + WS_WTOUT); } }
        float4 v[2][2];
#pragma unroll
        for (int q = 0; q < 2; ++q)
#pragma unroll
            for (int ps = 0; ps < 2; ++ps) { const int kk = (tid >> 4) + 32 * ps, nn4 = (tid & 15) * 4; v[q][ps] = *(const float4*)(src[q] + (size_t)(k0[q] + kk) * ld[q] + sc0[q] + nn4); }
#pragma unroll
        for (int q = 0; q < 2; ++q)
#pragma unroll
            for (int ps = 0; ps < 2; ++ps) { const int kk = (tid >> 4) + 32 * ps, nn4 = (tid & 15) * 4; LAS float* tl = tile + q * 4160 + kk * 65 + nn4; tl[0] = v[q][ps].x; tl[1] = v[q][ps].y; tl[2] = v[q][ps].z; tl[3] = v[q][ps].w; }
        __syncthreads();
#pragma unroll
        for (int q = 0; q < 2; ++q) { const int nn = tid >> 3, kk8 = (tid & 7) * 8; float f[8];
#pragma unroll
          for (int j = 0; j < 8; ++j) f[j] = tile[q * 4160 + (kk8 + j) * 65 + nn];
          *(u32x4*)(dst[q] + (size_t)(n0[q] + nn) * DM + k0[q] + kk8) = pack8(f); }
        __syncthreads();
    }
    { float2* rope = (float2*)(p.ws + WS_ROPE);
      for (int rp = 0; rp < REP_ROPE; ++rp)
      for (int idx = bid * 512 + tid; idx < 8200 * 8; idx += nb * 512) { const int pos = idx >> 3, i = idx & 7;
          const float invf = (float)exp(-(double)i * 0.125 * 13.122363377404328);
          const float ang = (float)pos * invf;
          const double q = rint((double)ang * 0.6366197723675814), r = (double)ang - q * 1.5707963267948966, r2 = r * r;
          const double s = r * (1.0 + r2 * (-1.0 / 6 + r2 * (1.0 / 120 + r2 * (-1.0 / 5040 + r2 * (1.0 / 362880 + r2 * (-1.0 / 39916800 + r2 * (1.0 / 6227020800.0)))))));
          const double c = 1.0 + r2 * (-0.5 + r2 * (1.0 / 24 + r2 * (-1.0 / 720 + r2 * (1.0 / 40320 + r2 * (-1.0 / 3628800 + r2 * (1.0 / 479001600.0))))));
          const int qi = ((int)q) & 3; double cs, sn;
          if (qi == 0) { sn = s; cs = c; } else if (qi == 1) { sn = c; cs = -s; } else if (qi == 2) { sn = -s; cs = -c; } else { sn = -c; cs = s; }
          rope[idx] = make_float2((float)cs, (float)sn); } }
    LAS float* wg = (LAS float*)(lds + 32768);
    for (int d = tid; d < DM; d += 512) { const float4 a = *(const float4*)(p.w_in + (size_t)d * DIN + 3328), b = *(const float4*)(p.w_in + (size_t)d * DIN + 3332);
        wg[d] = a.x; wg[1024 + d] = a.y; wg[2048 + d] = a.z; wg[3072 + d] = a.w; wg[4096 + d] = b.x; wg[5120 + d] = b.y; wg[6144 + d] = b.z; wg[7168 + d] = b.w; }
    __syncthreads();
    float4 nwr[4];
#pragma unroll
    for (int i = 0; i < 4; ++i) nwr[i] = *(const float4*)(p.norm_w + i * 256 + lane * 4);
    const float bgr = p.b_gates[lane >> 3];
    for (int rp = 0; rp < REP_ROW; ++rp)
    for (int row = bid * 8 + wid; row < NTOK; row += nb * 16) {
        const int row2 = row + nb * 8; const bool has2 = row2 < NTOK; const int r2 = has2 ? row2 : row;
        const float* xa = row < NTP ? p.x_p + (size_t)row * DM : p.x_s + (size_t)(row - NTP) * DM;
        const float* xb = r2 < NTP ? p.x_p + (size_t)r2 * DM : p.x_s + (size_t)(r2 - NTP) * DM;
        float4 va[4], vb[4];
#pragma unroll
        for (int i = 0; i < 4; ++i) va[i] = *(const float4*)(xa + i * 256 + lane * 4);
#pragma unroll
        for (int i = 0; i < 4; ++i) vb[i] = *(const float4*)(xb + i * 256 + lane * 4);
        norm_row(p, wg, row, va, nwr, bgr, lane);
        if (has2) norm_row(p, wg, row2, vb, nwr, bgr, lane);
    }
}

DI float block_excl_sum(float v, LAS float* red, int tid) {
    const int lane = tid & 63, wid = tid >> 6; float inc = v;
#pragma unroll
    for (int o = 1; o < 64; o <<= 1) { const float t = __shfl_up(inc, o); if (lane >= o) inc += t; }
    __syncthreads(); if (lane == 63) red[wid] = inc; __syncthreads();
    float base = 0.f;
#pragma unroll
    for (int w = 0; w < 8; ++w) base += (w < wid) ? red[w] : 0.f;
    return base + inc - v;
}
DI float block_excl_max(float v, LAS float* red, int tid) {
    const int lane = tid & 63, wid = tid >> 6; float inc = v;
#pragma unroll
    for (int o = 1; o < 64; o <<= 1) { const float t = __shfl_up(inc, o); if (lane >= o) inc = fmaxf(inc, t); }
    __syncthreads(); if (lane == 63) red[wid] = inc; __syncthreads();
    float base = -INFINITY;
#pragma unroll
    for (int w = 0; w < 8; ++w) base = fmaxf(base, (w < wid) ? red[w] : -INFINITY);
    float ex = __shfl_up(inc, 1); if (lane == 0) ex = -INFINITY;
    return fmaxf(base, ex);
}
DI void gate_scan(const Params& p, LAS uchar* lds, int bh) {
    const int tid = threadIdx.x, b = bh >> 2, h = bh & 3, t0 = tid * 16;
    const float* gates = (const float*)(p.ws + WS_GATES); float2* FM = (float2*)(p.ws + WS_FM) + (size_t)bh * SEQ;
    LAS float* red = (LAS float*)lds;
    float li[16], F[16];
    float run = 0.f;
#pragma unroll
    for (int j = 0; j < 16; ++j) { const float* g = gates + (size_t)(b * SEQ + t0 + j) * 8; li[j] = g[h]; run += g[4 + h]; F[j] = run; }
    const float base = block_excl_sum(run, red, tid);
    float mx = -INFINITY, ml[16];
#pragma unroll
    for (int j = 0; j < 16; ++j) { F[j] += base; mx = fmaxf(mx, li[j] - F[j]); ml[j] = mx; }
    const float mb = fmaxf(block_excl_max(mx, red, tid), 0.0f);
#pragma unroll
    for (int j = 0; j < 16; ++j) FM[t0 + j] = make_float2(F[j], F[j] + fmaxf(ml[j], mb));
    __syncthreads();
}

struct EpiProj {
    static constexpr bool PERM = true, AFTER_DRAIN = false;
    bf16_t* O;
    __device__ __forceinline__ void operator()(const f32x4 (&acc)[2][2][4][2], const pg8::Unit& u, int wr, int wc, int fr, int fq) const {
        const int row0 = u.pm * 256 + wr * 64 + fr, col0 = u.pn * 256 + wc * 32 + 8 * fq;
#pragma unroll
        for (int ai = 0; ai < 2; ++ai)
#pragma unroll
            for (int m = 0; m < 4; ++m) { bf16_t* rowp = O + (size_t)(row0 + ai * 128 + m * 16) * NPJ + col0;
#pragma unroll
                for (int bj = 0; bj < 2; ++bj) { const f32x4 v0 = acc[ai][bj][m][0], v1 = acc[ai][bj][m][1];
                    u32x4 w; w.x = pk2(v0[0], v0[1]); w.y = pk2(v0[2], v0[3]); w.z = pk2(v1[0], v1[1]); w.w = pk2(v1[2], v1[3]);
                    *(u32x4*)(rowp + bj * 128) = w; } }
    }
};
struct EpiOut {
    static constexpr bool PERM = false, AFTER_DRAIN = false;
    float* Y; const float* xp;
    __device__ __forceinline__ void operator()(const f32x4 (&acc)[2][2][4][2], const pg8::Unit& u, int wr, int wc, int fr, int fq) const {
        const int row0 = u.pm * 256 + wr * 64 + fr, col0 = u.pn * 256 + wc * 32 + 4 * fq;
#pragma unroll
        for (int ai = 0; ai < 2; ++ai)
#pragma unroll
            for (int mp = 0; mp < 2; ++mp) { f32x4 xv[2][2][2];
#pragma unroll
                for (int mm = 0; mm < 2; ++mm) { const float* xr = xp + (size_t)(row0 + ai * 128 + (mp * 2 + mm) * 16) * DM + col0;
#pragma unroll
                    for (int bj = 0; bj < 2; ++bj)
#pragma unroll
                        for (int n = 0; n < 2; ++n) xv[mm][bj][n] = *(const f32x4*)(xr + bj * 128 + n * 16); }
#pragma unroll
                for (int mm = 0; mm < 2; ++mm) { float* yr = Y + (size_t)(row0 + ai * 128 + (mp * 2 + mm) * 16) * DM + col0;
#pragma unroll
                    for (int bj = 0; bj < 2; ++bj)
#pragma unroll
                        for (int n = 0; n < 2; ++n) *(f32x4*)(yr + bj * 128 + n * 16) = acc[ai][bj][mp * 2 + mm][n] + xv[mm][bj][n]; } }
    }
};
DI void phase1(const Params& p, LAS uchar* lds) {
    const int nb = gridDim.x, bid = blockIdx.x;
    if (bid >= nb - 8) gate_scan(p, lds, bid - (nb - 8));
    pg8::Gemm g; g.A = (const bf16_t*)(p.ws + WS_H); g.Bt = (const bf16_t*)(p.ws + WS_WTIN); g.M = NTOK; g.N = NPJ; g.K = DM;
    pg8::StaticOrder S; S.init(g.M, g.N, nb, bid);
    EpiProj E; E.O = (bf16_t*)(p.ws + WS_PROJ);
    pg8::gemm_phase<EpiProj, pg8::StaticOrder, false>(lds, g, S, E, nullptr);
}
DI void phase5(const Params& p, LAS uchar* lds) {
    const int nb = gridDim.x, bid = blockIdx.x;
    pg8::Gemm g; g.A = (const bf16_t*)(p.ws + WS_MIXED); g.Bt = (const bf16_t*)(p.ws + WS_WTOUT); g.M = NTP; g.N = DM; g.K = DM;
    pg8::StaticOrder S; S.init(g.M, g.N, nb, bid);
    EpiOut E; E.Y = p.out + O_Y; E.xp = p.x_p;
    pg8::gemm_phase<EpiOut, pg8::StaticOrder, false>(lds, g, S, E, nullptr);
}

constexpr int KSTR = 144, VSTR = 560, AT_K = 0, AT_V = 272 * KSTR, AT_R = AT_V + 64 * VSTR;
typedef float f32x2r __attribute__((ext_vector_type(2)));

DI void qk_norm_rope16(float (&x)[16], int pt, const float* nw, const float2* rope_row) {
    float ss = 0.f;
#pragma unroll
    for (int j = 0; j < 16; ++j) ss += x[j] * x[j];
    ss += __shfl_xor(ss, 1); ss += __shfl_xor(ss, 2);
    const float rstd = rsqrtf(ss * (1.0f / 64) + 1e-6f);
#pragma unroll
    for (int j = 0; j < 16; ++j) x[j] = x[j] * rstd * nw[pt * 16 + j];
    if (pt == 0) {
#pragma unroll
        for (int i = 0; i < 8; ++i) { const float2 cs = rope_row[i]; const float a = x[i], b = x[i + 8]; x[i] = a * cs.x - b * cs.y; x[i + 8] = b * cs.x + a * cs.y; } }
}
DI void qk_norm_rope16p(float (&x)[16], int pt, const float* nw, const float2 (&rp)[8]) {
    float ss = 0.f;
#pragma unroll
    for (int j = 0; j < 16; ++j) ss += x[j] * x[j];
    ss += __shfl_xor(ss, 1); ss += __shfl_xor(ss, 2);
    const float rstd = rsqrtf(ss * (1.0f / 64) + 1e-6f);
#pragma unroll
    for (int j = 0; j < 16; ++j) x[j] = x[j] * rstd * nw[pt * 16 + j];
    if (pt == 0) {
#pragma unroll
        for (int i = 0; i < 8; ++i) { const float2 cs = rp[i]; const float a = x[i], b = x[i + 8]; x[i] = a * cs.x - b * cs.y; x[i + 8] = b * cs.x + a * cs.y; } }
}
DI void kv_to_lds(LAS uchar* lds, int ki, int pt, const float (&xk)[16], const float (&xv)[16]) {
    float a[8], b[8];
#pragma unroll
    for (int j = 0; j < 8; ++j) { a[j] = xk[j]; b[j] = xk[8 + j]; }
    *(LAS u32x4*)(lds + AT_K + ki * KSTR + pt * 32) = pack8(a); *(LAS u32x4*)(lds + AT_K + ki * KSTR + pt * 32 + 16) = pack8(b);
#pragma unroll
    for (int j = 0; j < 16; j += 2) { const unsigned w = pk2(xv[j], xv[j + 1]);
        *(LAS bf16_t*)(lds + AT_V + (pt * 16 + j) * VSTR + ki * 2) = (bf16_t)(w & 0xffffu); *(LAS bf16_t*)(lds + AT_V + (pt * 16 + j + 1) * VSTR + ki * 2) = (bf16_t)(w >> 16); }
}
DI void load16bf(const bf16_t* src, float (&x)[16]) { const u32x4 w0 = *(const u32x4*)src, w1 = *(const u32x4*)(src + 8); float a[8], b[8]; unpack8(w0, a); unpack8(w1, b);
#pragma unroll
    for (int j = 0; j < 8; ++j) { x[j] = a[j]; x[8 + j] = b[j]; } }
DI void load16f(const float* src, float (&x)[16]) {
#pragma unroll
    for (int j = 0; j < 4; ++j) { const float4 v = *(const float4*)(src + 4 * j); x[4 * j] = v.x; x[4 * j + 1] = v.y; x[4 * j + 2] = v.z; x[4 * j + 3] = v.w; } }
DI void store16f(float* dst, const float (&x)[16]) {
#pragma unroll
    for (int j = 0; j < 4; ++j) *(float4*)(dst + 4 * j) = make_float4(x[4 * j], x[4 * j + 1], x[4 * j + 2], x[4 * j + 3]); }

struct QRaw { u32x4 q0, q1; u32x2 gw[4]; };
DI void attn_q_load(const Params& p, int row, int hqa, QRaw& qr) {
    const int lane = threadIdx.x & 63, quad = lane >> 4;
    const bf16_t* rowp = (const bf16_t*)(p.ws + WS_PROJ) + (size_t)row * NPJ;
    qr.q0 = *(const u32x4*)(rowp + C_AQ + hqa * 64 + 8 * quad); qr.q1 = *(const u32x4*)(rowp + C_AQ + hqa * 64 + 32 + 8 * quad);
#pragma unroll
    for (int mt = 0; mt < 4; ++mt) qr.gw[mt] = *(const u32x2*)(rowp + C_AG + hqa * 64 + 16 * mt + 4 * quad);
}
template <bool LROPE> DI void attn_q_tile(const Params& p, LAS uchar* lds, const QRaw& qr, const float (&qw0)[8], const float (&qw1)[8], int row, int pos, int hqa, int qi, int kt0, int kmin) {
    const int lane = threadIdx.x & 63, r = lane & 15, quad = lane >> 4;
    const float2* rope = (const float2*)(p.ws + WS_ROPE);
    float x0[8], x1[8];
    unpack8(qr.q0, x0); unpack8(qr.q1, x1);
    float ss = 0.f;
#pragma unroll
    for (int j = 0; j < 8; ++j) ss += x0[j] * x0[j] + x1[j] * x1[j];
    ss += __shfl_xor(ss, 16); ss += __shfl_xor(ss, 32);
    const float rstd = rsqrtf(ss * (1.0f / 64) + 1e-6f) ;
#pragma unroll
    for (int j = 0; j < 8; ++j) { x0[j] = x0[j] * rstd * qw0[j]; x1[j] = x1[j] * rstd * qw1[j]; }
#pragma unroll
    for (int j = 0; j < 8; ++j) { const float pj = __shfl_xor(x0[j], 16); float2 cs; if (LROPE) { const f32x2r c2 = *(const LAS f32x2r*)(lds + AT_R + qi * 64 + j * 8); cs = make_float2(c2.x, c2.y); } else cs = rope[(size_t)pos * 8 + j];
        const float rot = x0[j] * cs.x + (quad == 0 ? -pj : pj) * cs.y; x0[j] = (quad < 2) ? rot : x0[j]; }
#pragma unroll
    for (int j = 0; j < 8; ++j) { x0[j] *= 0.18033688011112042f; x1[j] *= 0.18033688011112042f; }
    const bf16x8 qf0 = __builtin_bit_cast(bf16x8, pack8(x0)), qf1 = __builtin_bit_cast(bf16x8, pack8(x1));
    const float sink = p.sinks[hqa] * 1.4426950408889634f;
    f32x4 s[9];
#pragma unroll
    for (int kt = 0; kt < 9; ++kt) { const int krow = (kt0 + kt) * 16 + r;
        const bf16x8 a0 = *(const LAS bf16x8*)(lds + AT_K + krow * KSTR + quad * 16), a1 = *(const LAS bf16x8*)(lds + AT_K + krow * KSTR + 64 + quad * 16);
        f32x4 acc = {0.f, 0.f, 0.f, 0.f}; acc = mfma16(a0, qf0, acc); acc = mfma16(a1, qf1, acc); s[kt] = acc; }
    float mx = sink;
#pragma unroll
    for (int kt = 0; kt < 9; ++kt) {
        if ((kt0 + kt) * 16 + 15 < kmin) { s[kt] = (f32x4){-INFINITY, -INFINITY, -INFINITY, -INFINITY}; }
        else {
            if (kt == 0) {
#pragma unroll
                for (int v = 0; v < 4; ++v) { const int ki = kt0 * 16 + quad * 4 + v; s[kt][v] = (ki > qi) ? s[kt][v] : -INFINITY; } }
            if (kt == 8) {
#pragma unroll
                for (int v = 0; v < 4; ++v) { const int ki = (kt0 + 8) * 16 + quad * 4 + v; s[kt][v] = (ki <= qi + 128) ? s[kt][v] : -INFINITY; } }
            mx = fmaxf(fmaxf(mx, fmaxf(s[kt][0], s[kt][1])), fmaxf(s[kt][2], s[kt][3])); } }
    mx = fmaxf(mx, __shfl_xor(mx, 16)); mx = fmaxf(mx, __shfl_xor(mx, 32));
    float sum = 0.f;
#pragma unroll
    for (int kt = 0; kt < 9; ++kt)
#pragma unroll
        for (int v = 0; v < 4; ++v) { const float e = __builtin_amdgcn_exp2f(s[kt][v] - mx); s[kt][v] = e; sum += e; }
    sum += __shfl_xor(sum, 16); sum += __shfl_xor(sum, 32);
    sum += __builtin_amdgcn_exp2f(sink - mx);
    const float inv = __builtin_amdgcn_rcpf(sum);
    f32x4 o[4];
#pragma unroll
    for (int mt = 0; mt < 4; ++mt) o[mt] = (f32x4){0.f, 0.f, 0.f, 0.f};
#pragma unroll
    for (int ks = 0; ks < 5; ++ks) {
        u32x4 pw; pw.x = pk2(s[2 * ks][0], s[2 * ks][1]); pw.y = pk2(s[2 * ks][2], s[2 * ks][3]);
        if (ks < 4) { pw.z = pk2(s[2 * ks + 1][0], s[2 * ks + 1][1]); pw.w = pk2(s[2 * ks + 1][2], s[2 * ks + 1][3]); } else { pw.z = 0u; pw.w = 0u; }
        const bf16x8 pb = __builtin_bit_cast(bf16x8, pw);
#pragma unroll
        for (int mt = 0; mt < 4; ++mt) { const int d = 16 * mt + r; const LAS uchar* vp = lds + AT_V + d * VSTR + ((kt0 + 2 * ks) * 16 + 4 * quad) * 2;
            u32x4 aw; const u32x2 lo = *(const LAS u32x2*)vp, hi = *(const LAS u32x2*)(vp + 32); aw.x = lo.x; aw.y = lo.y; aw.z = hi.x; aw.w = hi.y;
            o[mt] = mfma16(__builtin_bit_cast(bf16x8, aw), pb, o[mt]); } }
    bf16_t* mixed = (bf16_t*)(p.ws + WS_MIXED) + (size_t)row * DM;
#pragma unroll
    for (int mt = 0; mt < 4; ++mt) { const int col = hqa * 64 + 16 * mt + 4 * quad; const u32x2 gw = qr.gw[mt];
        u32x2 w; w.x = pk2(o[mt][0] * inv * silu(bflo(gw.x)), o[mt][1] * inv * silu(bfhi(gw.x))); w.y = pk2(o[mt][2] * inv * silu(bflo(gw.y)), o[mt][3] * inv * silu(bfhi(gw.y)));
        *(u32x2*)(mixed + col) = w; }
}

DI void attn_prompt_item(const Params& p, LAS uchar* lds, int item) {
    const int tid = threadIdx.x, wid = tid >> 6, lane = tid & 63, r = lane & 15;
    const int g = item & 1, blk = (item >> 1) & 63, b = item >> 7;
    const bf16_t* proj = (const bf16_t*)(p.ws + WS_PROJ); const float2* rope = (const float2*)(p.ws + WS_ROPE);
    const int hqa = g * 4 + (wid >> 1), qh = wid & 1;
    __syncthreads();
    float qw0[8], qw1[8];
    { const int quad = lane >> 4;
#pragma unroll
      for (int j = 0; j < 8; ++j) { qw0[j] = p.qnw[8 * quad + j]; qw1[j] = p.qnw[32 + 8 * quad + j]; } }
    u32x4 kr[2][2], vr[2][2]; float2 rp[2][8];
#pragma unroll
    for (int it = 0; it < 2; ++it) { const int u = tid + 512 * it, ki = u >> 2, pt = u & 3, tk = (blk - 1) * 128 + ki; const int tkc = tk < 0 ? 0 : tk;
        const bf16_t* rowp = proj + (size_t)(b * SEQ + tkc) * NPJ;
        kr[it][0] = *(const u32x4*)(rowp + C_AK + g * 64 + pt * 16); kr[it][1] = *(const u32x4*)(rowp + C_AK + g * 64 + pt * 16 + 8);
        vr[it][0] = *(const u32x4*)(rowp + C_AV + g * 64 + pt * 16); vr[it][1] = *(const u32x4*)(rowp + C_AV + g * 64 + pt * 16 + 8);
#pragma unroll
        for (int i = 0; i < 8; ++i) rp[it][i] = rope[(size_t)tkc * 8 + i]; }
    if (tid < 128) { u32x4 z; z.x = 0u; z.y = 0u; z.z = 0u; z.w = 0u; *(LAS u32x4*)(lds + AT_V + (tid >> 1) * VSTR + 512 + (tid & 1) * 16) = z; }
    QRaw qr[4];
#pragma unroll
    for (int i = 0; i < 4; ++i) attn_q_load(p, b * SEQ + blk * 128 + (qh * 4 + i) * 16 + r, hqa, qr[i]);
    { const float2 ra = rope[(size_t)blk * 1024 + tid], rb = rope[(size_t)blk * 1024 + 512 + tid];
      *(LAS f32x2r*)(lds + AT_R + tid * 8) = (f32x2r){ra.x, ra.y}; *(LAS f32x2r*)(lds + AT_R + (512 + tid) * 8) = (f32x2r){rb.x, rb.y}; }
#pragma unroll
    for (int it = 0; it < 2; ++it) { const int u = tid + 512 * it, ki = u >> 2, pt = u & 3;
        {
            float xk[16], xv[16]; float a[8], c[8];
            unpack8(kr[it][0], a); unpack8(kr[it][1], c);
#pragma unroll
            for (int j = 0; j < 8; ++j) { xk[j] = a[j]; xk[8 + j] = c[j]; }
            unpack8(vr[it][0], a); unpack8(vr[it][1], c);
#pragma unroll
            for (int j = 0; j < 8; ++j) { xv[j] = a[j]; xv[8 + j] = c[j]; }
            qk_norm_rope16p(xk, pt, p.knw, rp[it]);
            kv_to_lds(lds, ki, pt, xk, xv);
            if (blk == 63 && ki >= 128) { const size_t o = ((size_t)(b * 128 + ki - 128) * 2 + g) * 64 + pt * 16; store16f(p.out + O_KWP + o, xk); store16f(p.out + O_VWP + o, xv); } } }
    __syncthreads();
#pragma unroll 2
    for (int i = 0; i < 4; ++i) { const int qt = qh * 4 + i, qi = qt * 16 + r, tq = blk * 128 + qi;
        attn_q_tile<true>(p, lds, qr[0], qw0, qw1, b * SEQ + tq, tq, hqa, qi, qt, blk == 0 ? 128 : 0);
        qr[0] = qr[1]; qr[1] = qr[2]; qr[2] = qr[3]; }
}
DI void attn_sample_item(const Params& p, LAS uchar* lds, int item) {
    const int tid = threadIdx.x, wid = tid >> 6, lane = tid & 63, r = lane & 15;
    const int g = item & 1, b = item >> 1;
    const bf16_t* proj = (const bf16_t*)(p.ws + WS_PROJ); const float2* rope = (const float2*)(p.ws + WS_ROPE);
    __syncthreads();
    QRaw qrs; if (wid == 0) attn_q_load(p, NTP + b * 4 + (r >> 2), g * 4 + (r & 3), qrs);
    float qw0[8], qw1[8];
    { const int quad = lane >> 4;
#pragma unroll
      for (int j = 0; j < 8; ++j) { qw0[j] = p.qnw[8 * quad + j]; qw1[j] = p.qnw[32 + 8 * quad + j]; } }
    for (int u = tid; u < 640; u += 512) { const int ki = u >> 2, pt = u & 3;
        float xk[16], xv[16];
#pragma unroll
        for (int j = 0; j < 16; ++j) { xk[j] = 0.f; xv[j] = 0.f; }
        if (ki < 128) { const size_t o = ((size_t)(b * 128 + ki) * 2 + g) * 64 + pt * 16; load16f(p.ck + o, xk); load16f(p.cv + o, xv); }
        else { if (ki < 132) { const bf16_t* rowp = proj + (size_t)(NTP + b * 4 + ki - 128) * NPJ; load16bf(rowp + C_AK + g * 64 + pt * 16, xk); load16bf(rowp + C_AV + g * 64 + pt * 16, xv); }
               qk_norm_rope16(xk, pt, p.knw, rope + (size_t)(SEQ + (ki < 132 ? ki - 128 : 0)) * 8); }
        kv_to_lds(lds, ki, pt, xk, xv);
        if (ki >= 4 && ki < 132) { const size_t o = ((size_t)(b * 128 + ki - 4) * 2 + g) * 64 + pt * 16; store16f(p.out + O_KWS + o, xk); store16f(p.out + O_VWS + o, xv); }
    }
    __syncthreads();
    if (wid == 0) { const int t = r >> 2, hqa = g * 4 + (r & 3); attn_q_tile<false>(p, lds, qrs, qw0, qw1, NTP + b * 4 + t, SEQ + t, hqa, t, 0, 0); }
}

constexpr int TSTR = 272;
constexpr int ML_Q = 0, ML_K = 128 * TSTR, ML_V = ML_K + 128 * TSTR, ML_S = ML_V + 144 * TSTR, ML_AS = ML_S + 144 * TSTR, ML_END = ML_AS + 512;
static_assert(ML_END <= LDS_MAIN, "lds");

struct ConvIn { u32x4 row[11]; float4 w[4][2]; float4 bias[2]; };
DI void conv_issue(const Params& p, const bf16_t* proj, int b, int t0, int col, int ch, ConvIn& ci) {
#pragma unroll
    for (int i = 0; i < 11; ++i) { const int tt = t0 - 3 + i; ci.row[i] = *(const u32x4*)(proj + (size_t)(b * SEQ + (tt < 0 ? 0 : tt)) * NPJ + col); }
#pragma unroll
    for (int j = 0; j < 4; ++j) { ci.w[j][0] = *(const float4*)(p.conv_w + j * 1024 + ch); ci.w[j][1] = *(const float4*)(p.conv_w + j * 1024 + ch + 4); }
    ci.bias[0] = *(const float4*)(p.conv_b + ch); ci.bias[1] = *(const float4*)(p.conv_b + ch + 4);
}
typedef float f32x2 __attribute__((ext_vector_type(2)));
DI void conv_compute(const ConvIn& ci, int t0, float (&y)[8][8]) {
    f32x2 w[4][4], yy[8][4];
#pragma unroll
    for (int j = 0; j < 4; ++j) { w[j][0] = (f32x2){ci.w[j][0].x, ci.w[j][0].y}; w[j][1] = (f32x2){ci.w[j][0].z, ci.w[j][0].w}; w[j][2] = (f32x2){ci.w[j][1].x, ci.w[j][1].y}; w[j][3] = (f32x2){ci.w[j][1].z, ci.w[j][1].w}; }
    const f32x2 bs[4] = {(f32x2){ci.bias[0].x, ci.bias[0].y}, (f32x2){ci.bias[0].z, ci.bias[0].w}, (f32x2){ci.bias[1].x, ci.bias[1].y}, (f32x2){ci.bias[1].z, ci.bias[1].w}};
#pragma unroll
    for (int i = 0; i < 8; ++i)
#pragma unroll
        for (int q = 0; q < 4; ++q) yy[i][q] = bs[q];
#pragma unroll
    for (int r = 0; r < 11; ++r) { f32x2 x[4];
        const bool zero = (r < 3) && (t0 - 3 + r < 0);
#pragma unroll
        for (int q = 0; q < 4; ++q) { const unsigned wd = zero ? 0u : ci.row[r][q]; x[q] = (f32x2){bflo(wd), bfhi(wd)}; }
#pragma unroll
        for (int j = 0; j < 4; ++j) { const int i = r - j;
            if (i >= 0 && i < 8) {
#pragma unroll
                for (int q = 0; q < 4; ++q) yy[i][q] += w[j][q] * x[q]; } } }
#pragma unroll
    for (int i = 0; i < 8; ++i)
#pragma unroll
        for (int q = 0; q < 4; ++q) { const f32x2 v = yy[i][q], a = v * -1.4426950408889634f; f32x2 e; e.x = __builtin_amdgcn_exp2f(a.x); e.y = __builtin_amdgcn_exp2f(a.y);
            const f32x2 d = e + 1.0f; f32x2 rc; rc.x = __builtin_amdgcn_rcpf(d.x); rc.y = __builtin_amdgcn_rcpf(d.y); const f32x2 o = v * rc; y[i][2 * q] = o.x; y[i][2 * q + 1] = o.y; }
}
DI void vt_store8(LAS uchar* img, int d0, int s0, const u32x4 (&row)[8]) {
#pragma unroll
    for (int wd = 0; wd < 4; ++wd) { u32x4 ev, od;
        unsigned a[8];
#pragma unroll
        for (int i = 0; i < 8; ++i) a[i] = row[i][wd];
        ev.x = (a[0] & 0xffffu) | (a[1] << 16); ev.y = (a[2] & 0xffffu) | (a[3] << 16); ev.z = (a[4] & 0xffffu) | (a[5] << 16); ev.w = (a[6] & 0xffffu) | (a[7] << 16);
        od.x = (a[0] >> 16) | (a[1] & 0xffff0000u); od.y = (a[2] >> 16) | (a[3] & 0xffff0000u); od.z = (a[4] >> 16) | (a[5] & 0xffff0000u); od.w = (a[6] >> 16) | (a[7] & 0xffff0000u);
        *(LAS u32x4*)(img + (d0 + 2 * wd) * TSTR + s0 * 2) = ev; *(LAS u32x4*)(img + (d0 + 2 * wd + 1) * TSTR + s0 * 2) = od; }
}
DI void vt_aug_rows(LAS uchar* img, int tid) {
    if (tid < 256) { const int rr = tid >> 4, s8 = (tid & 15) * 8; const unsigned v = rr == 0 ? 0x3F803F80u : 0u; u32x4 w; w.x = v; w.y = v; w.z = v; w.w = v;
        *(LAS u32x4*)(img + (128 + rr) * TSTR + s8 * 2) = w; }
}

DI void mlstm_u_item(const Params& p, LAS uchar* lds, int item) {
    const int tid = threadIdx.x, wid = tid >> 6, lane = tid & 63, r = lane & 15, quad = lane >> 4;
    const int c = item & 63, bh = item >> 6, b = bh >> 2, h = bh & 3;
    const bf16_t* proj = (const bf16_t*)(p.ws + WS_PROJ); const float* gates = (const float*)(p.ws + WS_GATES); const float2* FM = (const float2*)(p.ws + WS_FM) + (size_t)bh * SEQ;
    LAS float* wks = (LAS float*)(lds + ML_AS);
    __syncthreads();
    if (tid < 256) {
        const int g8 = (tid & 15) * 8, s0 = (tid >> 4) * 8, t0 = c * CH + s0;
        ConvIn ci; conv_issue(p, proj, b, t0, C_MK + h * 128 + g8, 512 + h * 128 + g8, ci);
        if (tid < 128) { const int t = c * CH + tid; const float2 fe = FM[c * CH + CH - 1], fs = FM[t];
            wks[tid] = __expf(fe.x - fs.x + gates[(size_t)(b * SEQ + t) * 8 + h] - fe.y) * 0.08838834764831845f; }
        vt_aug_rows(lds + ML_V, tid);
        __syncthreads();
        float y[8][8]; conv_compute(ci, t0, y);
        const f32x4 wa = *(const LAS f32x4*)(wks + s0), wb = *(const LAS f32x4*)(wks + s0 + 4);
        const float wk[8] = {wa[0], wa[1], wa[2], wa[3], wb[0], wb[1], wb[2], wb[3]};
#pragma unroll
        for (int e = 0; e < 8; ++e) { float f[8];
#pragma unroll
            for (int i = 0; i < 8; ++i) f[i] = y[i][e] * wk[i];
            *(LAS u32x4*)(lds + ML_K + (g8 + e) * TSTR + s0 * 2) = pack8(f); }
    } else {
        const int vt = tid - 256, d8 = (vt & 15) * 8, s0 = (vt >> 4) * 8, t0 = c * CH + s0;
        u32x4 row[8];
#pragma unroll
        for (int i = 0; i < 8; ++i) row[i] = *(const u32x4*)(proj + (size_t)(b * SEQ + t0 + i) * NPJ + C_MV + h * 128 + d8);
        __syncthreads();
        vt_store8(lds + ML_V, d8, s0, row);
    }
    __syncthreads();
    f32x4 acc[9];
#pragma unroll
    for (int mt = 0; mt < 9; ++mt) acc[mt] = (f32x4){0.f, 0.f, 0.f, 0.f};
#pragma unroll
    for (int ks = 0; ks < 4; ++ks) { const bf16x8 bk = *(const LAS bf16x8*)(lds + ML_K + (16 * wid + r) * TSTR + ks * 64 + quad * 16);
#pragma unroll
        for (int mt = 0; mt < 9; ++mt) { const bf16x8 av = *(const LAS bf16x8*)(lds + ML_V + (16 * mt + r) * TSTR + ks * 64 + quad * 16); acc[mt] = mfma16(av, bk, acc[mt]); } }
    bf16_t* U = (bf16_t*)(p.ws + WS_UST) + (size_t)item * USZ;
#pragma unroll
    for (int mt = 0; mt < 9; ++mt)
#pragma unroll
        for (int v = 0; v < 4; ++v) { const int dv = 16 * mt + 4 * quad + v; if (dv <= 128) U[dv * 128 + 16 * wid + r] = f2bf(acc[mt][v]); }
}

DI void sample_outproj(const Params& p, int unit) {
    const int lane = threadIdx.x & 63, wid = threadIdx.x >> 6, r = lane & 15, quad = lane >> 4;
    const int m0 = (unit >> 4) * 32 + (wid >> 2) * 16, n0 = (unit & 15) * 64 + (wid & 3) * 16;
    const bf16_t* A = (const bf16_t*)(p.ws + WS_WTOUT) + (size_t)(n0 + r) * DM + 8 * quad;
    const bf16_t* B = (const bf16_t*)(p.ws + WS_MIXED) + (size_t)(NTP + m0 + r) * DM + 8 * quad;
    f32x4 acc0 = {0.f, 0.f, 0.f, 0.f}, acc1 = {0.f, 0.f, 0.f, 0.f};
    const f32x4 xres = *(const f32x4*)(p.x_s + (size_t)(m0 + r) * DM + n0 + 4 * quad);
#pragma unroll
    for (int hb = 0; hb < 4; ++hb) { bf16x8 af[8], bfr[8];
#pragma unroll
        for (int ks = 0; ks < 8; ++ks) { af[ks] = *(const bf16x8*)(A + (hb * 8 + ks) * 32); bfr[ks] = *(const bf16x8*)(B + (hb * 8 + ks) * 32); }
#pragma unroll
        for (int ks = 0; ks < 8; ks += 2) { acc0 = mfma16(af[ks], bfr[ks], acc0); acc1 = mfma16(af[ks + 1], bfr[ks + 1], acc1); } }
    const size_t o = (size_t)(m0 + r) * DM + n0 + 4 * quad;
    *(f32x4*)(p.out + O_Y + (size_t)NTP * DM + o) = acc0 + acc1 + xres;
}
DI void mlstm_scan(const Params& p, LAS uchar* lds) {
    const int tid = threadIdx.x, nb = gridDim.x, bid = blockIdx.x;
    const bf16_t* UST = (const bf16_t*)(p.ws + WS_UST); bf16_t* SBF = (bf16_t*)(p.ws + WS_SB);
    LAS float* dcs = (LAS float*)lds;
    for (int it = nb - 1 - bid; it < 256; it += nb) sample_outproj(p, it);
    const int per = (8 * USZ + nb - 1) / nb, base = bid * per;
    const int lim = (base + per < 8 * USZ) ? base + per : 8 * USZ;
    const int eA = base + tid, eB = base + 512 + tid; const bool hasA = eA < lim, hasB = (tid < 64) && (eB < lim);
    const int ea = hasA ? eA : 0, eb2 = hasB ? eB : 0;
    const int bhA = ea / USZ, idxA = ea - bhA * USZ, bhB = eb2 / USZ, idxB = eb2 - bhB * USZ;
    const unsigned offA = (unsigned)(bhA * NCH * USZ + idxA), offB = (unsigned)(bhB * NCH * USZ + idxB);
    float ua[64];
#pragma unroll
    for (int j = 0; j < 64; ++j) ua[j] = __uint_as_float((unsigned)(UST + (size_t)j * USZ)[offA] << 16);
    __syncthreads();
    { const int bh = tid >> 6, c = tid & 63; const float2* FM = (const float2*)(p.ws + WS_FM) + (size_t)bh * SEQ;
      const float2 fe = FM[c * CH + CH - 1]; float2 pv = make_float2(0.f, 0.f); if (c > 0) pv = FM[c * CH - 1];
      dcs[tid] = __expf(fe.x - pv.x + pv.y - fe.y);
      if (bid == 0 && c == 63) p.out[O_MP + bh] = fe.y; }
    __syncthreads();
    if (hasA) { float SA = 0.f;
#pragma unroll
        for (int j = 0; j < 64; ++j) { (SBF + (size_t)j * USZ)[offA] = f2bf(SA); SA = dcs[bhA * 64 + j] * SA + ua[j]; }
        if (idxA < 16384) { const int dv = idxA >> 7, dk = idxA & 127; p.out[O_CP + (size_t)bhA * 16384 + dk * 128 + dv] = SA; } else p.out[O_NP + bhA * 128 + idxA - 16384] = SA; }
    if (tid < 64) {
        if (hasB) { float SB = 0.f;
#pragma unroll 1
            for (int c0 = 0; c0 < 64; c0 += 32) { float ub[32]; const bf16_t* Ub = UST + (size_t)c0 * USZ; const LAS float* db = dcs + bhB * 64 + c0;
#pragma unroll
                for (int j = 0; j < 32; ++j) ub[j] = __uint_as_float((unsigned)(Ub + (size_t)j * USZ)[offB] << 16);
#pragma unroll
                for (int j = 0; j < 32; ++j) { (SBF + (size_t)(c0 + j) * USZ)[offB] = f2bf(SB); SB = db[j] * SB + ub[j]; } }
            if (idxB < 16384) { const int dv = idxB >> 7, dk = idxB & 127; p.out[O_CP + (size_t)bhB * 16384 + dk * 128 + dv] = SB; } else p.out[O_NP + bhB * 128 + idxB - 16384] = SB; } }
}

DI void mlstm_out_item(const Params& p, LAS uchar* lds, int item) {
    const int tid = threadIdx.x, wid = tid >> 6, lane = tid & 63, r = lane & 15, quad = lane >> 4;
    const int c = item & 63, bh = item >> 6, b = bh >> 2, h = bh & 3;
    const bf16_t* proj = (const bf16_t*)(p.ws + WS_PROJ); const float* gates = (const float*)(p.ws + WS_GATES); const float2* FM = (const float2*)(p.ws + WS_FM) + (size_t)bh * SEQ;
    __syncthreads();
    {
        const bf16_t* St = (const bf16_t*)(p.ws + WS_SB) + (size_t)item * USZ;
        u32x4 sv[5];
#pragma unroll
        for (int k = 0; k < 5; ++k) { const int u = tid + 512 * k, dv = u >> 4, d8 = (u & 15) * 8; const int dvc = dv <= 128 ? dv : 128;
            sv[k] = *(const u32x4*)(St + dvc * 128 + d8); }
        const int isk = (tid >> 4) & 1, g8 = (tid & 15) * 8, s0 = (tid >> 5) * 8, t0 = c * CH + s0;
        ConvIn ci; conv_issue(p, proj, b, t0, (isk ? C_MK : C_MQ) + h * 128 + g8, isk * 512 + h * 128 + g8, ci);
        const int vd8 = (tid & 15) * 8, vs0 = (tid >> 4) * 4;
        u32x4 vrow[4];
#pragma unroll
        for (int i = 0; i < 4; ++i) vrow[i] = *(const u32x4*)(proj + (size_t)(b * SEQ + c * CH + vs0 + i) * NPJ + C_MV + h * 128 + vd8);
        if (tid < 128) { const int t = c * CH + tid; ((LAS float*)(lds + ML_AS))[tid] = gates[(size_t)(b * SEQ + t) * 8 + h] - FM[t].x; }
        vt_aug_rows(lds + ML_V, tid);
#pragma unroll
        for (int k = 0; k < 5; ++k) { const int u = tid + 512 * k, dv = u >> 4, d8 = (u & 15) * 8;
            if (u < 144 * 16) { u32x4 w = sv[k]; if (dv > 128) { w.x = 0u; w.y = 0u; w.z = 0u; w.w = 0u; }
                *(LAS u32x4*)(lds + ML_S + dv * TSTR + d8 * 2) = w; } }
        float y[8][8]; conv_compute(ci, t0, y);
#pragma unroll
        for (int i = 0; i < 8; ++i) { float f[8];
#pragma unroll
            for (int e = 0; e < 8; ++e) f[e] = isk ? y[i][e] * 0.08838834764831845f : y[i][e];
            *(LAS u32x4*)(lds + (isk ? ML_K : ML_Q) + (s0 + i) * TSTR + g8 * 2) = pack8(f); }
#pragma unroll
        for (int wd = 0; wd < 4; ++wd) { const unsigned a0 = vrow[0][wd], a1 = vrow[1][wd], a2 = vrow[2][wd], a3 = vrow[3][wd]; u32x2 ev, od;
            ev.x = (a0 & 0xffffu) | (a1 << 16); ev.y = (a2 & 0xffffu) | (a3 << 16); od.x = (a0 >> 16) | (a1 & 0xffff0000u); od.y = (a2 >> 16) | (a3 & 0xffff0000u);
            *(LAS u32x2*)(lds + ML_V + (vd8 + 2 * wd) * TSTR + vs0 * 2) = ev; *(LAS u32x2*)(lds + ML_V + (vd8 + 2 * wd + 1) * TSTR + vs0 * 2) = od; }
    }
    const int ti = 16 * wid + r, t = c * CH + ti; const float2 ft = FM[t]; float2 f0 = make_float2(0.f, 0.f); if (c > 0) f0 = FM[c * CH - 1];
    const bf16_t* rowp = proj + (size_t)(b * SEQ + t) * NPJ; bf16_t* mixed = (bf16_t*)(p.ws + WS_MIXED) + (size_t)(b * SEQ + t) * DM + 512 + h * 128;
    u32x2 ows[8], zws[8]; float4 nws[8];
#pragma unroll
    for (int mt = 0; mt < 8; ++mt) { const int dv = 16 * mt + 4 * quad; ows[mt] = *(const u32x2*)(rowp + C_MO + h * 128 + dv); zws[mt] = *(const u32x2*)(rowp + C_MZ + h * 128 + dv); nws[mt] = *(const float4*)(p.mhw + h * 128 + dv); }
    __syncthreads();
    bf16x8 qf[4];
#pragma unroll
    for (int ks = 0; ks < 4; ++ks) qf[ks] = *(const LAS bf16x8*)(lds + ML_Q + (16 * wid + r) * TSTR + ks * 64 + quad * 16);
    const float winter = __expf(ft.x - f0.x + f0.y - ft.y), bt = ft.x - ft.y;
    f32x4 acc[9];
#pragma unroll
    for (int mt = 0; mt < 9; ++mt) acc[mt] = (f32x4){0.f, 0.f, 0.f, 0.f};
#pragma unroll
    for (int ks = 0; ks < 4; ++ks)
#pragma unroll
        for (int mt = 0; mt < 9; ++mt) { const bf16x8 a = *(const LAS bf16x8*)(lds + ML_S + (16 * mt + r) * TSTR + ks * 64 + quad * 16); acc[mt] = mfma16(a, qf[ks], acc[mt]); }
#pragma unroll
    for (int mt = 0; mt < 9; ++mt) acc[mt] *= winter;
    const LAS float* as = (const LAS float*)(lds + ML_AS);
    for (int sp = 0; sp <= (wid >> 1); ++sp) {
        u32x4 pw;
#pragma unroll
        for (int half = 0; half < 2; ++half) { const int st = 2 * sp + half; f32x4 c4 = {0.f, 0.f, 0.f, 0.f};
            if (st <= wid) {
#pragma unroll
                for (int ks = 0; ks < 4; ++ks) { const bf16x8 a = *(const LAS bf16x8*)(lds + ML_K + (16 * st + r) * TSTR + ks * 64 + quad * 16); c4 = mfma16(a, qf[ks], c4); }
                const f32x4 av = *(const LAS f32x4*)(as + 16 * st + 4 * quad);
#pragma unroll
                for (int v = 0; v < 4; ++v) { const int si = 16 * st + 4 * quad + v; c4[v] = (si <= ti) ? c4[v] * __expf(bt + av[v]) : 0.f; } }
            if (half == 0) { pw.x = pk2(c4[0], c4[1]); pw.y = pk2(c4[2], c4[3]); } else { pw.z = pk2(c4[0], c4[1]); pw.w = pk2(c4[2], c4[3]); } }
        const bf16x8 pb = __builtin_bit_cast(bf16x8, pw);
#pragma unroll
        for (int mt = 0; mt < 9; ++mt) { const LAS uchar* vp = lds + ML_V + (16 * mt + r) * TSTR + (32 * sp + 4 * quad) * 2;
            u32x4 aw; const u32x2 lo = *(const LAS u32x2*)vp, hi = *(const LAS u32x2*)(vp + 32); aw.x = lo.x; aw.y = lo.y; aw.z = hi.x; aw.w = hi.y;
            acc[mt] = mfma16(__builtin_bit_cast(bf16x8, aw), pb, acc[mt]); } }
    const float den = __shfl(acc[8][0], r);
    const float inv = __builtin_amdgcn_rcpf(fmaxf(fabsf(den), __expf(-ft.y)));
    float ss = 0.f;
#pragma unroll
    for (int mt = 0; mt < 8; ++mt)
#pragma unroll
        for (int v = 0; v < 4; ++v) { acc[mt][v] *= inv; ss += acc[mt][v] * acc[mt][v]; }
    ss += __shfl_xor(ss, 16); ss += __shfl_xor(ss, 32);
    const float rstd = rsqrtf(ss * (1.0f / 128) + 1e-6f);
#pragma unroll
    for (int mt = 0; mt < 8; ++mt) { const int dv = 16 * mt + 4 * quad; const u32x2 ow = ows[mt], zw = zws[mt];
        const float4 nw = nws[mt];
        const f32x2 o0 = (f32x2){bflo(ow.x), bfhi(ow.x)}, o1 = (f32x2){bflo(ow.y), bfhi(ow.y)}, z0 = (f32x2){bflo(zw.x), bfhi(zw.x)}, z1 = (f32x2){bflo(zw.y), bfhi(zw.y)};
        const f32x2 ao0 = o0 * -1.4426950408889634f, ao1 = o1 * -1.4426950408889634f, az0 = z0 * -1.4426950408889634f, az1 = z1 * -1.4426950408889634f;
        f32x2 eo0, eo1, ez0, ez1; eo0.x = __builtin_amdgcn_exp2f(ao0.x); eo0.y = __builtin_amdgcn_exp2f(ao0.y); eo1.x = __builtin_amdgcn_exp2f(ao1.x); eo1.y = __builtin_amdgcn_exp2f(ao1.y);
        ez0.x = __builtin_amdgcn_exp2f(az0.x); ez0.y = __builtin_amdgcn_exp2f(az0.y); ez1.x = __builtin_amdgcn_exp2f(az1.x); ez1.y = __builtin_amdgcn_exp2f(az1.y);
        const f32x2 d0 = (eo0 + 1.0f) * (ez0 + 1.0f), d1 = (eo1 + 1.0f) * (ez1 + 1.0f);
        f32x2 r0, r1; r0.x = __builtin_amdgcn_rcpf(d0.x); r0.y = __builtin_amdgcn_rcpf(d0.y); r1.x = __builtin_amdgcn_rcpf(d1.x); r1.y = __builtin_amdgcn_rcpf(d1.y);
        const f32x2 h0 = (f32x2){acc[mt][0], acc[mt][1]}, h1 = (f32x2){acc[mt][2], acc[mt][3]};
        const f32x2 y0 = h0 * rstd * (f32x2){nw.x, nw.y} * z0 * r0, y1 = h1 * rstd * (f32x2){nw.z, nw.w} * z1 * r1;
        u32x2 w; w.x = pk2(y0.x, y0.y); w.y = pk2(y1.x, y1.y);
        *(u32x2*)(mixed + dv) = w; }
}

DI void mlstm_sample_item(const Params& p, LAS uchar* lds, int item) {
    const int tid = threadIdx.x, wid = tid >> 6, lane = tid & 63;
    const int h = item & 3, b = item >> 2;
    const bf16_t* proj = (const bf16_t*)(p.ws + WS_PROJ); const float* gates = (const float*)(p.ws + WS_GATES);
    LAS float* qs = (LAS float*)lds;
    LAS float* ks = qs + 512;
    LAS float* vs = ks + 512;
    LAS float* red = vs + 512;
    LAS float* dred = red + 2048;
    LAS float* sred = dred + 8;
    __syncthreads();
    const int dv = tid & 127, dkq = tid >> 7;
    const float* S0 = p.sC + ((size_t)(b * 4 + h) * 128 + dkq * 32) * 128 + dv;
    float S[32];
#pragma unroll
    for (int i = 0; i < 32; ++i) S[i] = S0[(size_t)i * 128];
    float nn = 0.f; if (tid < 128) nn = p.sn[(size_t)(b * 4 + h) * 128 + tid];
    const bf16_t* rowf = proj + (size_t)(NTP + b * 4 + (tid >> 7)) * NPJ;
    const unsigned ogr = rowf[C_MO + h * 128 + dv], zgr = rowf[C_MZ + h * 128 + dv]; const float mhr = p.mhw[h * 128 + dv];
    float cvs[2];
#pragma unroll
    for (int i = tid; i < 1024; i += 512) { const int t = i >> 8, lc = i & 255, ch = (lc < 128 ? 0 : 512) + h * 128 + (lc & 127);
        float y = p.conv_b[ch]; float xx[4], ww[4];
#pragma unroll
        for (int j = 0; j < 4; ++j) { const int tt = t - 3 + j; ww[j] = p.conv_w[j * 1024 + ch];
            if (tt < 0) xx[j] = p.sconv[(size_t)(b * 3 + 3 + tt) * 1024 + ch];
            else xx[j] = __uint_as_float((unsigned)proj[(size_t)(NTP + b * 4 + tt) * NPJ + C_MQ + ch] << 16); }
#pragma unroll
        for (int j = 0; j < 4; ++j) y += ww[j] * xx[j];
        cvs[i >> 9] = xx[3];
        y = silu(y);
        if (lc < 128) qs[t * 128 + lc] = y; else ks[t * 128 + (lc - 128)] = y * 0.08838834764831845f; }
    { const int t = tid >> 7, dv = tid & 127; vs[tid] = __uint_as_float((unsigned)proj[(size_t)(NTP + b * 4 + t) * NPJ + C_MV + h * 128 + dv] << 16); }
    float mt_[4], fd[4], iw[4];
    { float mprev = p.sm[b * 4 + h];
#pragma unroll
      for (int t = 0; t < 4; ++t) { const float* g = gates + (size_t)(NTP + b * 4 + t) * 8; const float li = g[h], lf = g[4 + h];
          const float m = fmaxf(lf + mprev, li); fd[t] = __expf(lf + mprev - m); iw[t] = __expf(li - m); mt_[t] = m; mprev = m; } }
    __syncthreads();
#pragma unroll
    for (int t = 0; t < 4; ++t) { const float vt = vs[t * 128 + dv] * iw[t]; float part = 0.f;
        f32x2 part2 = {0.f, 0.f};
#pragma unroll
        for (int i = 0; i < 32; i += 4) { const f32x4 k4 = *(const LAS f32x4*)(ks + t * 128 + dkq * 32 + i), q4 = *(const LAS f32x4*)(qs + t * 128 + dkq * 32 + i);
            f32x2 s01 = (f32x2){S[i], S[i + 1]}, s23 = (f32x2){S[i + 2], S[i + 3]};
            s01 = s01 * fd[t] + (f32x2){k4[0], k4[1]} * vt; s23 = s23 * fd[t] + (f32x2){k4[2], k4[3]} * vt;
            part2 += (f32x2){q4[0], q4[1]} * s01; part2 += (f32x2){q4[2], q4[3]} * s23;
            S[i] = s01.x; S[i + 1] = s01.y; S[i + 2] = s23.x; S[i + 3] = s23.y; }
        part = part2.x + part2.y;
        red[(dkq * 4 + t) * 128 + dv] = part;
        if (tid < 128) { nn = fd[t] * nn + iw[t] * ks[t * 128 + tid]; const float dp = wsum(qs[t * 128 + tid] * nn); if (lane == 0) dred[t * 2 + wid] = dp; } }
    float* Sout = p.out + O_CS + ((size_t)(b * 4 + h) * 128 + dkq * 32) * 128 + dv;
#pragma unroll
    for (int i = 0; i < 32; ++i) Sout[(size_t)i * 128] = S[i];
#pragma unroll
    for (int q = 0; q < 2; ++q) { const int i = tid + 512 * q, t = i >> 8, lc = i & 255, ch = (lc < 128 ? 0 : 512) + h * 128 + (lc & 127); if (t >= 1) p.out[O_CONVS + (size_t)(b * 3 + t - 1) * 1024 + ch] = cvs[q]; }
    if (tid < 128) p.out[O_NS + (size_t)(b * 4 + h) * 128 + tid] = nn;
    if (tid == 0) p.out[O_MS + b * 4 + h] = mt_[3];
    __syncthreads();
    { const int t = tid >> 7; const float num = red[(0 * 4 + t) * 128 + dv] + red[(1 * 4 + t) * 128 + dv] + red[(2 * 4 + t) * 128 + dv] + red[(3 * 4 + t) * 128 + dv];
      const float den = dred[t * 2] + dred[t * 2 + 1];
      const float mtv = t == 0 ? mt_[0] : t == 1 ? mt_[1] : t == 2 ? mt_[2] : mt_[3];
      const float hv = num / fmaxf(fabsf(den), __expf(-mtv));
      const float sq = wsum(hv * hv); if (lane == 0) sred[t * 2 + (wid & 1)] = sq;
      __syncthreads();
      const float rstd = rsqrtf((sred[t * 2] + sred[t * 2 + 1]) * (1.0f / 128) + 1e-6f);
      const size_t row = (size_t)(NTP + b * 4 + t);
      const float og = sigm(__uint_as_float(ogr << 16)), zg = silu(__uint_as_float(zgr << 16));
      ((bf16_t*)(p.ws + WS_MIXED))[row * DM + 512 + h * 128 + dv] = f2bf(hv * rstd * mhr * og * zg); }
}

DI void phase2(const Params& p, LAS uchar* lds) {
    const int nb = gridDim.x, bid = blockIdx.x, tid = threadIdx.x;
#ifndef REP_AP
#define REP_AP 1
#define REP_MU 1
#define REP_AS 1
#define REP_MS 1
#endif
    for (int rp = 0; rp < REP_AP; ++rp) for (int it = bid; it < 256; it += nb) attn_prompt_item(p, lds, it);
    for (int rp = 0; rp < REP_MU; ++rp) for (int it = bid; it < 512; it += nb) mlstm_u_item(p, lds, it);
    for (int rp = 0; rp < REP_AS; ++rp) for (int it = bid; it < 256; it += nb) attn_sample_item(p, lds, it);
    for (int rp = 0; rp < REP_MS; ++rp) for (int it = bid; it < 512; it += nb) mlstm_sample_item(p, lds, it);
    for (int i = bid * 512 + tid; i < 6144; i += nb * 512) { const int ch = i & 1023, rr = (i >> 10) % 3, b = i / 3072;
        p.out[O_CONVP + i] = __uint_as_float((unsigned)((const bf16_t*)(p.ws + WS_PROJ))[(size_t)(b * SEQ + SEQ - 3 + rr) * NPJ + C_MQ + ch] << 16); }
}
DI void phase4(const Params& p, LAS uchar* lds) {
    const int nb = gridDim.x, bid = blockIdx.x;
    for (int it = bid; it < 512; it += nb) mlstm_out_item(p, lds, it);
}

__global__ __launch_bounds__(512, 2) void hymba_mega(Params p, int ph_lo, int ph_hi) {
    extern __shared__ __attribute__((aligned(16))) unsigned char shm[];
    LAS uchar* lds = (LAS uchar*)shm;
    volatile LAS unsigned* st = (volatile LAS unsigned*)(lds + LDS_MAIN);
    if (threadIdx.x == 0) { st[0] = 0u; st[1] = 0u; }
    __syncthreads();
    const XcdBarrier xb = xcd_barrier_post((unsigned*)(p.ws + WS_BAR), st);
#ifdef PROBE_K
#define STAMP(i) ts[i] = wall_clock64();
    unsigned long long ts[7];
#else
#define STAMP(i)
#endif
#define RUNPH(n, call) if (ph_lo <= n && n < ph_hi) { if (ph_lo < n) xcd_barrier(xb); STAMP(n) call; }
    RUNPH(0, phase0(p, lds)) RUNPH(1, phase1(p, lds)) RUNPH(2, phase2(p, lds)) RUNPH(3, mlstm_scan(p, lds)) RUNPH(4, phase4(p, lds)) RUNPH(5, phase5(p, lds))
#ifdef PROBE_K
    xcd_barrier(xb); STAMP(6)
    if (blockIdx.x == 0 && threadIdx.x == 0) { const unsigned long long dt = (ts[PROBE_K + 1] - ts[PROBE_K]) * 4ull; while (wall_clock64() - ts[6] < dt) __builtin_amdgcn_s_sleep(8); }
#endif
}

#ifndef N_LAUNCHES
#define N_LAUNCHES 1
#endif
extern "C" void kernel_launch(void* const* d_in, const int* in_sizes, int n_in, void* d_out, int out_size, void* d_ws, size_t ws_size, hipStream_t stream) {
    static int grid = 0;
    if (grid == 0) {
        int dev = 0, cus = 0, per_cu = 0;
        hipGetDevice(&dev); hipDeviceGetAttribute(&cus, hipDeviceAttributeMultiprocessorCount, dev);
        if (hipFuncSetAttribute((const void*)hymba_mega, hipFuncAttributeMaxDynamicSharedMemorySize, LDS_BYTES) != hipSuccess) { fprintf(stderr, "hipFuncSetAttribute failed\n"); }
        if (hipOccupancyMaxActiveBlocksPerMultiprocessor(&per_cu, (const void*)hymba_mega, 512, LDS_BYTES) != hipSuccess || per_cu < 1) { fprintf(stderr, "occupancy query: %d\n", per_cu); per_cu = 1; }
        (void)hipGetLastError();
        grid = cus * per_cu;
        if (ws_size < WS_END || n_in != 18) { fprintf(stderr, "bad ws/n_in\n"); grid = -1; }
    }
    if (grid < 0) return;
    if (hipMemsetAsync((char*)d_ws + WS_BAR, 0, XCD_BAR_WORDS * sizeof(unsigned), stream) != hipSuccess) { fprintf(stderr, "memset failed\n"); return; }
    Params p{};
    p.x_p = (const float*)d_in[0]; p.x_s = (const float*)d_in[1]; p.ck = (const float*)d_in[2]; p.cv = (const float*)d_in[3]; p.sconv = (const float*)d_in[4];
    p.sC = (const float*)d_in[5]; p.sn = (const float*)d_in[6]; p.sm = (const float*)d_in[7]; p.norm_w = (const float*)d_in[8]; p.w_in = (const float*)d_in[9];
    p.b_gates = (const float*)d_in[10]; p.conv_w = (const float*)d_in[11]; p.conv_b = (const float*)d_in[12]; p.qnw = (const float*)d_in[13]; p.knw = (const float*)d_in[14];
    p.sinks = (const float*)d_in[15]; p.mhw = (const float*)d_in[16]; p.w_out = (const float*)d_in[17];
    p.out = (float*)d_out; p.ws = (uchar*)d_ws;
    if (N_LAUNCHES == 1) {
#ifdef PLAIN_LAUNCH
        hipLaunchKernelGGL(hymba_mega, dim3(grid), dim3(512), LDS_BYTES, stream, p, 0, 6);
#else
        int lo = 0, hi = 6; void* args[] = {&p, &lo, &hi};
        hipError_t e = hipLaunchCooperativeKernel((const void*)hymba_mega, dim3(grid), dim3(512), args, LDS_BYTES, stream);
        if (e != hipSuccess) fprintf(stderr, "cooperative launch failed: %s (grid %d)\n", hipGetErrorString(e), grid);
#endif
    } else {
#ifndef PHLIST
#define PHLIST {0, 1, 2, 3, 4, 5}
#endif
        const int phl[] = PHLIST;
        for (int i = 0; i < (int)(sizeof(phl) / sizeof(int)); ++i) hipLaunchKernelGGL(hymba_mega, dim3(grid), dim3(512), LDS_BYTES, stream, p, phl[i], phl[i] + 1);
    }
}
```

```cpp
#define N_LAUNCHES 1
#include <hip/hip_runtime.h>
#include <hip/hip_cooperative_groups.h>
#include <cstdio>
namespace cg = cooperative_groups;
#define LAS __attribute__((address_space(3)))
namespace pg8 {
#define PG8_LAS __attribute__((address_space(3)))
typedef unsigned short bf16_t;
typedef short bf16x8 __attribute__((ext_vector_type(8)));
typedef float f32x4 __attribute__((ext_vector_type(4)));
typedef unsigned u32x4 __attribute__((ext_vector_type(4)));
constexpr int BM = 256, BK = 64, HALF = 128, HTB = HALF * BK * 2  , STAGE_BYTES = 8 * HTB, NXCD = 8, WGM = 8;

__host__ __device__ __forceinline__ int lds_byte(int r, int c) { const int st = (r >> 4) * 2 + (c >> 5), rr = r & 15, cc = c & 31, ob = rr * 64 + cc * 2; return st * 1024 + (ob ^ (((ob >> 9) & 1) << 5)); }
__host__ __device__ __forceinline__ void stage_rc(int b, int& R, int& C) { const int st = b / 1024, sb = b % 1024, swz = sb ^ (((sb >> 9) & 1) << 5); R = (st >> 1) * 16 + swz / 64; C = (st & 1) * 32 + (swz % 64) / 2; }
__host__ __device__ __forceinline__ int perm32(int rho) { const int n = rho >> 4, i = rho & 15; return 8 * (i >> 2) + 4 * n + (i & 3); }

struct Unit { int pm, pn; };
struct Gemm { const bf16_t* A; const bf16_t* Bt; int M, N, K; };

struct StaticOrder {
    int nM, nN, nwg, G, c;
    __host__ __device__ void init(int M, int N, int G_, int c_) { nM = M / BM; nN = N / BM; nwg = nM * nN; G = G_; c = c_; }
    __host__ __device__ bool next(int i, Unit& u) const {
        const long L = (long)i * G + c; if (L >= nwg) return false;
        int wgid = (int)L; { const int q = nwg / NXCD, r = nwg % NXCD, xcd = wgid % NXCD, off = wgid / NXCD; wgid = (xcd < r ? xcd * (q + 1) : r * (q + 1) + (xcd - r) * q) + off; }
        const int nig = WGM * nN, gid = wgid / nig, fm = gid * WGM, gsz = (nM - fm) < WGM ? (nM - fm) : WGM;
        u.pm = fm + ((wgid % nig) % gsz); u.pn = (wgid % nig) / gsz; return true;
    }
    __device__ __forceinline__ void a_ready(const Unit&) const {}
    __device__ __forceinline__ void done(const Unit&) const {}
};
__device__ __forceinline__ unsigned cvt_pk_bf16(float lo, float hi) { unsigned r; asm volatile("v_cvt_pk_bf16_f32 %0, %1, %2" : "=v"(r) : "v"(lo), "v"(hi)); return r; }
template <class Epi, class Sched, bool STAMP = false>
__device__ __forceinline__ void gemm_phase(PG8_LAS unsigned char* lds, const Gemm g, const Sched& S, const Epi& E, unsigned long long* stamps) {
    const int tid = threadIdx.x, wid = __builtin_amdgcn_readfirstlane(tid >> 6), lane = tid & 63, wr = wid >> 2, wc = wid & 3, fr = lane & 15, fq = lane >> 4;
    const int K = g.K, nt = K / BK;
    int ts_lo = 0, ts_hi = 0, nts = 0; const unsigned long long rt_entry = STAMP ? (unsigned long long)wall_clock64() : 0ull;
#define PG8_STAMP() do { if (STAMP && wid == 0 && nts < 64) { const unsigned long long _c = (unsigned long long)clock64(); \
        ts_lo = (lane == nts) ? (int)(unsigned)_c : ts_lo; ts_hi = (lane == nts) ? (int)(unsigned)(_c >> 32) : ts_hi; ++nts; } } while (0)
    PG8_STAMP();
    unsigned voffA[2], voffB[2];
#pragma unroll
    for (int i = 0; i < 2; ++i) { int R, C; stage_rc(tid * 16 + i * 8192, R, C); const int Rb = Epi::PERM ? ((R & ~31) + perm32(R & 31)) : R;
        voffA[i] = (unsigned)(R * K + C) * 2u; voffB[i] = (unsigned)(Rb * K + C) * 2u; }
    const size_t kstep = (size_t)(BK * 2);
    const size_t hstep = (size_t)HALF * K * 2;
    const size_t tstep = 2 * hstep;
    const unsigned ldsw = (unsigned)wid * 1024u;
    const int aoff = lds_byte(wr * 64 + fr, fq * 8), boff = lds_byte(wc * 32 + fr, fq * 8);
#define PG8_SA(b, h) (((b) * 2 + (h)) * HTB)
#define PG8_SB(b, h) ((4 + (b) * 2 + (h)) * HTB)
#define PG8_STAGE(bufoff, gbase, voff) do { _Pragma("unroll") for (int _i = 0; _i < 2; ++_i) \
        __builtin_amdgcn_global_load_lds((const unsigned*)((const char*)(gbase) + (voff)[_i]), (PG8_LAS unsigned*)(lds + (bufoff) + ldsw + _i * 8192), 16, 0, 0); } while (0)
#define PG8_LDA(dst, b, h) do { _Pragma("unroll") for (int m = 0; m < 4; ++m) _Pragma("unroll") for (int k = 0; k < 2; ++k) dst[m][k] = *(const PG8_LAS bf16x8*)(lds + PG8_SA(b, h) + aoff + m * 2048 + k * 1024); } while (0)
#define PG8_LDB(dst, b, h) do { _Pragma("unroll") for (int n = 0; n < 2; ++n) _Pragma("unroll") for (int k = 0; k < 2; ++k) dst[n][k] = *(const PG8_LAS bf16x8*)(lds + PG8_SB(b, h) + boff + n * 2048 + k * 1024); } while (0)
#define PG8_MMA(ai, bj, At, Bt) do { __builtin_amdgcn_s_setprio(1); _Pragma("unroll") for (int m = 0; m < 4; ++m) _Pragma("unroll") for (int n = 0; n < 2; ++n) _Pragma("unroll") for (int k = 0; k < 2; ++k) \
        acc[ai][bj][m][n] = __builtin_amdgcn_mfma_f32_16x16x32_bf16(Bt[n][k], At[m][k], acc[ai][bj][m][n], 0, 0, 0); __builtin_amdgcn_s_setprio(0); } while (0)
#define PG8_WAIT_V(n) asm volatile("s_waitcnt vmcnt(" #n ")" ::: "memory")
#define PG8_WAIT_L(n) asm volatile("s_waitcnt lgkmcnt(" #n ")" ::: "memory")
#define PG8_BAR __builtin_amdgcn_s_barrier()
#define PG8_SCHED __builtin_amdgcn_sched_barrier(0)
    Unit cur, nxt; int ui = 0;
    if (!S.next(0, cur)) return;
    f32x4 acc[2][2][4][2];
#pragma unroll
    for (int a = 0; a < 2; ++a)
#pragma unroll
        for (int b = 0; b < 2; ++b)
#pragma unroll
            for (int m = 0; m < 4; ++m)
#pragma unroll
                for (int n = 0; n < 2; ++n) acc[a][b][m][n] = (f32x4){0.f, 0.f, 0.f, 0.f};
    bf16x8 At[4][2], B0[2][2], B1[2][2];
    const char* cA = (const char*)g.A + (size_t)cur.pm * tstep; const char* cB = (const char*)g.Bt + (size_t)cur.pn * tstep;
    S.a_ready(cur);
    PG8_STAGE(PG8_SB(0, 0), cB, voffB); PG8_STAGE(PG8_SA(0, 0), cA, voffA); PG8_STAGE(PG8_SB(0, 1), cB + hstep, voffB); PG8_STAGE(PG8_SA(0, 1), cA + hstep, voffA);
    if (wr == 1) PG8_BAR;
    PG8_WAIT_V(4); PG8_BAR;
    PG8_STAGE(PG8_SB(1, 0), cB + kstep, voffB); PG8_STAGE(PG8_SA(1, 0), cA + kstep, voffA); PG8_STAGE(PG8_SB(1, 1), cB + hstep + kstep, voffB);
    PG8_WAIT_V(6); PG8_BAR;
    PG8_STAMP();
    for (;;) {
        const bool has_next = S.next(ui + 1, nxt);
        const char* nA = has_next ? (const char*)g.A + (size_t)nxt.pm * tstep : cA; const char* nB = has_next ? (const char*)g.Bt + (size_t)nxt.pn * tstep : cB;
        for (int t = 0; t < nt; t += 2) {
            const bool last = (t == nt - 2);
            const char* a1 = cA + (size_t)(t + 1) * kstep;
            const char* a2 = last ? nA : cA + (size_t)(t + 2) * kstep; const char* b2 = last ? nB : cB + (size_t)(t + 2) * kstep;
            const char* a3 = a2 + kstep; const char* b3 = b2 + kstep;
            if (last && has_next) S.a_ready(nxt);
            PG8_LDB(B0, 0, 0); PG8_SCHED; PG8_LDA(At, 0, 0); PG8_STAGE(PG8_SA(1, 1), a1 + hstep, voffA);
            PG8_WAIT_L(8); PG8_BAR; PG8_WAIT_L(0); PG8_MMA(0, 0, At, B0); PG8_BAR; PG8_SCHED;
            PG8_LDB(B1, 0, 1); PG8_STAGE(PG8_SB(0, 0), b2, voffB);
            PG8_BAR; PG8_WAIT_L(0); PG8_MMA(0, 1, At, B1); PG8_BAR;
            PG8_LDA(At, 0, 1); PG8_STAGE(PG8_SA(0, 0), a2, voffA);
            PG8_BAR; PG8_WAIT_L(0); PG8_MMA(1, 0, At, B0); PG8_BAR; PG8_SCHED;
            PG8_STAGE(PG8_SB(0, 1), b2 + hstep, voffB);
            PG8_WAIT_V(6); PG8_BAR; PG8_MMA(1, 1, At, B1); PG8_BAR;
            PG8_LDB(B0, 1, 0); PG8_SCHED; PG8_LDA(At, 1, 0); PG8_STAGE(PG8_SA(0, 1), a2 + hstep, voffA);
            PG8_WAIT_L(8); PG8_BAR; PG8_WAIT_L(0); PG8_MMA(0, 0, At, B0); PG8_BAR; PG8_SCHED;
            PG8_LDB(B1, 1, 1); PG8_STAGE(PG8_SB(1, 0), b3, voffB);
            PG8_BAR; PG8_WAIT_L(0); PG8_MMA(0, 1, At, B1); PG8_BAR;
            PG8_LDA(At, 1, 1); PG8_STAGE(PG8_SA(1, 0), a3, voffA);
            PG8_BAR; PG8_WAIT_L(0); PG8_MMA(1, 0, At, B0); PG8_BAR; PG8_SCHED;
            PG8_STAGE(PG8_SB(1, 1), b3 + hstep, voffB);
            PG8_WAIT_V(6); PG8_BAR; PG8_MMA(1, 1, At, B1); PG8_BAR;
        }
        PG8_STAMP();
        if constexpr (!Epi::AFTER_DRAIN) { E(acc, cur, wr, wc, fr, fq); S.done(cur); }
        PG8_STAMP();
        if (!has_next) break;
#pragma unroll
        for (int a = 0; a < 2; ++a)
#pragma unroll
            for (int b = 0; b < 2; ++b)
#pragma unroll
                for (int m = 0; m < 4; ++m)
#pragma unroll
                    for (int n = 0; n < 2; ++n) acc[a][b][m][n] = (f32x4){0.f, 0.f, 0.f, 0.f};
        cur = nxt; cA = nA; cB = nB; ++ui;
    }
    PG8_WAIT_V(0);
    if (wr == 0) PG8_BAR;
    PG8_BAR;
    if constexpr (Epi::AFTER_DRAIN) { E.fused(acc, cur, wr, wc, fr, fq, lds, wid, lane); S.done(cur); }
    PG8_STAMP();
    if (STAMP && wid == 0) { stamps[lane] = lane < nts ? (((unsigned long long)(unsigned)ts_hi << 32) | (unsigned)ts_lo) : 0ull;
        if (lane == 62) stamps[62] = rt_entry; if (lane == 63) stamps[63] = (unsigned long long)wall_clock64(); }
#undef PG8_STAMP
#undef PG8_SA
#undef PG8_SB
#undef PG8_STAGE
#undef PG8_LDA
#undef PG8_LDB
#undef PG8_MMA
#undef PG8_WAIT_V
#undef PG8_WAIT_L
#undef PG8_BAR
#undef PG8_SCHED
}
}

#define XB_TMO      128
#define XB_XCNT(j)  (256  + 64 * (j))
#define XB_XSUB(j)  (1280 + 64 * (j))
#define XB_XGEN(j)  (2304 + 64 * (j))
#define XB_TOP      3328
#define XB_TOPGEN   3392
#define XCD_BAR_WORDS 3456
#define XB_SPIN_CAP (1u << 18)

__device__ __forceinline__ unsigned xb_ld(unsigned* p)              { return __hip_atomic_load(p, __ATOMIC_RELAXED, __HIP_MEMORY_SCOPE_AGENT); }
__device__ __forceinline__ unsigned xb_add(unsigned* p, unsigned v) { return __hip_atomic_fetch_add(p, v, __ATOMIC_RELAXED, __HIP_MEMORY_SCOPE_AGENT); }
__device__ __forceinline__ unsigned xb_xcc_id() { return (unsigned)__builtin_amdgcn_s_getreg((3 << 11) | 20) & 0xFu; }
#define XB_SPIN(cond, bar) do { unsigned _sp = 0; while (cond) { __builtin_amdgcn_s_sleep(1); \
    if ((++_sp & 255u) == 0u) { if (xb_ld(&(bar)[XB_TMO])) break; if (_sp > XB_SPIN_CAP) { atomicAdd(&(bar)[XB_TMO], 1u); break; } } } } while (0)

struct XcdBarrier {
    unsigned* bar; unsigned x;
    volatile LAS unsigned* st;
};

__device__ __forceinline__ XcdBarrier xcd_barrier_post(unsigned* bar, volatile LAS unsigned* st) {
    XcdBarrier b; b.bar = bar; b.x = xb_xcc_id(); b.st = st;
    if (threadIdx.x == 0) (void)xb_add(&bar[XB_XCNT(b.x)], 1u);
    return b;
}
__device__ __forceinline__ void xcd_barrier_complete(unsigned* bar, unsigned x, unsigned& nloc, unsigned& nx) {
    const unsigned G = gridDim.x * gridDim.y * gridDim.z;
    unsigned sum, cnt, mine, sp = 0u;
    for (;;) {
        sum = 0u; cnt = 0u; mine = 0u;
#pragma unroll
        for (unsigned j = 0; j < 16; ++j) { const unsigned c = xb_ld(&bar[XB_XCNT(j)]); sum += c; cnt += (c > 0u) ? 1u : 0u; mine = (j == x) ? c : mine; }
        if (sum == G) break;
        __builtin_amdgcn_s_sleep(1);
        if ((++sp & 255u) == 0u) { if (xb_ld(&bar[XB_TMO])) break; if (sp > XB_SPIN_CAP) { atomicAdd(&bar[XB_TMO], 1u); break; } }
    }
    nloc = mine > 0u ? mine : 1u; nx = cnt > 0u ? cnt : 1u;
}

__device__ __forceinline__ void xcd_barrier(const XcdBarrier& b) {
    asm volatile("s_waitcnt vmcnt(0)" ::: "memory");
    __syncthreads();
    if (threadIdx.x == 0) {
        unsigned* bar = b.bar;
        __builtin_amdgcn_s_waitcnt(0);
        unsigned nloc = b.st[0], nx = b.st[1];
        if (nloc == 0u) { xcd_barrier_complete(bar, b.x, nloc, nx); b.st[0] = nloc; b.st[1] = nx; }
        const unsigned old = xb_add(&bar[XB_XSUB(b.x)], 1u);
        const unsigned gen = old / nloc;
        if (old + 1u == (gen + 1u) * nloc) {
            __builtin_amdgcn_fence(__ATOMIC_RELEASE, "agent");
            asm volatile("s_waitcnt vmcnt(0)" ::: "memory");
            const unsigned og = xb_add(&bar[XB_TOP], 1u);
            const unsigned tg = og / nx;
            if (og + 1u == (tg + 1u) * nx) xb_add(&bar[XB_TOPGEN], 1u);
            else XB_SPIN(xb_ld(&bar[XB_TOPGEN]) == tg, bar);
            __builtin_amdgcn_fence(__ATOMIC_ACQUIRE, "agent");
            xb_add(&bar[XB_XGEN(b.x)], 1u);
            asm volatile("s_waitcnt vmcnt(0)" ::: "memory");
        } else {
            XB_SPIN(xb_ld(&bar[XB_XGEN(b.x)]) == gen, bar);
            __builtin_amdgcn_fence(__ATOMIC_ACQUIRE, "agent");
            asm volatile("s_waitcnt vmcnt(0)" ::: "memory");
        }
    }
    __syncthreads();
}

using pg8::bf16_t; using pg8::bf16x8; using pg8::f32x4; using pg8::u32x4;
#define DI __device__ __forceinline__
typedef unsigned char uchar;
typedef unsigned u32x2 __attribute__((ext_vector_type(2)));

constexpr int NTP = 16384, NTS = 512, NTOK = 16896, DM = 1024, DIN = 3848, NPJ = 3840, SEQ = 8192;
constexpr int C_AQ = 0, C_AK = 512, C_AV = 640, C_AG = 768, C_MQ = 1280, C_MK = 1792, C_MV = 2304, C_MO = 2816, C_MZ = 3328;
constexpr int NCH = 64, CH = 128, USZ = 129 * 128;
constexpr size_t O_Y = 0, O_KWP = 17301504, O_VWP = 17334272, O_CONVP = 17367040, O_CP = 17373184, O_NP = 17504256, O_MP = 17505280,
                 O_KWS = 17505288, O_VWS = 19602440, O_CONVS = 21699592, O_CS = 22092808, O_NS = 30481416, O_MS = 30546952;
constexpr size_t WS_WTIN = 0, WS_WTOUT = 7864320, WS_H = 9961472, WS_GATES = 44564480, WS_ROPE = 45105152, WS_FM = 45637632,
                 WS_PROJ = 46161920, WS_UST = 175923200, WS_MIXED = 209739776, WS_BAR = 244342784, WS_SB = 244342784 + 16384, WS_END = WS_SB + 16908288;
constexpr int LDS_MAIN = 151552, LDS_BYTES = LDS_MAIN + 16;

struct Params {
    const float *x_p, *x_s, *ck, *cv, *sconv, *sC, *sn, *sm, *norm_w, *w_in, *b_gates, *conv_w, *conv_b, *qnw, *knw, *sinks, *mhw, *w_out;
    float* out; uchar* ws;
};

DI float bflo(unsigned w) { return __uint_as_float(w << 16); }
DI float bfhi(unsigned w) { return __uint_as_float(w & 0xffff0000u); }
DI unsigned pk2(float a, float b) { return pg8::cvt_pk_bf16(a, b); }
DI bf16_t f2bf(float f) { unsigned u = __float_as_uint(f); u += 0x7fffu + ((u >> 16) & 1u); return (bf16_t)(u >> 16); }
DI void unpack8(const u32x4 w, float (&f)[8]) { f[0] = bflo(w.x); f[1] = bfhi(w.x); f[2] = bflo(w.y); f[3] = bfhi(w.y); f[4] = bflo(w.z); f[5] = bfhi(w.z); f[6] = bflo(w.w); f[7] = bfhi(w.w); }
DI u32x4 pack8(const float (&f)[8]) { u32x4 w; w.x = pk2(f[0], f[1]); w.y = pk2(f[2], f[3]); w.z = pk2(f[4], f[5]); w.w = pk2(f[6], f[7]); return w; }
DI float wsum(float v) { for (int o = 32; o; o >>= 1) v += __shfl_xor(v, o); return v; }
DI float silu(float x) { return x * __builtin_amdgcn_rcpf(1.0f + __builtin_amdgcn_exp2f(-1.4426950408889634f * x)); }
DI float sigm(float x) { return __builtin_amdgcn_rcpf(1.0f + __builtin_amdgcn_exp2f(-1.4426950408889634f * x)); }
DI f32x4 mfma16(bf16x8 a, bf16x8 b, f32x4 c) { return __builtin_amdgcn_mfma_f32_16x16x32_bf16(a, b, c, 0, 0, 0); }

typedef float f32x2g __attribute__((ext_vector_type(2)));
DI void norm_row(const Params& p, const LAS float* wg, int row, const float4 (&xv)[4], const float4 (&nw)[4], float bgl, int lane) {
    bf16_t* H = (bf16_t*)(p.ws + WS_H); float* gates = (float*)(p.ws + WS_GATES);
    float ss = 0.f;
#pragma unroll
    for (int i = 0; i < 4; ++i) ss += xv[i].x * xv[i].x + xv[i].y * xv[i].y + xv[i].z * xv[i].z + xv[i].w * xv[i].w;
    ss = wsum(ss); const float rstd = rsqrtf(ss * (1.0f / DM) + 1e-6f);
    f32x2g g2[8];
#pragma unroll
    for (int j = 0; j < 8; ++j) g2[j] = (f32x2g){0.f, 0.f};
    u32x2 hw[4];
#pragma unroll
    for (int i = 0; i < 4; ++i) { const int d0 = i * 256 + lane * 4;
        const f32x2g ha = (f32x2g){xv[i].x, xv[i].y} * rstd * (f32x2g){nw[i].x, nw[i].y}, hb = (f32x2g){xv[i].z, xv[i].w} * rstd * (f32x2g){nw[i].z, nw[i].w};
        hw[i].x = pk2(ha.x, ha.y); hw[i].y = pk2(hb.x, hb.y);
#pragma unroll
        for (int j = 0; j < 8; ++j) { const f32x4 wv = *(const LAS f32x4*)(wg + j * 1024 + d0); g2[j] += ha * (f32x2g){wv[0], wv[1]}; g2[j] += hb * (f32x2g){wv[2], wv[3]}; } }
#pragma unroll
    for (int i = 0; i < 4; ++i) *(u32x2*)(H + (size_t)row * DM + i * 256 + lane * 4) = hw[i];
    float g[8];
#pragma unroll
    for (int j = 0; j < 8; ++j) g[j] = g2[j].x + g2[j].y;
    const bool b5 = lane & 32, b4 = lane & 16, b3 = lane & 8;
    float r1[4], r2[2], r3;
#pragma unroll
    for (int j = 0; j < 4; ++j) { const float mine = b5 ? g[4 + j] : g[j], other = b5 ? g[j] : g[4 + j]; r1[j] = mine + __shfl_xor(other, 32); }
#pragma unroll
    for (int j = 0; j < 2; ++j) { const float mine = b4 ? r1[2 + j] : r1[j], other = b4 ? r1[j] : r1[2 + j]; r2[j] = mine + __shfl_xor(other, 16); }
    { const float mine = b3 ? r2[1] : r2[0], other = b3 ? r2[0] : r2[1]; r3 = mine + __shfl_xor(other, 8); }
    r3 += __shfl_xor(r3, 4); r3 += __shfl_xor(r3, 2); r3 += __shfl_xor(r3, 1);
    const float z = r3 + bgl; const int gi = lane >> 3;
    const float lf = fminf(z, 0.f) - __logf(1.0f + __expf(-fabsf(z)));
    if ((lane & 7) == 0) gates[(size_t)row * 8 + gi] = gi < 4 ? z : lf;
}
DI void phase0(const Params& p, LAS uchar* lds) {
    const int tid = threadIdx.x, lane = tid & 63, wid = tid >> 6, nb = gridDim.x, bid = blockIdx.x;
    LAS float* tile = (LAS float*)lds;
#ifndef REP_TR
#define REP_TR 1
#define REP_ROW 1
#define REP_ROPE 1
#endif
    for (int rp = 0; rp < REP_TR; ++rp)
    for (int t0 = bid * 2; t0 < 960 + 256; t0 += nb * 2) {
        const float* src[2]; bf16_t* dst[2]; int ld[2], k0[2], n0[2], sc0[2];
#pragma unroll
        for (int q = 0; q < 2; ++q) { const int t = t0 + q;
            if (t < 960) { const int nt = t % 60, kt = t / 60; n0[q] = nt * 64; k0[q] = kt * 64; sc0[q] = n0[q] + (n0[q] >= 3328 ? 8 : 0); src[q] = p.w_in; ld[q] = DIN; dst[q] = (bf16_t*)(p.ws + WS_WTIN); }
            else { const int t2 = t - 960, nt = t2 % 16, kt = t2 / 16; n0[q] = nt * 64; k0[q] = kt * 64; sc0[q] = n0[q]; src[q] = p.w_out; ld[q] = DM; dst[q] = (bf16_t*)(p.ws + WS_WTOUT); } }
        float4 v[2][2];
#pragma unroll
        for (int q = 0; q < 2; ++q)
#pragma unroll
            for (int ps = 0; ps < 2; ++ps) { const int kk = (tid >> 4) + 32 * ps, nn4 = (tid & 15) * 4; v[q][ps] = *(const float4*)(src[q] + (size_t)(k0[q] + kk) * ld[q] + sc0[q] + nn4); }
#pragma unroll
        for (int q = 0; q < 2; ++q)
#pragma unroll
            for (int ps = 0; ps < 2; ++ps) { const int kk = (tid >> 4) + 32 * ps, nn4 = (tid & 15) * 4; LAS float* tl = tile + q * 4160 + kk * 65 + nn4; tl[0] = v[q][ps].x; tl[1] = v[q][ps].y; tl[2] = v[q][ps].z; tl[3] = v[q][ps].w; }
        __syncthreads();
#pragma unroll
        for (int q = 0; q < 2; ++q) { const int nn = tid >> 3, kk8 = (tid & 7) * 8; float f[8];
#pragma unroll
          for (int j = 0; j < 8; ++j) f[j] = tile[q * 4160 + (kk8 + j) * 65 + nn];
          *(u32x4*)(dst[q] + (size_t)(n0[q] + nn) * DM + k0[q] + kk8) = pack8(f); }
        __syncthreads();
    }
    { float2* rope = (float2*)(p.ws + WS_ROPE);
      for (int rp = 0; rp < REP_ROPE; ++rp)
      for (int idx = bid * 512 + tid; idx < 8200 * 8; idx += nb * 512) { const int pos = idx >> 3, i = idx & 7;
          const float invf = (float)exp(-(double)i * 0.125 * 13.122363377404328);
          const float ang = (float)pos * invf;
          const double q = rint((double)ang * 0.6366197723675814), r = (double)ang - q * 1.5707963267948966, r2 = r * r;
          const double s = r * (1.0 + r2 * (-1.0 / 6 + r2 * (1.0 / 120 + r2 * (-1.0 / 5040 + r2 * (1.0 / 362880 + r2 * (-1.0 / 39916800 + r2 * (1.0 / 6227020800.0)))))));
          const double c = 1.0 + r2 * (-0.5 + r2 * (1.0 / 24 + r2 * (-1.0 / 720 + r2 * (1.0 / 40320 + r2 * (-1.0 / 3628800 + r2 * (1.0 / 479001600.0))))));
          const int qi = ((int)q) & 3; double cs, sn;
          if (qi == 0) { sn = s; cs = c; } else if (qi == 1) { sn = c; cs = -s; } else if (qi == 2) { sn = -s; cs = -c; } else { sn = -c; cs = s; }
          rope[idx] = make_float2((float)cs, (float)sn); } }
    LAS float* wg = (LAS float*)(lds + 32768);
    for (int d = tid; d < DM; d += 512) { const float4 a = *(const float4*)(p.w_in + (size_t)d * DIN + 3328), b = *(const float4*)(p.w_in + (size_t)d * DIN + 3332);
        wg[d] = a.x; wg[1024 + d] = a.y; wg[2048 + d] = a.z; wg[3072 + d] = a.w; wg[4096 + d] = b.x; wg[5120 + d] = b.y; wg[6144 + d] = b.z; wg[7168 + d] = b.w; }
    __syncthreads();
    float4 nwr[4];
#pragma unroll
    for (int i = 0; i < 4; ++i) nwr[i] = *(const float4*)(p.norm_w + i * 256 + lane * 4);
    const float bgr = p.b_gates[lane >> 3];
    for (int rp = 0; rp < REP_ROW; ++rp)
    for (int row = bid * 8 + wid; row < NTOK; row += nb * 16) {
        const int row2 = row + nb * 8; const bool has2 = row2 < NTOK; const int r2 = has2 ? row2 : row;
        const float* xa = row < NTP ? p.x_p + (size_t)row * DM : p.x_s + (size_t)(row - NTP) * DM;
        const float* xb = r2 < NTP ? p.x_p + (size_t)r2 * DM : p.x_s + (size_t)(r2 - NTP) * DM;
        float4 va[4], vb[4];
#pragma unroll
        for (int i = 0; i < 4; ++i) va[i] = *(const float4*)(xa + i * 256 + lane * 4);
#pragma unroll
        for (int i = 0; i < 4; ++i) vb[i] = *(const float4*)(xb + i * 256 + lane * 4);
        norm_row(p, wg, row, va, nwr, bgr, lane);
        if (has2) norm_row(p, wg, row2, vb, nwr, bgr, lane);
    }
}

DI float block_excl_sum(float v, LAS float* red, int tid) {
    const int lane = tid & 63, wid = tid >> 6; float inc = v;
#pragma unroll
    for (int o = 1; o < 64; o <<= 1) { const float t = __shfl_up(inc, o); if (lane >= o) inc += t; }
    __syncthreads(); if (lane == 63) red[wid] = inc; __syncthreads();
    float base = 0.f;
#pragma unroll
    for (int w = 0; w < 8; ++w) base += (w < wid) ? red[w] : 0.f;
    return base + inc - v;
}
DI float block_excl_max(float v, LAS float* red, int tid) {
    const int lane = tid & 63, wid = tid >> 6; float inc = v;
#pragma unroll
    for (int o = 1; o < 64; o <<= 1) { const float t = __shfl_up(inc, o); if (lane >= o) inc = fmaxf(inc, t); }
    __syncthreads(); if (lane == 63) red[wid] = inc; __syncthreads();
    float base = -INFINITY;
#pragma unroll
    for (int w = 0; w < 8; ++w) base = fmaxf(base, (w < wid) ? red[w] : -INFINITY);
    float ex = __shfl_up(inc, 1); if (lane == 0) ex = -INFINITY;
    return fmaxf(base, ex);
}
DI void gate_scan(const Params& p, LAS uchar* lds, int bh) {
    const int tid = threadIdx.x, b = bh >> 2, h = bh & 3, t0 = tid * 16;
    const float* gates = (const float*)(p.ws + WS_GATES); float2* FM = (float2*)(p.ws + WS_FM) + (size_t)bh * SEQ;
    LAS float* red = (LAS float*)lds;
    float li[16], F[16];
    float run = 0.f;
#pragma unroll
    for (int j = 0; j < 16; ++j) { const float* g = gates + (size_t)(b * SEQ + t0 + j) * 8; li[j] = g[h]; run += g[4 + h]; F[j] = run; }
    const float base = block_excl_sum(run, red, tid);
    float mx = -INFINITY, ml[16];
#pragma unroll
    for (int j = 0; j < 16; ++j) { F[j] += base; mx = fmaxf(mx, li[j] - F[j]); ml[j] = mx; }
    const float mb = fmaxf(block_excl_max(mx, red, tid), 0.0f);
#pragma unroll
    for (int j = 0; j < 16; ++j) FM[t0 + j] = make_float2(F[j], F[j] + fmaxf(ml[j], mb));
    __syncthreads();
}

struct EpiProj {
    static constexpr bool PERM = true, AFTER_DRAIN = false;
    bf16_t* O;
    __device__ __forceinline__ void operator()(const f32x4 (&acc)[2][2][4][2], const pg8::Unit& u, int wr, int wc, int fr, int fq) const {
        const int row0 = u.pm * 256 + wr * 64 + fr, col0 = u.pn * 256 + wc * 32 + 8 * fq;
#pragma unroll
        for (int ai = 0; ai < 2; ++ai)
#pragma unroll
            for (int m = 0; m < 4; ++m) { bf16_t* rowp = O + (size_t)(row0 + ai * 128 + m * 16) * NPJ + col0;
#pragma unroll
                for (int bj = 0; bj < 2; ++bj) { const f32x4 v0 = acc[ai][bj][m][0], v1 = acc[ai][bj][m][1];
                    u32x4 w; w.x = pk2(v0[0], v0[1]); w.y = pk2(v0[2], v0[3]); w.z = pk2(v1[0], v1[1]); w.w = pk2(v1[2], v1[3]);
                    *(u32x4*)(rowp + bj * 128) = w; } }
    }
};
struct EpiOut {
    static constexpr bool PERM = false, AFTER_DRAIN = false;
    float* Y; const float* xp;
    __device__ __forceinline__ void operator()(const f32x4 (&acc)[2][2][4][2], const pg8::Unit& u, int wr, int wc, int fr, int fq) const {
        const int row0 = u.pm * 256 + wr * 64 + fr, col0 = u.pn * 256 + wc * 32 + 4 * fq;
#pragma unroll
        for (int ai = 0; ai < 2; ++ai)
#pragma unroll
            for (int mp = 0; mp < 2; ++mp) { f32x4 xv[2][2][2];
#pragma unroll
                for (int mm = 0; mm < 2; ++mm) { const float* xr = xp + (size_t)(row0 + ai * 128 + (mp * 2 + mm) * 16) * DM + col0;
#pragma unroll
                    for (int bj = 0; bj < 2; ++bj)
#pragma unroll
                        for (int n = 0; n < 2; ++n) xv[mm][bj][n] = *(const f32x4*)(xr + bj * 128 + n * 16); }
#pragma unroll
                for (int mm = 0; mm < 2; ++mm) { float* yr = Y + (size_t)(row0 + ai * 128 + (mp * 2 + mm) * 16) * DM + col0;
#pragma unroll
                    for (int bj = 0; bj < 2; ++bj)
#pragma unroll
                        for (int n = 0; n < 2; ++n) *(f32x4*)(yr + bj * 128 + n * 16) = acc[ai][bj][mp * 2 + mm][n] + xv[mm][bj][n]; } }
    }
};
DI void phase1(const Params& p, LAS uchar* lds) {
    const int nb = gridDim.x, bid = blockIdx.x;
    if (bid >= nb - 8) gate_scan(p, lds, bid - (nb - 8));
    pg8::Gemm g; g.A = (const bf16_t*)(p.ws + WS_H); g.Bt = (const bf16_t*)(p.ws + WS_WTIN); g.M = NTOK; g.N = NPJ; g.K = DM;
    pg8::StaticOrder S; S.init(g.M, g.N, nb, bid);
    EpiProj E; E.O = (bf16_t*)(p.ws + WS_PROJ);
    pg8::gemm_phase<EpiProj, pg8::StaticOrder, false>(lds, g, S, E, nullptr);
}
DI void phase5(const Params& p, LAS uchar* lds) {
    const int nb = gridDim.x, bid = blockIdx.x;
    pg8::Gemm g; g.A = (const bf16_t*)(p.ws + WS_MIXED); g.Bt = (const bf16_t*)(p.ws + WS_WTOUT); g.M = NTP; g.N = DM; g.K = DM;
    pg8::StaticOrder S; S.init(g.M, g.N, nb, bid);
    EpiOut E; E.Y = p.out + O_Y; E.xp = p.x_p;
    pg8::gemm_phase<EpiOut, pg8::StaticOrder, false>(lds, g, S, E, nullptr);
}

constexpr int KSTR = 144, VSTR = 560, AT_K = 0, AT_V = 272 * KSTR, AT_R = AT_V + 64 * VSTR;
typedef float f32x2r __attribute__((ext_vector_type(2)));

DI void qk_norm_rope16(float (&x)[16], int pt, const float* nw, const float2* rope_row) {
    float ss = 0.f;
#pragma unroll
    for (int j = 0; j < 16; ++j) ss += x[j] * x[j];
    ss += __shfl_xor(ss, 1); ss += __shfl_xor(ss, 2);
    const float rstd = rsqrtf(ss * (1.0f / 64) + 1e-6f);
#pragma unroll
    for (int j = 0; j < 16; ++j) x[j] = x[j] * rstd * nw[pt * 16 + j];
    if (pt == 0) {
#pragma unroll
        for (int i = 0; i < 8; ++i) { const float2 cs = rope_row[i]; const float a = x[i], b = x[i + 8]; x[i] = a * cs.x - b * cs.y; x[i + 8] = b * cs.x + a * cs.y; } }
}
DI void qk_norm_rope16p(float (&x)[16], int pt, const float* nw, const float2 (&rp)[8]) {
    float ss = 0.f;
#pragma unroll
    for (int j = 0; j < 16; ++j) ss += x[j] * x[j];
    ss += __shfl_xor(ss, 1); ss += __shfl_xor(ss, 2);
    const float rstd = rsqrtf(ss * (1.0f / 64) + 1e-6f);
#pragma unroll
    for (int j = 0; j < 16; ++j) x[j] = x[j] * rstd * nw[pt * 16 + j];
    if (pt == 0) {
#pragma unroll
        for (int i = 0; i < 8; ++i) { const float2 cs = rp[i]; const float a = x[i], b = x[i + 8]; x[i] = a * cs.x - b * cs.y; x[i + 8] = b * cs.x + a * cs.y; } }
}
DI void kv_to_lds(LAS uchar* lds, int ki, int pt, const float (&xk)[16], const float (&xv)[16]) {
    float a[8], b[8];
#pragma unroll
    for (int j = 0; j < 8; ++j) { a[j] = xk[j]; b[j] = xk[8 + j]; }
    *(LAS u32x4*)(lds + AT_K + ki * KSTR + pt * 32) = pack8(a); *(LAS u32x4*)(lds + AT_K + ki * KSTR + pt * 32 + 16) = pack8(b);
#pragma unroll
    for (int j = 0; j < 16; j += 2) { const unsigned w = pk2(xv[j], xv[j + 1]);
        *(LAS bf16_t*)(lds + AT_V + (pt * 16 + j) * VSTR + ki * 2) = (bf16_t)(w & 0xffffu); *(LAS bf16_t*)(lds + AT_V + (pt * 16 + j + 1) * VSTR + ki * 2) = (bf16_t)(w >> 16); }
}
DI void load16bf(const bf16_t* src, float (&x)[16]) { const u32x4 w0 = *(const u32x4*)src, w1 = *(const u32x4*)(src + 8); float a[8], b[8]; unpack8(w0, a); unpack8(w1, b);
#pragma unroll
    for (int j = 0; j < 8; ++j) { x[j] = a[j]; x[8 + j] = b[j]; } }
DI void load16f(const float* src, float (&x)[16]) {
#pragma unroll
    for (int j = 0; j < 4; ++j) { const float4 v = *(const float4*)(src + 4 * j); x[4 * j] = v.x; x[4 * j + 1] = v.y; x[4 * j + 2] = v.z; x[4 * j + 3] = v.w; } }
DI void store16f(float* dst, const float (&x)[16]) {
#pragma unroll
    for (int j = 0; j < 4; ++j) *(float4*)(dst + 4 * j) = make_float4(x[4 * j], x[4 * j + 1], x[4 * j + 2], x[4 * j + 3]); }

struct QRaw { u32x4 q0, q1; u32x2 gw[4]; };
DI void attn_q_load(const Params& p, int row, int hqa, QRaw& qr) {
    const int lane = threadIdx.x & 63, quad = lane >> 4;
    const bf16_t* rowp = (const bf16_t*)(p.ws + WS_PROJ) + (size_t)row * NPJ;
    qr.q0 = *(const u32x4*)(rowp + C_AQ + hqa * 64 + 8 * quad); qr.q1 = *(const u32x4*)(rowp + C_AQ + hqa * 64 + 32 + 8 * quad);
#pragma unroll
    for (int mt = 0; mt < 4; ++mt) qr.gw[mt] = *(const u32x2*)(rowp + C_AG + hqa * 64 + 16 * mt + 4 * quad);
}
template <bool LROPE> DI void attn_q_tile(const Params& p, LAS uchar* lds, const QRaw& qr, const float (&qw0)[8], const float (&qw1)[8], int row, int pos, int hqa, int qi, int kt0, int kmin) {
    const int lane = threadIdx.x & 63, r = lane & 15, quad = lane >> 4;
    const float2* rope = (const float2*)(p.ws + WS_ROPE);
    float x0[8], x1[8];
    unpack8(qr.q0, x0); unpack8(qr.q1, x1);
    float ss = 0.f;
#pragma unroll
    for (int j = 0; j < 8; ++j) ss += x0[j] * x0[j] + x1[j] * x1[j];
    ss += __shfl_xor(ss, 16); ss += __shfl_xor(ss, 32);
    const float rstd = rsqrtf(ss * (1.0f / 64) + 1e-6f) ;
#pragma unroll
    for (int j = 0; j < 8; ++j) { x0[j] = x0[j] * rstd * qw0[j]; x1[j] = x1[j] * rstd * qw1[j]; }
#pragma unroll
    for (int j = 0; j < 8; ++j) { const float pj = __shfl_xor(x0[j], 16); float2 cs; if (LROPE) { const f32x2r c2 = *(const LAS f32x2r*)(lds + AT_R + qi * 64 + j * 8); cs = make_float2(c2.x, c2.y); } else cs = rope[(size_t)pos * 8 + j];
        const float rot = x0[j] * cs.x + (quad == 0 ? -pj : pj) * cs.y; x0[j] = (quad < 2) ? rot : x0[j]; }
#pragma unroll
    for (int j = 0; j < 8; ++j) { x0[j] *= 0.18033688011112042f; x1[j] *= 0.18033688011112042f; }
    const bf16x8 qf0 = __builtin_bit_cast(bf16x8, pack8(x0)), qf1 = __builtin_bit_cast(bf16x8, pack8(x1));
    const float sink = p.sinks[hqa] * 1.4426950408889634f;
    f32x4 s[9];
#pragma unroll
    for (int kt = 0; kt < 9; ++kt) { const int krow = (kt0 + kt) * 16 + r;
        const bf16x8 a0 = *(const LAS bf16x8*)(lds + AT_K + krow * KSTR + quad * 16), a1 = *(const LAS bf16x8*)(lds + AT_K + krow * KSTR + 64 + quad * 16);
        f32x4 acc = {0.f, 0.f, 0.f, 0.f}; acc = mfma16(a0, qf0, acc); acc = mfma16(a1, qf1, acc); s[kt] = acc; }
    float mx = sink;
#pragma unroll
    for (int kt = 0; kt < 9; ++kt) {
        if ((kt0 + kt) * 16 + 15 < kmin) { s[kt] = (f32x4){-INFINITY, -INFINITY, -INFINITY, -INFINITY}; }
        else {
            if (kt == 0) {
#pragma unroll
                for (int v = 0; v < 4; ++v) { const int ki = kt0 * 16 + quad * 4 + v; s[kt][v] = (ki > qi) ? s[kt][v] : -INFINITY; } }
            if (kt == 8) {
#pragma unroll
                for (int v = 0; v < 4; ++v) { const int ki = (kt0 + 8) * 16 + quad * 4 + v; s[kt][v] = (ki <= qi + 128) ? s[kt][v] : -INFINITY; } }
            mx = fmaxf(fmaxf(mx, fmaxf(s[kt][0], s[kt][1])), fmaxf(s[kt][2], s[kt][3])); } }
    mx = fmaxf(mx, __shfl_xor(mx, 16)); mx = fmaxf(mx, __shfl_xor(mx, 32));
    float sum = 0.f;
#pragma unroll
    for (int kt = 0; kt < 9; ++kt)
#pragma unroll
        for (int v = 0; v < 4; ++v) { const float e = __builtin_amdgcn_exp2f(s[kt][v] - mx); s[kt][v] = e; sum += e; }
    sum += __shfl_xor(sum, 16); sum += __shfl_xor(sum, 32);
    sum += __builtin_amdgcn_exp2f(sink - mx);
    const float inv = __builtin_amdgcn_rcpf(sum);
    f32x4 o[4];
#pragma unroll
    for (int mt = 0; mt < 4; ++mt) o[mt] = (f32x4){0.f, 0.f, 0.f, 0.f};
#pragma unroll
    for (int ks = 0; ks < 5; ++ks) {
        u32x4 pw; pw.x = pk2(s[2 * ks][0], s[2 * ks][1]); pw.y = pk2(s[2 * ks][2], s[2 * ks][3]);
        if (ks < 4) { pw.z = pk2(s[2 * ks + 1][0], s[2 * ks + 1][1]); pw.w = pk2(s[2 * ks + 1][2], s[2 * ks + 1][3]); } else { pw.z = 0u; pw.w = 0u; }
        const bf16x8 pb = __builtin_bit_cast(bf16x8, pw);
#pragma unroll
        for (int mt = 0; mt < 4; ++mt) { const int d = 16 * mt + r; const LAS uchar* vp = lds + AT_V + d * VSTR + ((kt0 + 2 * ks) * 16 + 4 * quad) * 2;
            u32x4 aw; const u32x2 lo = *(const LAS u32x2*)vp, hi = *(const LAS u32x2*)(vp + 32); aw.x = lo.x; aw.y = lo.y; aw.z = hi.x; aw.w = hi.y;
            o[mt] = mfma16(__builtin_bit_cast(bf16x8, aw), pb, o[mt]); } }
    bf16_t* mixed = (bf16_t*)(p.ws + WS_MIXED) + (size_t)row * DM;
#pragma unroll
    for (int mt = 0; mt < 4; ++mt) { const int col = hqa * 64 + 16 * mt + 4 * quad; const u32x2 gw = qr.gw[mt];
        u32x2 w; w.x = pk2(o[mt][0] * inv * silu(bflo(gw.x)), o[mt][1] * inv * silu(bfhi(gw.x))); w.y = pk2(o[mt][2] * inv * silu(bflo(gw.y)), o[mt][3] * inv * silu(bfhi(gw.y)));
        *(u32x2*)(mixed + col) = w; }
}

DI void attn_prompt_item(const Params& p, LAS uchar* lds, int item) {
    const int tid = threadIdx.x, wid = tid >> 6, lane = tid & 63, r = lane & 15;
    const int g = item & 1, blk = (item >> 1) & 63, b = item >> 7;
    const bf16_t* proj = (const bf16_t*)(p.ws + WS_PROJ); const float2* rope = (const float2*)(p.ws + WS_ROPE);
    const int hqa = g * 4 + (wid >> 1), qh = wid & 1;
    __syncthreads();
    float qw0[8], qw1[8];
    { const int quad = lane >> 4;
#pragma unroll
      for (int j = 0; j < 8; ++j) { qw0[j] = p.qnw[8 * quad + j]; qw1[j] = p.qnw[32 + 8 * quad + j]; } }
    u32x4 kr[2][2], vr[2][2]; float2 rp[2][8];
#pragma unroll
    for (int it = 0; it < 2; ++it) { const int u = tid + 512 * it, ki = u >> 2, pt = u & 3, tk = (blk - 1) * 128 + ki; const int tkc = tk < 0 ? 0 : tk;
        const bf16_t* rowp = proj + (size_t)(b * SEQ + tkc) * NPJ;
        kr[it][0] = *(const u32x4*)(rowp + C_AK + g * 64 + pt * 16); kr[it][1] = *(const u32x4*)(rowp + C_AK + g * 64 + pt * 16 + 8);
        vr[it][0] = *(const u32x4*)(rowp + C_AV + g * 64 + pt * 16); vr[it][1] = *(const u32x4*)(rowp + C_AV + g * 64 + pt * 16 + 8);
#pragma unroll
        for (int i = 0; i < 8; ++i) rp[it][i] = rope[(size_t)tkc * 8 + i]; }
    if (tid < 128) { u32x4 z; z.x = 0u; z.y = 0u; z.z = 0u; z.w = 0u; *(LAS u32x4*)(lds + AT_V + (tid >> 1) * VSTR + 512 + (tid & 1) * 16) = z; }
    QRaw qr[4];
#pragma unroll
    for (int i = 0; i < 4; ++i) attn_q_load(p, b * SEQ + blk * 128 + (qh * 4 + i) * 16 + r, hqa, qr[i]);
    { const float2 ra = rope[(size_t)blk * 1024 + tid], rb = rope[(size_t)blk * 1024 + 512 + tid];
      *(LAS f32x2r*)(lds + AT_R + tid * 8) = (f32x2r){ra.x, ra.y}; *(LAS f32x2r*)(lds + AT_R + (512 + tid) * 8) = (f32x2r){rb.x, rb.y}; }
#pragma unroll
    for (int it = 0; it < 2; ++it) { const int u = tid + 512 * it, ki = u >> 2, pt = u & 3;
        {
            float xk[16], xv[16]; float a[8], c[8];
            unpack8(kr[it][0], a); unpack8(kr[it][1], c);
#pragma unroll
            for (int j = 0; j < 8; ++j) { xk[j] = a[j]; xk[8 + j] = c[j]; }
            unpack8(vr[it][0], a); unpack8(vr[it][1], c);
#pragma unroll
            for (int j = 0; j < 8; ++j) { xv[j] = a[j]; xv[8 + j] = c[j]; }
            qk_norm_rope16p(xk, pt, p.knw, rp[it]);
            kv_to_lds(lds, ki, pt, xk, xv);
            if (blk == 63 && ki >= 128) { const size_t o = ((size_t)(b * 128 + ki - 128) * 2 + g) * 64 + pt * 16; store16f(p.out + O_KWP + o, xk); store16f(p.out + O_VWP + o, xv); } } }
    __syncthreads();
#pragma unroll 2
    for (int i = 0; i < 4; ++i) { const int qt = qh * 4 + i, qi = qt * 16 + r, tq = blk * 128 + qi;
        attn_q_tile<true>(p, lds, qr[0], qw0, qw1, b * SEQ + tq, tq, hqa, qi, qt, blk == 0 ? 128 : 0);
        qr[0] = qr[1]; qr[1] = qr[2]; qr[2] = qr[3]; }
}
DI void attn_sample_item(const Params& p, LAS uchar* lds, int item) {
    const int tid = threadIdx.x, wid = tid >> 6, lane = tid & 63, r = lane & 15;
    const int g = item & 1, b = item >> 1;
    const bf16_t* proj = (const bf16_t*)(p.ws + WS_PROJ); const float2* rope = (const float2*)(p.ws + WS_ROPE);
    __syncthreads();
    QRaw qrs; if (wid == 0) attn_q_load(p, NTP + b * 4 + (r >> 2), g * 4 + (r & 3), qrs);
    float qw0[8], qw1[8];
    { const int quad = lane >> 4;
#pragma unroll
      for (int j = 0; j < 8; ++j) { qw0[j] = p.qnw[8 * quad + j]; qw1[j] = p.qnw[32 + 8 * quad + j]; } }
    for (int u = tid; u < 640; u += 512) { const int ki = u >> 2, pt = u & 3;
        float xk[16], xv[16];
#pragma unroll
        for (int j = 0; j < 16; ++j) { xk[j] = 0.f; xv[j] = 0.f; }
        if (ki < 128) { const size_t o = ((size_t)(b * 128 + ki) * 2 + g) * 64 + pt * 16; load16f(p.ck + o, xk); load16f(p.cv + o, xv); }
        else { if (ki < 132) { const bf16_t* rowp = proj + (size_t)(NTP + b * 4 + ki - 128) * NPJ; load16bf(rowp + C_AK + g * 64 + pt * 16, xk); load16bf(rowp + C_AV + g * 64 + pt * 16, xv); }
               qk_norm_rope16(xk, pt, p.knw, rope + (size_t)(SEQ + (ki < 132 ? ki - 128 : 0)) * 8); }
        kv_to_lds(lds, ki, pt, xk, xv);
        if (ki >= 4 && ki < 132) { const size_t o = ((size_t)(b * 128 + ki - 4) * 2 + g) * 64 + pt * 16; store16f(p.out + O_KWS + o, xk); store16f(p.out + O_VWS + o, xv); }
    }
    __syncthreads();
    if (wid == 0) { const int t = r >> 2, hqa = g * 4 + (r & 3); attn_q_tile<false>(p, lds, qrs, qw0, qw1, NTP + b * 4 + t, SEQ + t, hqa, t, 0, 0); }
}

constexpr int TSTR = 272;
constexpr int ML_Q = 0, ML_K = 128 * TSTR, ML_V = ML_K + 128 * TSTR, ML_S = ML_V + 144 * TSTR, ML_AS = ML_S + 144 * TSTR, ML_END = ML_AS + 512;
static_assert(ML_END <= LDS_MAIN, "lds");

struct ConvIn { u32x4 row[11]; float4 w[4][2]; float4 bias[2]; };
DI void conv_issue(const Params& p, const bf16_t* proj, int b, int t0, int col, int ch, ConvIn& ci) {
#pragma unroll
    for (int i = 0; i < 11; ++i) { const int tt = t0 - 3 + i; ci.row[i] = *(const u32x4*)(proj + (size_t)(b * SEQ + (tt < 0 ? 0 : tt)) * NPJ + col); }
#pragma unroll
    for (int j = 0; j < 4; ++j) { ci.w[j][0] = *(const float4*)(p.conv_w + j * 1024 + ch); ci.w[j][1] = *(const float4*)(p.conv_w + j * 1024 + ch + 4); }
    ci.bias[0] = *(const float4*)(p.conv_b + ch); ci.bias[1] = *(const float4*)(p.conv_b + ch + 4);
}
typedef float f32x2 __attribute__((ext_vector_type(2)));
DI void conv_compute(const ConvIn& ci, int t0, float (&y)[8][8]) {
    f32x2 w[4][4], yy[8][4];
#pragma unroll
    for (int j = 0; j < 4; ++j) { w[j][0] = (f32x2){ci.w[j][0].x, ci.w[j][0].y}; w[j][1] = (f32x2){ci.w[j][0].z, ci.w[j][0].w}; w[j][2] = (f32x2){ci.w[j][1].x, ci.w[j][1].y}; w[j][3] = (f32x2){ci.w[j][1].z, ci.w[j][1].w}; }
    const f32x2 bs[4] = {(f32x2){ci.bias[0].x, ci.bias[0].y}, (f32x2){ci.bias[0].z, ci.bias[0].w}, (f32x2){ci.bias[1].x, ci.bias[1].y}, (f32x2){ci.bias[1].z, ci.bias[1].w}};
#pragma unroll
    for (int i = 0; i < 8; ++i)
#pragma unroll
        for (int q = 0; q < 4; ++q) yy[i][q] = bs[q];
#pragma unroll
    for (int r = 0; r < 11; ++r) { f32x2 x[4];
        const bool zero = (r < 3) && (t0 - 3 + r < 0);
#pragma unroll
        for (int q = 0; q < 4; ++q) { const unsigned wd = zero ? 0u : ci.row[r][q]; x[q] = (f32x2){bflo(wd), bfhi(wd)}; }
#pragma unroll
        for (int j = 0; j < 4; ++j) { const int i = r - j;
            if (i >= 0 && i < 8) {
#pragma unroll
                for (int q = 0; q < 4; ++q) yy[i][q] += w[j][q] * x[q]; } } }
#pragma unroll
    for (int i = 0; i < 8; ++i)
#pragma unroll
        for (int q = 0; q < 4; ++q) { const f32x2 v = yy[i][q], a = v * -1.4426950408889634f; f32x2 e; e.x = __builtin_amdgcn_exp2f(a.x); e.y = __builtin_amdgcn_exp2f(a.y);
            const f32x2 d = e + 1.0f; f32x2 rc; rc.x = __builtin_amdgcn_rcpf(d.x); rc.y = __builtin_amdgcn_rcpf(d.y); const f32x2 o = v * rc; y[i][2 * q] = o.x; y[i][2 * q + 1] = o.y; }
}
DI void vt_store8(LAS uchar* img, int d0, int s0, const u32x4 (&row)[8]) {
#pragma unroll
    for (int wd = 0; wd < 4; ++wd) { u32x4 ev, od;
        unsigned a[8];
#pragma unroll
        for (int i = 0; i < 8; ++i) a[i] = row[i][wd];
        ev.x = (a[0] & 0xffffu) | (a[1] << 16); ev.y = (a[2] & 0xffffu) | (a[3] << 16); ev.z = (a[4] & 0xffffu) | (a[5] << 16); ev.w = (a[6] & 0xffffu) | (a[7] << 16);
        od.x = (a[0] >> 16) | (a[1] & 0xffff0000u); od.y = (a[2] >> 16) | (a[3] & 0xffff0000u); od.z = (a[4] >> 16) | (a[5] & 0xffff0000u); od.w = (a[6] >> 16) | (a[7] & 0xffff0000u);
        *(LAS u32x4*)(img + (d0 + 2 * wd) * TSTR + s0 * 2) = ev; *(LAS u32x4*)(img + (d0 + 2 * wd + 1) * TSTR + s0 * 2) = od; }
}
DI void vt_aug_rows(LAS uchar* img, int tid) {
    if (tid < 256) { const int rr = tid >> 4, s8 = (tid & 15) * 8; const unsigned v = rr == 0 ? 0x3F803F80u : 0u; u32x4 w; w.x = v; w.y = v; w.z = v; w.w = v;
        *(LAS u32x4*)(img + (128 + rr) * TSTR + s8 * 2) = w; }
}

DI void mlstm_u_item(const Params& p, LAS uchar* lds, int item) {
    const int tid = threadIdx.x, wid = tid >> 6, lane = tid & 63, r = lane & 15, quad = lane >> 4;
    const int c = item & 63, bh = item >> 6, b = bh >> 2, h = bh & 3;
    const bf16_t* proj = (const bf16_t*)(p.ws + WS_PROJ); const float* gates = (const float*)(p.ws + WS_GATES); const float2* FM = (const float2*)(p.ws + WS_FM) + (size_t)bh * SEQ;
    LAS float* wks = (LAS float*)(lds + ML_AS);
    __syncthreads();
    if (tid < 256) {
        const int g8 = (tid & 15) * 8, s0 = (tid >> 4) * 8, t0 = c * CH + s0;
        ConvIn ci; conv_issue(p, proj, b, t0, C_MK + h * 128 + g8, 512 + h * 128 + g8, ci);
        if (tid < 128) { const int t = c * CH + tid; const float2 fe = FM[c * CH + CH - 1], fs = FM[t];
            wks[tid] = __expf(fe.x - fs.x + gates[(size_t)(b * SEQ + t) * 8 + h] - fe.y) * 0.08838834764831845f; }
        vt_aug_rows(lds + ML_V, tid);
        __syncthreads();
        float y[8][8]; conv_compute(ci, t0, y);
        const f32x4 wa = *(const LAS f32x4*)(wks + s0), wb = *(const LAS f32x4*)(wks + s0 + 4);
        const float wk[8] = {wa[0], wa[1], wa[2], wa[3], wb[0], wb[1], wb[2], wb[3]};
#pragma unroll
        for (int e = 0; e < 8; ++e) { float f[8];
#pragma unroll
            for (int i = 0; i < 8; ++i) f[i] = y[i][e] * wk[i];
            *(LAS u32x4*)(lds + ML_K + (g8 + e) * TSTR + s0 * 2) = pack8(f); }
    } else {
        const int vt = tid - 256, d8 = (vt & 15) * 8, s0 = (vt >> 4) * 8, t0 = c * CH + s0;
        u32x4 row[8];
#pragma unroll
        for (int i = 0; i < 8; ++i) row[i] = *(const u32x4*)(proj + (size_t)(b * SEQ + t0 + i) * NPJ + C_MV + h * 128 + d8);
        __syncthreads();
        vt_store8(lds + ML_V, d8, s0, row);
    }
    __syncthreads();
    f32x4 acc[9];
#pragma unroll
    for (int mt = 0; mt < 9; ++mt) acc[mt] = (f32x4){0.f, 0.f, 0.f, 0.f};
#pragma unroll
    for (int ks = 0; ks < 4; ++ks) { const bf16x8 bk = *(const LAS bf16x8*)(lds + ML_K + (16 * wid + r) * TSTR + ks * 64 + quad * 16);
#pragma unroll
        for (int mt = 0; mt < 9; ++mt) { const bf16x8 av = *(const LAS bf16x8*)(lds + ML_V + (16 * mt + r) * TSTR + ks * 64 + quad * 16); acc[mt] = mfma16(av, bk, acc[mt]); } }
    bf16_t* U = (bf16_t*)(p.ws + WS_UST) + (size_t)item * USZ;
#pragma unroll
    for (int mt = 0; mt < 9; ++mt)
#pragma unroll
        for (int v = 0; v < 4; ++v) { const int dv = 16 * mt + 4 * quad + v; if (dv <= 128) U[dv * 128 + 16 * wid + r] = f2bf(acc[mt][v]); }
}

DI void sample_outproj(const Params& p, int unit) {
    const int lane = threadIdx.x & 63, wid = threadIdx.x >> 6, r = lane & 15, quad = lane >> 4;
    const int m0 = (unit >> 4) * 32 + (wid >> 2) * 16, n0 = (unit & 15) * 64 + (wid & 3) * 16;
    const bf16_t* A = (const bf16_t*)(p.ws + WS_WTOUT) + (size_t)(n0 + r) * DM + 8 * quad;
    const bf16_t* B = (const bf16_t*)(p.ws + WS_MIXED) + (size_t)(NTP + m0 + r) * DM + 8 * quad;
    f32x4 acc0 = {0.f, 0.f, 0.f, 0.f}, acc1 = {0.f, 0.f, 0.f, 0.f};
    const f32x4 xres = *(const f32x4*)(p.x_s + (size_t)(m0 + r) * DM + n0 + 4 * quad);
#pragma unroll
    for (int hb = 0; hb < 4; ++hb) { bf16x8 af[8], bfr[8];
#pragma unroll
        for (int ks = 0; ks < 8; ++ks) { af[ks] = *(const bf16x8*)(A + (hb * 8 + ks) * 32); bfr[ks] = *(const bf16x8*)(B + (hb * 8 + ks) * 32); }
#pragma unroll
        for (int ks = 0; ks < 8; ks += 2) { acc0 = mfma16(af[ks], bfr[ks], acc0); acc1 = mfma16(af[ks + 1], bfr[ks + 1], acc1); } }
    const size_t o = (size_t)(m0 + r) * DM + n0 + 4 * quad;
    *(f32x4*)(p.out + O_Y + (size_t)NTP * DM + o) = acc0 + acc1 + xres;
}
DI void mlstm_scan(const Params& p, LAS uchar* lds) {
    const int tid = threadIdx.x, nb = gridDim.x, bid = blockIdx.x;
    const bf16_t* UST = (const bf16_t*)(p.ws + WS_UST); bf16_t* SBF = (bf16_t*)(p.ws + WS_SB);
    LAS float* dcs = (LAS float*)lds;
    for (int it = nb - 1 - bid; it < 256; it += nb) sample_outproj(p, it);
    const int per = (8 * USZ + nb - 1) / nb, base = bid * per;
    const int lim = (base + per < 8 * USZ) ? base + per : 8 * USZ;
    const int eA = base + tid, eB = base + 512 + tid; const bool hasA = eA < lim, hasB = (tid < 64) && (eB < lim);
    const int ea = hasA ? eA : 0, eb2 = hasB ? eB : 0;
    const int bhA = ea / USZ, idxA = ea - bhA * USZ, bhB = eb2 / USZ, idxB = eb2 - bhB * USZ;
    const unsigned offA = (unsigned)(bhA * NCH * USZ + idxA), offB = (unsigned)(bhB * NCH * USZ + idxB);
    float ua[64];
#pragma unroll
    for (int j = 0; j < 64; ++j) ua[j] = __uint_as_float((unsigned)(UST + (size_t)j * USZ)[offA] << 16);
    __syncthreads();
    { const int bh = tid >> 6, c = tid & 63; const float2* FM = (const float2*)(p.ws + WS_FM) + (size_t)bh * SEQ;
      const float2 fe = FM[c * CH + CH - 1]; float2 pv = make_float2(0.f, 0.f); if (c > 0) pv = FM[c * CH - 1];
      dcs[tid] = __expf(fe.x - pv.x + pv.y - fe.y);
      if (bid == 0 && c == 63) p.out[O_MP + bh] = fe.y; }
    __syncthreads();
    if (hasA) { float SA = 0.f;
#pragma unroll
        for (int j = 0; j < 64; ++j) { (SBF + (size_t)j * USZ)[offA] = f2bf(SA); SA = dcs[bhA * 64 + j] * SA + ua[j]; }
        if (idxA < 16384) { const int dv = idxA >> 7, dk = idxA & 127; p.out[O_CP + (size_t)bhA * 16384 + dk * 128 + dv] = SA; } else p.out[O_NP + bhA * 128 + idxA - 16384] = SA; }
    if (tid < 64) {
        if (hasB) { float SB = 0.f;
#pragma unroll 1
            for (int c0 = 0; c0 < 64; c0 += 32) { float ub[32]; const bf16_t* Ub = UST + (size_t)c0 * USZ; const LAS float* db = dcs + bhB * 64 + c0;
#pragma unroll
                for (int j = 0; j < 32; ++j) ub[j] = __uint_as_float((unsigned)(Ub + (size_t)j * USZ)[offB] << 16);
#pragma unroll
                for (int j = 0; j < 32; ++j) { (SBF + (size_t)(c0 + j) * USZ)[offB] = f2bf(SB); SB = db[j] * SB + ub[j]; } }
            if (idxB < 16384) { const int dv = idxB >> 7, dk = idxB & 127; p.out[O_CP + (size_t)bhB * 16384 + dk * 128 + dv] = SB; } else p.out[O_NP + bhB * 128 + idxB - 16384] = SB; } }
}

DI void mlstm_out_item(const Params& p, LAS uchar* lds, int item) {
    const int tid = threadIdx.x, wid = tid >> 6, lane = tid & 63, r = lane & 15, quad = lane >> 4;
    const int c = item & 63, bh = item >> 6, b = bh >> 2, h = bh & 3;
    const bf16_t* proj = (const bf16_t*)(p.ws + WS_PROJ); const float* gates = (const float*)(p.ws + WS_GATES); const float2* FM = (const float2*)(p.ws + WS_FM) + (size_t)bh * SEQ;
    __syncthreads();
    {
        const bf16_t* St = (const bf16_t*)(p.ws + WS_SB) + (size_t)item * USZ;
        u32x4 sv[5];
#pragma unroll
        for (int k = 0; k < 5; ++k) { const int u = tid + 512 * k, dv = u >> 4, d8 = (u & 15) * 8; const int dvc = dv <= 128 ? dv : 128;
            sv[k] = *(const u32x4*)(St + dvc * 128 + d8); }
        const int isk = (tid >> 4) & 1, g8 = (tid & 15) * 8, s0 = (tid >> 5) * 8, t0 = c * CH + s0;
        ConvIn ci; conv_issue(p, proj, b, t0, (isk ? C_MK : C_MQ) + h * 128 + g8, isk * 512 + h * 128 + g8, ci);
        const int vd8 = (tid & 15) * 8, vs0 = (tid >> 4) * 4;
        u32x4 vrow[4];
#pragma unroll
        for (int i = 0; i < 4; ++i) vrow[i] = *(const u32x4*)(proj + (size_t)(b * SEQ + c * CH + vs0 + i) * NPJ + C_MV + h * 128 + vd8);
        if (tid < 128) { const int t = c * CH + tid; ((LAS float*)(lds + ML_AS))[tid] = gates[(size_t)(b * SEQ + t) * 8 + h] - FM[t].x; }
        vt_aug_rows(lds + ML_V, tid);
#pragma unroll
        for (int k = 0; k < 5; ++k) { const int u = tid + 512 * k, dv = u >> 4, d8 = (u & 15) * 8;
            if (u < 144 * 16) { u32x4 w = sv[k]; if (dv > 128) { w.x = 0u; w.y = 0u; w.z = 0u; w.w = 0u; }
                *(LAS u32x4*)(lds + ML_S + dv * TSTR + d8 * 2) = w; } }
        float y[8][8]; conv_compute(ci, t0, y);
#pragma unroll
        for (int i = 0; i < 8; ++i) { float f[8];
#pragma unroll
            for (int e = 0; e < 8; ++e) f[e] = isk ? y[i][e] * 0.08838834764831845f : y[i][e];
            *(LAS u32x4*)(lds + (isk ? ML_K : ML_Q) + (s0 + i) * TSTR + g8 * 2) = pack8(f); }
#pragma unroll
        for (int wd = 0; wd < 4; ++wd) { const unsigned a0 = vrow[0][wd], a1 = vrow[1][wd], a2 = vrow[2][wd], a3 = vrow[3][wd]; u32x2 ev, od;
            ev.x = (a0 & 0xffffu) | (a1 << 16); ev.y = (a2 & 0xffffu) | (a3 << 16); od.x = (a0 >> 16) | (a1 & 0xffff0000u); od.y = (a2 >> 16) | (a3 & 0xffff0000u);
            *(LAS u32x2*)(lds + ML_V + (vd8 + 2 * wd) * TSTR + vs0 * 2) = ev; *(LAS u32x2*)(lds + ML_V + (vd8 + 2 * wd + 1) * TSTR + vs0 * 2) = od; }
    }
    const int ti = 16 * wid + r, t = c * CH + ti; const float2 ft = FM[t]; float2 f0 = make_float2(0.f, 0.f); if (c > 0) f0 = FM[c * CH - 1];
    const bf16_t* rowp = proj + (size_t)(b * SEQ + t) * NPJ; bf16_t* mixed = (bf16_t*)(p.ws + WS_MIXED) + (size_t)(b * SEQ + t) * DM + 512 + h * 128;
    u32x2 ows[8], zws[8]; float4 nws[8];
#pragma unroll
    for (int mt = 0; mt < 8; ++mt) { const int dv = 16 * mt + 4 * quad; ows[mt] = *(const u32x2*)(rowp + C_MO + h * 128 + dv); zws[mt] = *(const u32x2*)(rowp + C_MZ + h * 128 + dv); nws[mt] = *(const float4*)(p.mhw + h * 128 + dv); }
    __syncthreads();
    bf16x8 qf[4];
#pragma unroll
    for (int ks = 0; ks < 4; ++ks) qf[ks] = *(const LAS bf16x8*)(lds + ML_Q + (16 * wid + r) * TSTR + ks * 64 + quad * 16);
    const float winter = __expf(ft.x - f0.x + f0.y - ft.y), bt = ft.x - ft.y;
    f32x4 acc[9];
#pragma unroll
    for (int mt = 0; mt < 9; ++mt) acc[mt] = (f32x4){0.f, 0.f, 0.f, 0.f};
#pragma unroll
    for (int ks = 0; ks < 4; ++ks)
#pragma unroll
        for (int mt = 0; mt < 9; ++mt) { const bf16x8 a = *(const LAS bf16x8*)(lds + ML_S + (16 * mt + r) * TSTR + ks * 64 + quad * 16); acc[mt] = mfma16(a, qf[ks], acc[mt]); }
#pragma unroll
    for (int mt = 0; mt < 9; ++mt) acc[mt] *= winter;
    const LAS float* as = (const LAS float*)(lds + ML_AS);
    for (int sp = 0; sp <= (wid >> 1); ++sp) {
        u32x4 pw;
#pragma unroll
        for (int half = 0; half < 2; ++half) { const int st = 2 * sp + half; f32x4 c4 = {0.f, 0.f, 0.f, 0.f};
            if (st <= wid) {
#pragma unroll
                for (int ks = 0; ks < 4; ++ks) { const bf16x8 a = *(const LAS bf16x8*)(lds + ML_K + (16 * st + r) * TSTR + ks * 64 + quad * 16); c4 = mfma16(a, qf[ks], c4); }
                const f32x4 av = *(const LAS f32x4*)(as + 16 * st + 4 * quad);
#pragma unroll
                for (int v = 0; v < 4; ++v) { const int si = 16 * st + 4 * quad + v; c4[v] = (si <= ti) ? c4[v] * __expf(bt + av[v]) : 0.f; } }
            if (half == 0) { pw.x = pk2(c4[0], c4[1]); pw.y = pk2(c4[2], c4[3]); } else { pw.z = pk2(c4[0], c4[1]); pw.w = pk2(c4[2], c4[3]); } }
        const bf16x8 pb = __builtin_bit_cast(bf16x8, pw);
#pragma unroll
        for (int mt = 0; mt < 9; ++mt) { const LAS uchar* vp = lds + ML_V + (16 * mt + r) * TSTR + (32 * sp + 4 * quad) * 2;
            u32x4 aw; const u32x2 lo = *(const LAS u32x2*)vp, hi = *(const LAS u32x2*)(vp + 32); aw.x = lo.x; aw.y = lo.y; aw.z = hi.x; aw.w = hi.y;
            acc[mt] = mfma16(__builtin_bit_cast(bf16x8, aw), pb, acc[mt]); } }
    const float den = __shfl(acc[8][0], r);
    const float inv = __builtin_amdgcn_rcpf(fmaxf(fabsf(den), __expf(-ft.y)));
    float ss = 0.f;
#pragma unroll
    for (int mt = 0; mt < 8; ++mt)
#pragma unroll
        for (int v = 0; v < 4; ++v) { acc[mt][v] *= inv; ss += acc[mt][v] * acc[mt][v]; }
    ss += __shfl_xor(ss, 16); ss += __shfl_xor(ss, 32);
    const float rstd = rsqrtf(ss * (1.0f / 128) + 1e-6f);
#pragma unroll
    for (int mt = 0; mt < 8; ++mt) { const int dv = 16 * mt + 4 * quad; const u32x2 ow = ows[mt], zw = zws[mt];
        const float4 nw = nws[mt];
        const f32x2 o0 = (f32x2){bflo(ow.x), bfhi(ow.x)}, o1 = (f32x2){bflo(ow.y), bfhi(ow.y)}, z0 = (f32x2){bflo(zw.x), bfhi(zw.x)}, z1 = (f32x2){bflo(zw.y), bfhi(zw.y)};
        const f32x2 ao0 = o0 * -1.4426950408889634f, ao1 = o1 * -1.4426950408889634f, az0 = z0 * -1.4426950408889634f, az1 = z1 * -1.4426950408889634f;
        f32x2 eo0, eo1, ez0, ez1; eo0.x = __builtin_amdgcn_exp2f(ao0.x); eo0.y = __builtin_amdgcn_exp2f(ao0.y); eo1.x = __builtin_amdgcn_exp2f(ao1.x); eo1.y = __builtin_amdgcn_exp2f(ao1.y);
        ez0.x = __builtin_amdgcn_exp2f(az0.x); ez0.y = __builtin_amdgcn_exp2f(az0.y); ez1.x = __builtin_amdgcn_exp2f(az1.x); ez1.y = __builtin_amdgcn_exp2f(az1.y);
        const f32x2 d0 = (eo0 + 1.0f) * (ez0 + 1.0f), d1 = (eo1 + 1.0f) * (ez1 + 1.0f);
        f32x2 r0, r1; r0.x = __builtin_amdgcn_rcpf(d0.x); r0.y = __builtin_amdgcn_rcpf(d0.y); r1.x = __builtin_amdgcn_rcpf(d1.x); r1.y = __builtin_amdgcn_rcpf(d1.y);
        const f32x2 h0 = (f32x2){acc[mt][0], acc[mt][1]}, h1 = (f32x2){acc[mt][2], acc[mt][3]};
        const f32x2 y0 = h0 * rstd * (f32x2){nw.x, nw.y} * z0 * r0, y1 = h1 * rstd * (f32x2){nw.z, nw.w} * z1 * r1;
        u32x2 w; w.x = pk2(y0.x, y0.y); w.y = pk2(y1.x, y1.y);
        *(u32x2*)(mixed + dv) = w; }
}

DI void mlstm_sample_item(const Params& p, LAS uchar* lds, int item) {
    const int tid = threadIdx.x, wid = tid >> 6, lane = tid & 63;
    const int h = item & 3, b = item >> 2;
    const bf16_t* proj = (const bf16_t*)(p.ws + WS_PROJ); const float* gates = (const float*)(p.ws + WS_GATES);
    LAS float* qs = (LAS float*)lds;
    LAS float* ks = qs + 512;
    LAS float* vs = ks + 512;
    LAS float* red = vs + 512;
    LAS float* dred = red + 2048;
    LAS float* sred = dred + 8;
    __syncthreads();
    const int dv = tid & 127, dkq = tid >> 7;
    const float* S0 = p.sC + ((size_t)(b * 4 + h) * 128 + dkq * 32) * 128 + dv;
    float S[32];
#pragma unroll
    for (int i = 0; i < 32; ++i) S[i] = S0[(size_t)i * 128];
    float nn = 0.f; if (tid < 128) nn = p.sn[(size_t)(b * 4 + h) * 128 + tid];
    const bf16_t* rowf = proj + (size_t)(NTP + b * 4 + (tid >> 7)) * NPJ;
    const unsigned ogr = rowf[C_MO + h * 128 + dv], zgr = rowf[C_MZ + h * 128 + dv]; const float mhr = p.mhw[h * 128 + dv];
    float cvs[2];
#pragma unroll
    for (int i = tid; i < 1024; i += 512) { const int t = i >> 8, lc = i & 255, ch = (lc < 128 ? 0 : 512) + h * 128 + (lc & 127);
        float y = p.conv_b[ch]; float xx[4], ww[4];
#pragma unroll
        for (int j = 0; j < 4; ++j) { const int tt = t - 3 + j; ww[j] = p.conv_w[j * 1024 + ch];
            if (tt < 0) xx[j] = p.sconv[(size_t)(b * 3 + 3 + tt) * 1024 + ch];
            else xx[j] = __uint_as_float((unsigned)proj[(size_t)(NTP + b * 4 + tt) * NPJ + C_MQ + ch] << 16); }
#pragma unroll
        for (int j = 0; j < 4; ++j) y += ww[j] * xx[j];
        cvs[i >> 9] = xx[3];
        y = silu(y);
        if (lc < 128) qs[t * 128 + lc] = y; else ks[t * 128 + (lc - 128)] = y * 0.08838834764831845f; }
    { const int t = tid >> 7, dv = tid & 127; vs[tid] = __uint_as_float((unsigned)proj[(size_t)(NTP + b * 4 + t) * NPJ + C_MV + h * 128 + dv] << 16); }
    float mt_[4], fd[4], iw[4];
    { float mprev = p.sm[b * 4 + h];
#pragma unroll
      for (int t = 0; t < 4; ++t) { const float* g = gates + (size_t)(NTP + b * 4 + t) * 8; const float li = g[h], lf = g[4 + h];
          const float m = fmaxf(lf + mprev, li); fd[t] = __expf(lf + mprev - m); iw[t] = __expf(li - m); mt_[t] = m; mprev = m; } }
    __syncthreads();
#pragma unroll
    for (int t = 0; t < 4; ++t) { const float vt = vs[t * 128 + dv] * iw[t]; float part = 0.f;
        f32x2 part2 = {0.f, 0.f};
#pragma unroll
        for (int i = 0; i < 32; i += 4) { const f32x4 k4 = *(const LAS f32x4*)(ks + t * 128 + dkq * 32 + i), q4 = *(const LAS f32x4*)(qs + t * 128 + dkq * 32 + i);
            f32x2 s01 = (f32x2){S[i], S[i + 1]}, s23 = (f32x2){S[i + 2], S[i + 3]};
            s01 = s01 * fd[t] + (f32x2){k4[0], k4[1]} * vt; s23 = s23 * fd[t] + (f32x2){k4[2], k4[3]} * vt;
            part2 += (f32x2){q4[0], q4[1]} * s01; part2 += (f32x2){q4[2], q4[3]} * s23;
            S[i] = s01.x; S[i + 1] = s01.y; S[i + 2] = s23.x; S[i + 3] = s23.y; }
        part = part2.x + part2.y;
        red[(dkq * 4 + t) * 128 + dv] = part;
        if (tid < 128) { nn = fd[t] * nn + iw[t] * ks[t * 128 + tid]; const float dp = wsum(qs[t * 128 + tid] * nn); if (lane == 0) dred[t * 2 + wid] = dp; } }
    float* Sout = p.out + O_CS + ((size_t)(b * 4 + h) * 128 + dkq * 32) * 128 + dv;
#pragma unroll
    for (int i = 0; i < 32; ++i) Sout[(size_t)i * 128] = S[i];
#pragma unroll
    for (int q = 0; q < 2; ++q) { const int i = tid + 512 * q, t = i >> 8, lc = i & 255, ch = (lc < 128 ? 0 : 512) + h * 128 + (lc & 127); if (t >= 1) p.out[O_CONVS + (size_t)(b * 3 + t - 1) * 1024 + ch] = cvs[q]; }
    if (tid < 128) p.out[O_NS + (size_t)(b * 4 + h) * 128 + tid] = nn;
    if (tid == 0) p.out[O_MS + b * 4 + h] = mt_[3];
    __syncthreads();
    { const int t = tid >> 7; const float num = red[(0 * 4 + t) * 128 + dv] + red[(1 * 4 + t) * 128 + dv] + red[(2 * 4 + t) * 128 + dv] + red[(3 * 4 + t) * 128 + dv];
      const float den = dred[t * 2] + dred[t * 2 + 1];
      const float mtv = t == 0 ? mt_[0] : t == 1 ? mt_[1] : t == 2 ? mt_[2] : mt_[3];
      const float hv = num / fmaxf(fabsf(den), __expf(-mtv));
      const float sq = wsum(hv * hv); if (lane == 0) sred[t * 2 + (wid & 1)] = sq;
      __syncthreads();
      const float rstd = rsqrtf((sred[t * 2] + sred[t * 2 + 1]) * (1.0f / 128) + 1e-6f);
      const size_t row = (size_t)(NTP + b * 4 + t);
      const float og = sigm(__uint_as_float(ogr << 16)), zg = silu(__uint_as_float(zgr << 16));
      ((bf16_t*)(p.ws + WS_MIXED))[row * DM + 512 + h * 128 + dv] = f2bf(hv * rstd * mhr * og * zg); }
}

DI void phase2(const Params& p, LAS uchar* lds) {
    const int nb = gridDim.x, bid = blockIdx.x, tid = threadIdx.x;
#ifndef REP_AP
#define REP_AP 1
#define REP_MU 1
#define REP_AS 1
#define REP_MS 1
#endif
    const bool late = ((bid >> 3) & 1) == 0;
    if (!late) { for (int it = bid; it < 256; it += nb) attn_sample_item(p, lds, it);
                 for (int it = bid; it < 512; it += nb) mlstm_sample_item(p, lds, it); }
    for (int it = bid; it < 256; it += nb) attn_prompt_item(p, lds, it);
    for (int it = bid; it < 512; it += nb) mlstm_u_item(p, lds, it);
    if (late) { for (int it = bid; it < 256; it += nb) attn_sample_item(p, lds, it);
                for (int it = bid; it < 512; it += nb) mlstm_sample_item(p, lds, it); }
    for (int i = bid * 512 + tid; i < 6144; i += nb * 512) { const int ch = i & 1023, rr = (i >> 10) % 3, b = i / 3072;
        p.out[O_CONVP + i] = __uint_as_float((unsigned)((const bf16_t*)(p.ws + WS_PROJ))[(size_t)(b * SEQ + SEQ - 3 + rr) * NPJ + C_MQ + ch] << 16); }
}
DI void phase4(const Params& p, LAS uchar* lds) {
    const int nb = gridDim.x, bid = blockIdx.x;
    for (int it = bid; it < 512; it += nb) mlstm_out_item(p, lds, it);
}

__global__ __launch_bounds__(512, 2) void hymba_mega(Params p, int ph_lo, int ph_hi) {
    extern __shared__ __attribute__((aligned(16))) unsigned char shm[];
    LAS uchar* lds = (LAS uchar*)shm;
    volatile LAS unsigned* st = (volatile LAS unsigned*)(lds + LDS_MAIN);
    if (threadIdx.x == 0) { st[0] = 0u; st[1] = 0u; }
    __syncthreads();
    const XcdBarrier xb = xcd_barrier_post((unsigned*)(p.ws + WS_BAR), st);
#ifdef PROBE_K
#define STAMP(i) ts[i] = wall_clock64();
    unsigned long long ts[7];
#else
#define STAMP(i)
#endif
#define RUNPH(n, call) if (ph_lo <= n && n < ph_hi) { if (ph_lo < n) xcd_barrier(xb); STAMP(n) call; }
    RUNPH(0, phase0(p, lds)) RUNPH(1, phase1(p, lds)) RUNPH(2, phase2(p, lds)) RUNPH(3, mlstm_scan(p, lds)) RUNPH(4, phase4(p, lds)) RUNPH(5, phase5(p, lds))
#ifdef PROBE_K
    xcd_barrier(xb); STAMP(6)
    if (blockIdx.x == 0 && threadIdx.x == 0) { const unsigned long long dt = (ts[PROBE_K + 1] - ts[PROBE_K]) * 4ull; while (wall_clock64() - ts[6] < dt) __builtin_amdgcn_s_sleep(8); }
#endif
}

#ifndef N_LAUNCHES
#define N_LAUNCHES 1
#endif
extern "C" void kernel_launch(void* const* d_in, const int* in_sizes, int n_in, void* d_out, int out_size, void* d_ws, size_t ws_size, hipStream_t stream) {
    static int grid = 0;
    if (grid == 0) {
        int dev = 0, cus = 0, per_cu = 0;
        hipGetDevice(&dev); hipDeviceGetAttribute(&cus, hipDeviceAttributeMultiprocessorCount, dev);
        if (hipFuncSetAttribute((const void*)hymba_mega, hipFuncAttributeMaxDynamicSharedMemorySize, LDS_BYTES) != hipSuccess) { fprintf(stderr, "hipFuncSetAttribute failed\n"); }
        if (hipOccupancyMaxActiveBlocksPerMultiprocessor(&per_cu, (const void*)hymba_mega, 512, LDS_BYTES) != hipSuccess || per_cu < 1) { fprintf(stderr, "occupancy query: %d\n", per_cu); per_cu = 1; }
        (void)hipGetLastError();
        grid = cus * per_cu;
        if (ws_size < WS_END || n_in != 18) { fprintf(stderr, "bad ws/n_in\n"); grid = -1; }
    }
    if (grid < 0) return;
    if (hipMemsetAsync((char*)d_ws + WS_BAR, 0, XCD_BAR_WORDS * sizeof(unsigned), stream) != hipSuccess) { fprintf(stderr, "memset failed\n"); return; }
    Params p{};
    p.x_p = (const float*)d_in[0]; p.x_s = (const float*)d_in[1]; p.ck = (const float*)d_in[2]; p.cv = (const float*)d_in[3]; p.sconv = (const float*)d_in[4];
    p.sC = (const float*)d_in[5]; p.sn = (const float*)d_in[6]; p.sm = (const float*)d_in[7]; p.norm_w = (const float*)d_in[8]; p.w_in = (const float*)d_in[9];
    p.b_gates = (const float*)d_in[10]; p.conv_w = (const float*)d_in[11]; p.conv_b = (const float*)d_in[12]; p.qnw = (const float*)d_in[13]; p.knw = (const float*)d_in[14];
    p.sinks = (const float*)d_in[15]; p.mhw = (const float*)d_in[16]; p.w_out = (const float*)d_in[17];
    p.out = (float*)d_out; p.ws = (uchar*)d_ws;
    if (N_LAUNCHES == 1) {
#ifdef PLAIN_LAUNCH
        hipLaunchKernelGGL(hymba_mega, dim3(grid), dim3(512), LDS_BYTES, stream, p, 0, 6);
#else
        int lo = 0, hi = 6; void* args[] = {&p, &lo, &hi};
        hipError_t e = hipLaunchCooperativeKernel((const void*)hymba_mega, dim3(grid), dim3(512), args, LDS_BYTES, stream);
        if (e != hipSuccess) fprintf(stderr, "cooperative launch failed: %s (grid %d)\n", hipGetErrorString(e), grid);
#endif
    } else {
#ifndef PHLIST
#define PHLIST {0, 1, 2, 3, 4, 5}
#endif
        const int phl[] = PHLIST;
        for (int i = 0; i < (int)(sizeof(phl) / sizeof(int)); ++i) hipLaunchKernelGGL(hymba_mega, dim3(grid), dim3(512), LDS_BYTES, stream, p, phl[i], phl[i] + 1);
    }
}
```

```cpp
#define N_LAUNCHES 1
#include <hip/hip_runtime.h>
#include <hip/hip_cooperative_groups.h>
#include <cstdio>
namespace cg = cooperative_groups;
#define LAS __attribute__((address_space(3)))
namespace pg8 {
#define PG8_LAS __attribute__((address_space(3)))
typedef unsigned short bf16_t;
typedef short bf16x8 __attribute__((ext_vector_type(8)));
typedef float f32x4 __attribute__((ext_vector_type(4)));
typedef unsigned u32x4 __attribute__((ext_vector_type(4)));
constexpr int BM = 256, BK = 64, HALF = 128, HTB = HALF * BK * 2  , STAGE_BYTES = 8 * HTB, NXCD = 8, WGM = 8;

__host__ __device__ __forceinline__ int lds_byte(int r, int c) { const int st = (r >> 4) * 2 + (c >> 5), rr = r & 15, cc = c & 31, ob = rr * 64 + cc * 2; return st * 1024 + (ob ^ (((ob >> 9) & 1) << 5)); }
__host__ __device__ __forceinline__ void stage_rc(int b, int& R, int& C) { const int st = b / 1024, sb = b % 1024, swz = sb ^ (((sb >> 9) & 1) << 5); R = (st >> 1) * 16 + swz / 64; C = (st & 1) * 32 + (swz % 64) / 2; }
__host__ __device__ __forceinline__ int perm32(int rho) { const int n = rho >> 4, i = rho & 15; return 8 * (i >> 2) + 4 * n + (i & 3); }

struct Unit { int pm, pn; };
struct Gemm { const bf16_t* A; const bf16_t* Bt; int M, N, K; };

struct StaticOrder {
    int nM, nN, nwg, G, c;
    __host__ __device__ void init(int M, int N, int G_, int c_) { nM = M / BM; nN = N / BM; nwg = nM * nN; G = G_; c = c_; }
    __host__ __device__ bool next(int i, Unit& u) const {
        const long L = (long)i * G + c; if (L >= nwg) return false;
        int wgid = (int)L; { const int q = nwg / NXCD, r = nwg % NXCD, xcd = wgid % NXCD, off = wgid / NXCD; wgid = (xcd < r ? xcd * (q + 1) : r * (q + 1) + (xcd - r) * q) + off; }
        const int nig = WGM * nN, gid = wgid / nig, fm = gid * WGM, gsz = (nM - fm) < WGM ? (nM - fm) : WGM;
        u.pm = fm + ((wgid % nig) % gsz); u.pn = (wgid % nig) / gsz; return true;
    }
    __device__ __forceinline__ void a_ready(const Unit&) const {}
    __device__ __forceinline__ void done(const Unit&) const {}
};
__device__ __forceinline__ unsigned cvt_pk_bf16(float lo, float hi) { unsigned r; asm volatile("v_cvt_pk_bf16_f32 %0, %1, %2" : "=v"(r) : "v"(lo), "v"(hi)); return r; }
template <class Epi, class Sched, bool STAMP = false>
__device__ __forceinline__ void gemm_phase(PG8_LAS unsigned char* lds, const Gemm g, const Sched& S, const Epi& E, unsigned long long* stamps) {
    const int tid = threadIdx.x, wid = __builtin_amdgcn_readfirstlane(tid >> 6), lane = tid & 63, wr = wid >> 2, wc = wid & 3, fr = lane & 15, fq = lane >> 4;
    const int K = g.K, nt = K / BK;
    int ts_lo = 0, ts_hi = 0, nts = 0; const unsigned long long rt_entry = STAMP ? (unsigned long long)wall_clock64() : 0ull;
#define PG8_STAMP() do { if (STAMP && wid == 0 && nts < 64) { const unsigned long long _c = (unsigned long long)clock64(); \
        ts_lo = (lane == nts) ? (int)(unsigned)_c : ts_lo; ts_hi = (lane == nts) ? (int)(unsigned)(_c >> 32) : ts_hi; ++nts; } } while (0)
    PG8_STAMP();
    unsigned voffA[2], voffB[2];
#pragma unroll
    for (int i = 0; i < 2; ++i) { int R, C; stage_rc(tid * 16 + i * 8192, R, C); const int Rb = Epi::PERM ? ((R & ~31) + perm32(R & 31)) : R;
        voffA[i] = (unsigned)(R * K + C) * 2u; voffB[i] = (unsigned)(Rb * K + C) * 2u; }
    const size_t kstep = (size_t)(BK * 2);
    const size_t hstep = (size_t)HALF * K * 2;
    const size_t tstep = 2 * hstep;
    const unsigned ldsw = (unsigned)wid * 1024u;
    const int aoff = lds_byte(wr * 64 + fr, fq * 8), boff = lds_byte(wc * 32 + fr, fq * 8);
#define PG8_SA(b, h) (((b) * 2 + (h)) * HTB)
#define PG8_SB(b, h) ((4 + (b) * 2 + (h)) * HTB)
#define PG8_STAGE(bufoff, gbase, voff) do { _Pragma("unroll") for (int _i = 0; _i < 2; ++_i) \
        __builtin_amdgcn_global_load_lds((const unsigned*)((const char*)(gbase) + (voff)[_i]), (PG8_LAS unsigned*)(lds + (bufoff) + ldsw + _i * 8192), 16, 0, 0); } while (0)
#define PG8_LDA(dst, b, h) do { _Pragma("unroll") for (int m = 0; m < 4; ++m) _Pragma("unroll") for (int k = 0; k < 2; ++k) dst[m][k] = *(const PG8_LAS bf16x8*)(lds + PG8_SA(b, h) + aoff + m * 2048 + k * 1024); } while (0)
#define PG8_LDB(dst, b, h) do { _Pragma("unroll") for (int n = 0; n < 2; ++n) _Pragma("unroll") for (int k = 0; k < 2; ++k) dst[n][k] = *(const PG8_LAS bf16x8*)(lds + PG8_SB(b, h) + boff + n * 2048 + k * 1024); } while (0)
#define PG8_MMA(ai, bj, At, Bt) do { __builtin_amdgcn_s_setprio(1); _Pragma("unroll") for (int m = 0; m < 4; ++m) _Pragma("unroll") for (int n = 0; n < 2; ++n) _Pragma("unroll") for (int k = 0; k < 2; ++k) \
        acc[ai][bj][m][n] = __builtin_amdgcn_mfma_f32_16x16x32_bf16(Bt[n][k], At[m][k], acc[ai][bj][m][n], 0, 0, 0); __builtin_amdgcn_s_setprio(0); } while (0)
#define PG8_WAIT_V(n) asm volatile("s_waitcnt vmcnt(" #n ")" ::: "memory")
#define PG8_WAIT_L(n) asm volatile("s_waitcnt lgkmcnt(" #n ")" ::: "memory")
#define PG8_BAR __builtin_amdgcn_s_barrier()
#define PG8_SCHED __builtin_amdgcn_sched_barrier(0)
    Unit cur, nxt; int ui = 0;
    if (!S.next(0, cur)) return;
    f32x4 acc[2][2][4][2];
#pragma unroll
    for (int a = 0; a < 2; ++a)
#pragma unroll
        for (int b = 0; b < 2; ++b)
#pragma unroll
            for (int m = 0; m < 4; ++m)
#pragma unroll
                for (int n = 0; n < 2; ++n) acc[a][b][m][n] = (f32x4){0.f, 0.f, 0.f, 0.f};
    bf16x8 At[4][2], B0[2][2], B1[2][2];
    const char* cA = (const char*)g.A + (size_t)cur.pm * tstep; const char* cB = (const char*)g.Bt + (size_t)cur.pn * tstep;
    S.a_ready(cur);
    PG8_STAGE(PG8_SB(0, 0), cB, voffB); PG8_STAGE(PG8_SA(0, 0), cA, voffA); PG8_STAGE(PG8_SB(0, 1), cB + hstep, voffB); PG8_STAGE(PG8_SA(0, 1), cA + hstep, voffA);
    if (wr == 1) PG8_BAR;
    PG8_WAIT_V(4); PG8_BAR;
    PG8_STAGE(PG8_SB(1, 0), cB + kstep, voffB); PG8_STAGE(PG8_SA(1, 0), cA + kstep, voffA); PG8_STAGE(PG8_SB(1, 1), cB + hstep + kstep, voffB);
    PG8_WAIT_V(6); PG8_BAR;
    PG8_STAMP();
    for (;;) {
        const bool has_next = S.next(ui + 1, nxt);
        const char* nA = has_next ? (const char*)g.A + (size_t)nxt.pm * tstep : cA; const char* nB = has_next ? (const char*)g.Bt + (size_t)nxt.pn * tstep : cB;
        for (int t = 0; t < nt; t += 2) {
            const bool last = (t == nt - 2);
            const char* a1 = cA + (size_t)(t + 1) * kstep;
            const char* a2 = last ? nA : cA + (size_t)(t + 2) * kstep; const char* b2 = last ? nB : cB + (size_t)(t + 2) * kstep;
            const char* a3 = a2 + kstep; const char* b3 = b2 + kstep;
            if (last && has_next) S.a_ready(nxt);
            PG8_LDB(B0, 0, 0); PG8_SCHED; PG8_LDA(At, 0, 0); PG8_STAGE(PG8_SA(1, 1), a1 + hstep, voffA);
            PG8_WAIT_L(8); PG8_BAR; PG8_WAIT_L(0); PG8_MMA(0, 0, At, B0); PG8_BAR; PG8_SCHED;
            PG8_LDB(B1, 0, 1); PG8_STAGE(PG8_SB(0, 0), b2, voffB);
            PG8_BAR; PG8_WAIT_L(0); PG8_MMA(0, 1, At, B1); PG8_BAR;
            PG8_LDA(At, 0, 1); PG8_STAGE(PG8_SA(0, 0), a2, voffA);
            PG8_BAR; PG8_WAIT_L(0); PG8_MMA(1, 0, At, B0); PG8_BAR; PG8_SCHED;
            PG8_STAGE(PG8_SB(0, 1), b2 + hstep, voffB);
            PG8_WAIT_V(6); PG8_BAR; PG8_MMA(1, 1, At, B1); PG8_BAR;
            PG8_LDB(B0, 1, 0); PG8_SCHED; PG8_LDA(At, 1, 0); PG8_STAGE(PG8_SA(0, 1), a2 + hstep, voffA);
            PG8_WAIT_L(8); PG8_BAR; PG8_WAIT_L(0); PG8_MMA(0, 0, At, B0); PG8_BAR; PG8_SCHED;
            PG8_LDB(B1, 1, 1); PG8_STAGE(PG8_SB(1, 0), b3, voffB);
            PG8_BAR; PG8_WAIT_L(0); PG8_MMA(0, 1, At, B1); PG8_BAR;
            PG8_LDA(At, 1, 1); PG8_STAGE(PG8_SA(1, 0), a3, voffA);
            PG8_BAR; PG8_WAIT_L(0); PG8_MMA(1, 0, At, B0); PG8_BAR; PG8_SCHED;
            PG8_STAGE(PG8_SB(1, 1), b3 + hstep, voffB);
            PG8_WAIT_V(6); PG8_BAR; PG8_MMA(1, 1, At, B1); PG8_BAR;
        }
        PG8_STAMP();
        if constexpr (!Epi::AFTER_DRAIN) { E(acc, cur, wr, wc, fr, fq); S.done(cur); }
        PG8_STAMP();
        if (!has_next) break;
#pragma unroll
        for (int a = 0; a < 2; ++a)
#pragma unroll
            for (int b = 0; b < 2; ++b)
#pragma unroll
                for (int m = 0; m < 4; ++m)
#pragma unroll
                    for (int n = 0; n < 2; ++n) acc[a][b][m][n] = (f32x4){0.f, 0.f, 0.f, 0.f};
        cur = nxt; cA = nA; cB = nB; ++ui;
    }
    PG8_WAIT_V(0);
    if (wr == 0) PG8_BAR;
    PG8_BAR;
    if constexpr (Epi::AFTER_DRAIN) { E.fused(acc, cur, wr, wc, fr, fq, lds, wid, lane); S.done(cur); }
    PG8_STAMP();
    if (STAMP && wid == 0) { stamps[lane] = lane < nts ? (((unsigned long long)(unsigned)ts_hi << 32) | (unsigned)ts_lo) : 0ull;
        if (lane == 62) stamps[62] = rt_entry; if (lane == 63) stamps[63] = (unsigned long long)wall_clock64(); }
#undef PG8_STAMP
#undef PG8_SA
#undef PG8_SB
#undef PG8_STAGE
#undef PG8_LDA
#undef PG8_LDB
#undef PG8_MMA
#undef PG8_WAIT_V
#undef PG8_WAIT_L
#undef PG8_BAR
#undef PG8_SCHED
}
}

#define XB_TMO      128
#define XB_XCNT(j)  (256  + 64 * (j))
#define XB_XSUB(j)  (1280 + 64 * (j))
#define XB_XGEN(j)  (2304 + 64 * (j))
#define XB_TOP      3328
#define XB_TOPGEN   3392
#define XCD_BAR_WORDS 3456
#define XB_SPIN_CAP (1u << 18)

__device__ __forceinline__ unsigned xb_ld(unsigned* p)              { return __hip_atomic_load(p, __ATOMIC_RELAXED, __HIP_MEMORY_SCOPE_AGENT); }
__device__ __forceinline__ unsigned xb_add(unsigned* p, unsigned v) { return __hip_atomic_fetch_add(p, v, __ATOMIC_RELAXED, __HIP_MEMORY_SCOPE_AGENT); }
__device__ __forceinline__ unsigned xb_xcc_id() { return (unsigned)__builtin_amdgcn_s_getreg((3 << 11) | 20) & 0xFu; }
#define XB_SPIN(cond, bar) do { unsigned _sp = 0; while (cond) { __builtin_amdgcn_s_sleep(1); \
    if ((++_sp & 255u) == 0u) { if (xb_ld(&(bar)[XB_TMO])) break; if (_sp > XB_SPIN_CAP) { atomicAdd(&(bar)[XB_TMO], 1u); break; } } } } while (0)

struct XcdBarrier {
    unsigned* bar; unsigned x;
    volatile LAS unsigned* st;
};

__device__ __forceinline__ XcdBarrier xcd_barrier_post(unsigned* bar, volatile LAS unsigned* st) {
    XcdBarrier b; b.bar = bar; b.x = xb_xcc_id(); b.st = st;
    if (threadIdx.x == 0) (void)xb_add(&bar[XB_XCNT(b.x)], 1u);
    return b;
}
__device__ __forceinline__ void xcd_barrier_complete(unsigned* bar, unsigned x, unsigned& nloc, unsigned& nx) {
    const unsigned G = gridDim.x * gridDim.y * gridDim.z;
    unsigned sum, cnt, mine, sp = 0u;
    for (;;) {
        sum = 0u; cnt = 0u; mine = 0u;
#pragma unroll
        for (unsigned j = 0; j < 16; ++j) { const unsigned c = xb_ld(&bar[XB_XCNT(j)]); sum += c; cnt += (c > 0u) ? 1u : 0u; mine = (j == x) ? c : mine; }
        if (sum == G) break;
        __builtin_amdgcn_s_sleep(1);
        if ((++sp & 255u) == 0u) { if (xb_ld(&bar[XB_TMO])) break; if (sp > XB_SPIN_CAP) { atomicAdd(&bar[XB_TMO], 1u); break; } }
    }
    nloc = mine > 0u ? mine : 1u; nx = cnt > 0u ? cnt : 1u;
}

__device__ __forceinline__ void xcd_barrier(const XcdBarrier& b) {
    asm volatile("s_waitcnt vmcnt(0)" ::: "memory");
    __syncthreads();
    if (threadIdx.x == 0) {
        unsigned* bar = b.bar;
        __builtin_amdgcn_s_waitcnt(0);
        unsigned nloc = b.st[0], nx = b.st[1];
        if (nloc == 0u) { xcd_barrier_complete(bar, b.x, nloc, nx); b.st[0] = nloc; b.st[1] = nx; }
        const unsigned old = xb_add(&bar[XB_XSUB(b.x)], 1u);
        const unsigned gen = old / nloc;
        if (old + 1u == (gen + 1u) * nloc) {
            __builtin_amdgcn_fence(__ATOMIC_RELEASE, "agent");
            asm volatile("s_waitcnt vmcnt(0)" ::: "memory");
            const unsigned og = xb_add(&bar[XB_TOP], 1u);
            const unsigned tg = og / nx;
            if (og + 1u == (tg + 1u) * nx) xb_add(&bar[XB_TOPGEN], 1u);
            else XB_SPIN(xb_ld(&bar[XB_TOPGEN]) == tg, bar);
            __builtin_amdgcn_fence(__ATOMIC_ACQUIRE, "agent");
            xb_add(&bar[XB_XGEN(b.x)], 1u);
            asm volatile("s_waitcnt vmcnt(0)" ::: "memory");
        } else {
            XB_SPIN(xb_ld(&bar[XB_XGEN(b.x)]) == gen, bar);
            __builtin_amdgcn_fence(__ATOMIC_ACQUIRE, "agent");
            asm volatile("s_waitcnt vmcnt(0)" ::: "memory");
        }
    }
    __syncthreads();
}

using pg8::bf16_t; using pg8::bf16x8; using pg8::f32x4; using pg8::u32x4;
#define DI __device__ __forceinline__
typedef unsigned char uchar;
typedef unsigned u32x2 __attribute__((ext_vector_type(2)));

constexpr int NTP = 16384, NTS = 512, NTOK = 16896, DM = 1024, DIN = 3848, NGE = 3840, NPJ = 3328, SEQ = 8192;
constexpr int C_AQ = 0, C_AK = 512, C_AV = 640, C_AG = 768, C_MQ = 1280, C_MK = 1792, C_MV = 2304, C_G = 2816;
constexpr int NCH = 64, CH = 128, USZ = 129 * 128;
constexpr size_t O_Y = 0, O_KWP = 17301504, O_VWP = 17334272, O_CONVP = 17367040, O_CP = 17373184, O_NP = 17504256, O_MP = 17505280,
                 O_KWS = 17505288, O_VWS = 19602440, O_CONVS = 21699592, O_CS = 22092808, O_NS = 30481416, O_MS = 30546952;
constexpr size_t WS_WTIN = 0, WS_WTOUT = 7864320, WS_H = 9961472, WS_GATES = 44564480, WS_ROPE = 45105152, WS_FM = 45637632,
                 WS_PROJ = 46161920, WS_UST = 175923200, WS_MIXED = 209739776, WS_BAR = 244342784, WS_SB = 244342784 + 16384, WS_END = WS_SB + 16908288;
constexpr int LDS_MAIN = 151552, LDS_BYTES = LDS_MAIN + 16;

struct Params {
    const float *x_p, *x_s, *ck, *cv, *sconv, *sC, *sn, *sm, *norm_w, *w_in, *b_gates, *conv_w, *conv_b, *qnw, *knw, *sinks, *mhw, *w_out;
    float* out; uchar* ws;
};

DI float bflo(unsigned w) { return __uint_as_float(w << 16); }
DI float bfhi(unsigned w) { return __uint_as_float(w & 0xffff0000u); }
DI unsigned pk2(float a, float b) { return pg8::cvt_pk_bf16(a, b); }
DI bf16_t f2bf(float f) { unsigned u = __float_as_uint(f); u += 0x7fffu + ((u >> 16) & 1u); return (bf16_t)(u >> 16); }
DI void unpack8(const u32x4 w, float (&f)[8]) { f[0] = bflo(w.x); f[1] = bfhi(w.x); f[2] = bflo(w.y); f[3] = bfhi(w.y); f[4] = bflo(w.z); f[5] = bfhi(w.z); f[6] = bflo(w.w); f[7] = bfhi(w.w); }
DI u32x4 pack8(const float (&f)[8]) { u32x4 w; w.x = pk2(f[0], f[1]); w.y = pk2(f[2], f[3]); w.z = pk2(f[4], f[5]); w.w = pk2(f[6], f[7]); return w; }
DI float wsum(float v) { for (int o = 32; o; o >>= 1) v += __shfl_xor(v, o); return v; }
DI float silu(float x) { return x * __builtin_amdgcn_rcpf(1.0f + __builtin_amdgcn_exp2f(-1.4426950408889634f * x)); }
DI float sigm(float x) { return __builtin_amdgcn_rcpf(1.0f + __builtin_amdgcn_exp2f(-1.4426950408889634f * x)); }
DI f32x4 mfma16(bf16x8 a, bf16x8 b, f32x4 c) { return __builtin_amdgcn_mfma_f32_16x16x32_bf16(a, b, c, 0, 0, 0); }

typedef float f32x2g __attribute__((ext_vector_type(2)));
DI void norm_row(const Params& p, const LAS float* wg, int row, const float4 (&xv)[4], const float4 (&nw)[4], float bgl, int lane) {
    bf16_t* H = (bf16_t*)(p.ws + WS_H); float* gates = (float*)(p.ws + WS_GATES);
    float ss = 0.f;
#pragma unroll
    for (int i = 0; i < 4; ++i) ss += xv[i].x * xv[i].x + xv[i].y * xv[i].y + xv[i].z * xv[i].z + xv[i].w * xv[i].w;
    ss = wsum(ss); const float rstd = rsqrtf(ss * (1.0f / DM) + 1e-6f);
    f32x2g g2[8];
#pragma unroll
    for (int j = 0; j < 8; ++j) g2[j] = (f32x2g){0.f, 0.f};
    u32x2 hw[4];
#pragma unroll
    for (int i = 0; i < 4; ++i) { const int d0 = i * 256 + lane * 4;
        const f32x2g ha = (f32x2g){xv[i].x, xv[i].y} * rstd * (f32x2g){nw[i].x, nw[i].y}, hb = (f32x2g){xv[i].z, xv[i].w} * rstd * (f32x2g){nw[i].z, nw[i].w};
        hw[i].x = pk2(ha.x, ha.y); hw[i].y = pk2(hb.x, hb.y);
#pragma unroll
        for (int j = 0; j < 8; ++j) { const f32x4 wv = *(const LAS f32x4*)(wg + j * 1024 + d0); g2[j] += ha * (f32x2g){wv[0], wv[1]}; g2[j] += hb * (f32x2g){wv[2], wv[3]}; } }
#pragma unroll
    for (int i = 0; i < 4; ++i) *(u32x2*)(H + (size_t)row * DM + i * 256 + lane * 4) = hw[i];
    float g[8];
#pragma unroll
    for (int j = 0; j < 8; ++j) g[j] = g2[j].x + g2[j].y;
    const bool b5 = lane & 32, b4 = lane & 16, b3 = lane & 8;
    float r1[4], r2[2], r3;
#pragma unroll
    for (int j = 0; j < 4; ++j) { const float mine = b5 ? g[4 + j] : g[j], other = b5 ? g[j] : g[4 + j]; r1[j] = mine + __shfl_xor(other, 32); }
#pragma unroll
    for (int j = 0; j < 2; ++j) { const float mine = b4 ? r1[2 + j] : r1[j], other = b4 ? r1[j] : r1[2 + j]; r2[j] = mine + __shfl_xor(other, 16); }
    { const float mine = b3 ? r2[1] : r2[0], other = b3 ? r2[0] : r2[1]; r3 = mine + __shfl_xor(other, 8); }
    r3 += __shfl_xor(r3, 4); r3 += __shfl_xor(r3, 2); r3 += __shfl_xor(r3, 1);
    const float z = r3 + bgl; const int gi = lane >> 3;
    const float lf = fminf(z, 0.f) - __logf(1.0f + __expf(-fabsf(z)));
    if ((lane & 7) == 0) gates[(size_t)row * 8 + gi] = gi < 4 ? z : lf;
}
DI void phase0(const Params& p, LAS uchar* lds) {
    const int tid = threadIdx.x, lane = tid & 63, wid = tid >> 6, nb = gridDim.x, bid = blockIdx.x;
    LAS float* tile = (LAS float*)lds;
#ifndef REP_TR
#define REP_TR 1
#define REP_ROW 1
#define REP_ROPE 1
#endif
    for (int rp = 0; rp < REP_TR; ++rp)
    for (int t0 = bid * 2; t0 < 960 + 256; t0 += nb * 2) {
        const float* src[2]; bf16_t* dst[2]; int ld[2], k0[2], n0[2], sc0[2];
#pragma unroll
        for (int q = 0; q < 2; ++q) { const int t = t0 + q;
            if (t < 960) { const int nt = t % 60, kt = t / 60; n0[q] = nt * 64; k0[q] = kt * 64; sc0[q] = n0[q] < 2816 ? n0[q] : (((n0[q] - 2816) & 255) < 128 ? 2816 + ((n0[q] - 2816) >> 8) * 128 + ((n0[q] - 2816) & 255) : 3336 + ((n0[q] - 2816) >> 8) * 128 + ((n0[q] - 2816) & 255) - 128); src[q] = p.w_in; ld[q] = DIN; dst[q] = (bf16_t*)(p.ws + WS_WTIN); }
            else { const int t2 = t - 960, nt = t2 % 16, kt = t2 / 16; n0[q] = nt * 64; k0[q] = kt * 64; sc0[q] = n0[q]; src[q] = p.w_out; ld[q] = DM; dst[q] = (bf16_t*)(p.ws + WS_WTOUT); } }
        float4 v[2][2];
#pragma unroll
        for (int q = 0; q < 2; ++q)
#pragma unroll
            for (int ps = 0; ps < 2; ++ps) { const int kk = (tid >> 4) + 32 * ps, nn4 = (tid & 15) * 4; v[q][ps] = *(const float4*)(src[q] + (size_t)(k0[q] + kk) * ld[q] + sc0[q] + nn4); }
#pragma unroll
        for (int q = 0; q < 2; ++q)
#pragma unroll
            for (int ps = 0; ps < 2; ++ps) { const int kk = (tid >> 4) + 32 * ps, nn4 = (tid & 15) * 4; LAS float* tl = tile + q * 4160 + kk * 65 + nn4; tl[0] = v[q][ps].x; tl[1] = v[q][ps].y; tl[2] = v[q][ps].z; tl[3] = v[q][ps].w; }
        __syncthreads();
#pragma unroll
        for (int q = 0; q < 2; ++q) { const int nn = tid >> 3, kk8 = (tid & 7) * 8; float f[8];
#pragma unroll
          for (int j = 0; j < 8; ++j) f[j] = tile[q * 4160 + (kk8 + j) * 65 + nn];
          *(u32x4*)(dst[q] + (size_t)(n0[q] + nn) * DM + k0[q] + kk8) = pack8(f); }
        __syncthreads();
    }
    { float2* rope = (float2*)(p.ws + WS_ROPE);
      for (int rp = 0; rp < REP_ROPE; ++rp)
      for (int idx = bid * 512 + tid; idx < 8200 * 8; idx += nb * 512) { const int pos = idx >> 3, i = idx & 7;
          const float invf = (float)exp(-(double)i * 0.125 * 13.122363377404328);
          const float ang = (float)pos * invf;
          const double q = rint((double)ang * 0.6366197723675814), r = (double)ang - q * 1.5707963267948966, r2 = r * r;
          const double s = r * (1.0 + r2 * (-1.0 / 6 + r2 * (1.0 / 120 + r2 * (-1.0 / 5040 + r2 * (1.0 / 362880 + r2 * (-1.0 / 39916800 + r2 * (1.0 / 6227020800.0)))))));
          const double c = 1.0 + r2 * (-0.5 + r2 * (1.0 / 24 + r2 * (-1.0 / 720 + r2 * (1.0 / 40320 + r2 * (-1.0 / 3628800 + r2 * (1.0 / 479001600.0))))));
          const int qi = ((int)q) & 3; double cs, sn;
          if (qi == 0) { sn = s; cs = c; } else if (qi == 1) { sn = c; cs = -s; } else if (qi == 2) { sn = -s; cs = -c; } else { sn = -c; cs = s; }
          rope[idx] = make_float2((float)cs, (float)sn); } }
    LAS float* wg = (LAS float*)(lds + 32768);
    for (int d = tid; d < DM; d += 512) { const float4 a = *(const float4*)(p.w_in + (size_t)d * DIN + 3328), b = *(const float4*)(p.w_in + (size_t)d * DIN + 3332);
        wg[d] = a.x; wg[1024 + d] = a.y; wg[2048 + d] = a.z; wg[3072 + d] = a.w; wg[4096 + d] = b.x; wg[5120 + d] = b.y; wg[6144 + d] = b.z; wg[7168 + d] = b.w; }
    __syncthreads();
    float4 nwr[4];
#pragma unroll
    for (int i = 0; i < 4; ++i) nwr[i] = *(const float4*)(p.norm_w + i * 256 + lane * 4);
    const float bgr = p.b_gates[lane >> 3];
    for (int rp = 0; rp < REP_ROW; ++rp)
    for (int row = bid * 8 + wid; row < NTOK; row += nb * 16) {
        const int row2 = row + nb * 8; const bool has2 = row2 < NTOK; const int r2 = has2 ? row2 : row;
        const float* xa = row < NTP ? p.x_p + (size_t)row * DM : p.x_s + (size_t)(row - NTP) * DM;
        const float* xb = r2 < NTP ? p.x_p + (size_t)r2 * DM : p.x_s + (size_t)(r2 - NTP) * DM;
        float4 va[4], vb[4];
#pragma unroll
        for (int i = 0; i < 4; ++i) va[i] = *(const float4*)(xa + i * 256 + lane * 4);
#pragma unroll
        for (int i = 0; i < 4; ++i) vb[i] = *(const float4*)(xb + i * 256 + lane * 4);
        norm_row(p, wg, row, va, nwr, bgr, lane);
        if (has2) norm_row(p, wg, row2, vb, nwr, bgr, lane);
    }
}

DI float block_excl_sum(float v, LAS float* red, int tid) {
    const int lane = tid & 63, wid = tid >> 6; float inc = v;
#pragma unroll
    for (int o = 1; o < 64; o <<= 1) { const float t = __shfl_up(inc, o); if (lane >= o) inc += t; }
    __syncthreads(); if (lane == 63) red[wid] = inc; __syncthreads();
    float base = 0.f;
#pragma unroll
    for (int w = 0; w < 8; ++w) base += (w < wid) ? red[w] : 0.f;
    return base + inc - v;
}
DI float block_excl_max(float v, LAS float* red, int tid) {
    const int lane = tid & 63, wid = tid >> 6; float inc = v;
#pragma unroll
    for (int o = 1; o < 64; o <<= 1) { const float t = __shfl_up(inc, o); if (lane >= o) inc = fmaxf(inc, t); }
    __syncthreads(); if (lane == 63) red[wid] = inc; __syncthreads();
    float base = -INFINITY;
#pragma unroll
    for (int w = 0; w < 8; ++w) base = fmaxf(base, (w < wid) ? red[w] : -INFINITY);
    float ex = __shfl_up(inc, 1); if (lane == 0) ex = -INFINITY;
    return fmaxf(base, ex);
}
DI void gate_scan(const Params& p, LAS uchar* lds, int bh) {
    const int tid = threadIdx.x, b = bh >> 2, h = bh & 3, t0 = tid * 16;
    const float* gates = (const float*)(p.ws + WS_GATES); float2* FM = (float2*)(p.ws + WS_FM) + (size_t)bh * SEQ;
    LAS float* red = (LAS float*)lds;
    float li[16], F[16];
    float run = 0.f;
#pragma unroll
    for (int j = 0; j < 16; ++j) { const float* g = gates + (size_t)(b * SEQ + t0 + j) * 8; li[j] = g[h]; run += g[4 + h]; F[j] = run; }
    const float base = block_excl_sum(run, red, tid);
    float mx = -INFINITY, ml[16];
#pragma unroll
    for (int j = 0; j < 16; ++j) { F[j] += base; mx = fmaxf(mx, li[j] - F[j]); ml[j] = mx; }
    const float mb = fmaxf(block_excl_max(mx, red, tid), 0.0f);
#pragma unroll
    for (int j = 0; j < 16; ++j) FM[t0 + j] = make_float2(F[j], F[j] + fmaxf(ml[j], mb));
    __syncthreads();
}

struct EpiProj {
    static constexpr bool PERM = true, AFTER_DRAIN = false;
    bf16_t* O;
    __device__ __forceinline__ void operator()(const f32x4 (&acc)[2][2][4][2], const pg8::Unit& u, int wr, int wc, int fr, int fq) const {
        const int row0 = u.pm * 256 + wr * 64 + fr;
        if (u.pn < 11) { const int col0 = u.pn * 256 + wc * 32 + 8 * fq;
#pragma unroll
            for (int ai = 0; ai < 2; ++ai)
#pragma unroll
                for (int m = 0; m < 4; ++m) { bf16_t* rowp = O + (size_t)(row0 + ai * 128 + m * 16) * NPJ + col0;
#pragma unroll
                    for (int bj = 0; bj < 2; ++bj) { const f32x4 v0 = acc[ai][bj][m][0], v1 = acc[ai][bj][m][1];
                        u32x4 w; w.x = pk2(v0[0], v0[1]); w.y = pk2(v0[2], v0[3]); w.z = pk2(v1[0], v1[1]); w.w = pk2(v1[2], v1[3]);
                        *(u32x4*)(rowp + bj * 128) = w; } }
        } else { const int col0 = C_G + (u.pn - 11) * 128 + wc * 32 + 8 * fq;
#pragma unroll
            for (int ai = 0; ai < 2; ++ai)
#pragma unroll
                for (int m = 0; m < 4; ++m) { float g[8];
#pragma unroll
                    for (int n = 0; n < 2; ++n)
#pragma unroll
                        for (int e = 0; e < 4; ++e) { const float o = acc[ai][0][m][n][e], z = acc[ai][1][m][n][e];
                            g[4 * n + e] = z * __builtin_amdgcn_rcpf((1.0f + __builtin_amdgcn_exp2f(-1.4426950408889634f * o)) * (1.0f + __builtin_amdgcn_exp2f(-1.4426950408889634f * z))); }
                    *(u32x4*)(O + (size_t)(row0 + ai * 128 + m * 16) * NPJ + col0) = pack8(g); }
        }
    }
};
struct EpiOut {
    static constexpr bool PERM = false, AFTER_DRAIN = false;
    float* Y; const float* xp;
    __device__ __forceinline__ void operator()(const f32x4 (&acc)[2][2][4][2], const pg8::Unit& u, int wr, int wc, int fr, int fq) const {
        const int row0 = u.pm * 256 + wr * 64 + fr, col0 = u.pn * 256 + wc * 32 + 4 * fq;
#pragma unroll
        for (int ai = 0; ai < 2; ++ai)
#pragma unroll
            for (int mp = 0; mp < 2; ++mp) { f32x4 xv[2][2][2];
#pragma unroll
                for (int mm = 0; mm < 2; ++mm) { const float* xr = xp + (size_t)(row0 + ai * 128 + (mp * 2 + mm) * 16) * DM + col0;
#pragma unroll
                    for (int bj = 0; bj < 2; ++bj)
#pragma unroll
                        for (int n = 0; n < 2; ++n) xv[mm][bj][n] = *(const f32x4*)(xr + bj * 128 + n * 16); }
#pragma unroll
                for (int mm = 0; mm < 2; ++mm) { float* yr = Y + (size_t)(row0 + ai * 128 + (mp * 2 + mm) * 16) * DM + col0;
#pragma unroll
                    for (int bj = 0; bj < 2; ++bj)
#pragma unroll
                        for (int n = 0; n < 2; ++n) *(f32x4*)(yr + bj * 128 + n * 16) = acc[ai][bj][mp * 2 + mm][n] + xv[mm][bj][n]; } }
    }
};
DI void phase1(const Params& p, LAS uchar* lds) {
    const int nb = gridDim.x, bid = blockIdx.x;
    if (bid >= nb - 8) gate_scan(p, lds, bid - (nb - 8));
    pg8::Gemm g; g.A = (const bf16_t*)(p.ws + WS_H); g.Bt = (const bf16_t*)(p.ws + WS_WTIN); g.M = NTOK; g.N = NGE; g.K = DM;
    pg8::StaticOrder S; S.init(g.M, g.N, nb, bid);
    EpiProj E; E.O = (bf16_t*)(p.ws + WS_PROJ);
    pg8::gemm_phase<EpiProj, pg8::StaticOrder, false>(lds, g, S, E, nullptr);
}
DI void phase5(const Params& p, LAS uchar* lds) {
    const int nb = gridDim.x, bid = blockIdx.x;
    pg8::Gemm g; g.A = (const bf16_t*)(p.ws + WS_MIXED); g.Bt = (const bf16_t*)(p.ws + WS_WTOUT); g.M = NTP; g.N = DM; g.K = DM;
    pg8::StaticOrder S; S.init(g.M, g.N, nb, bid);
    EpiOut E; E.Y = p.out + O_Y; E.xp = p.x_p;
    pg8::gemm_phase<EpiOut, pg8::StaticOrder, false>(lds, g, S, E, nullptr);
}

constexpr int KSTR = 144, VSTR = 560, AT_K = 0, AT_V = 272 * KSTR, AT_R = AT_V + 64 * VSTR;
typedef float f32x2r __attribute__((ext_vector_type(2)));

DI void qk_norm_rope16(float (&x)[16], int pt, const float* nw, const float2* rope_row) {
    float ss = 0.f;
#pragma unroll
    for (int j = 0; j < 16; ++j) ss += x[j] * x[j];
    ss += __shfl_xor(ss, 1); ss += __shfl_xor(ss, 2);
    const float rstd = rsqrtf(ss * (1.0f / 64) + 1e-6f);
#pragma unroll
    for (int j = 0; j < 16; ++j) x[j] = x[j] * rstd * nw[pt * 16 + j];
    if (pt == 0) {
#pragma unroll
        for (int i = 0; i < 8; ++i) { const float2 cs = rope_row[i]; const float a = x[i], b = x[i + 8]; x[i] = a * cs.x - b * cs.y; x[i + 8] = b * cs.x + a * cs.y; } }
}
DI void qk_norm_rope16p(float (&x)[16], int pt, const float* nw, const float2 (&rp)[8]) {
    float ss = 0.f;
#pragma unroll
    for (int j = 0; j < 16; ++j) ss += x[j] * x[j];
    ss += __shfl_xor(ss, 1); ss += __shfl_xor(ss, 2);
    const float rstd = rsqrtf(ss * (1.0f / 64) + 1e-6f);
#pragma unroll
    for (int j = 0; j < 16; ++j) x[j] = x[j] * rstd * nw[pt * 16 + j];
    if (pt == 0) {
#pragma unroll
        for (int i = 0; i < 8; ++i) { const float2 cs = rp[i]; const float a = x[i], b = x[i + 8]; x[i] = a * cs.x - b * cs.y; x[i + 8] = b * cs.x + a * cs.y; } }
}
DI void kv_to_lds(LAS uchar* lds, int ki, int pt, const float (&xk)[16], const float (&xv)[16]) {
    float a[8], b[8];
#pragma unroll
    for (int j = 0; j < 8; ++j) { a[j] = xk[j]; b[j] = xk[8 + j]; }
    *(LAS u32x4*)(lds + AT_K + ki * KSTR + pt * 32) = pack8(a); *(LAS u32x4*)(lds + AT_K + ki * KSTR + pt * 32 + 16) = pack8(b);
#pragma unroll
    for (int j = 0; j < 16; j += 2) { const unsigned w = pk2(xv[j], xv[j + 1]);
        *(LAS bf16_t*)(lds + AT_V + (pt * 16 + j) * VSTR + ki * 2) = (bf16_t)(w & 0xffffu); *(LAS bf16_t*)(lds + AT_V + (pt * 16 + j + 1) * VSTR + ki * 2) = (bf16_t)(w >> 16); }
}
DI void load16bf(const bf16_t* src, float (&x)[16]) { const u32x4 w0 = *(const u32x4*)src, w1 = *(const u32x4*)(src + 8); float a[8], b[8]; unpack8(w0, a); unpack8(w1, b);
#pragma unroll
    for (int j = 0; j < 8; ++j) { x[j] = a[j]; x[8 + j] = b[j]; } }
DI void load16f(const float* src, float (&x)[16]) {
#pragma unroll
    for (int j = 0; j < 4; ++j) { const float4 v = *(const float4*)(src + 4 * j); x[4 * j] = v.x; x[4 * j + 1] = v.y; x[4 * j + 2] = v.z; x[4 * j + 3] = v.w; } }
DI void store16f(float* dst, const float (&x)[16]) {
#pragma unroll
    for (int j = 0; j < 4; ++j) *(float4*)(dst + 4 * j) = make_float4(x[4 * j], x[4 * j + 1], x[4 * j + 2], x[4 * j + 3]); }

struct QRaw { u32x4 q0, q1; u32x2 gw[4]; };
DI void attn_q_load(const Params& p, int row, int hqa, QRaw& qr) {
    const int lane = threadIdx.x & 63, quad = lane >> 4;
    const bf16_t* rowp = (const bf16_t*)(p.ws + WS_PROJ) + (size_t)row * NPJ;
    qr.q0 = *(const u32x4*)(rowp + C_AQ + hqa * 64 + 8 * quad); qr.q1 = *(const u32x4*)(rowp + C_AQ + hqa * 64 + 32 + 8 * quad);
#pragma unroll
    for (int mt = 0; mt < 4; ++mt) qr.gw[mt] = *(const u32x2*)(rowp + C_AG + hqa * 64 + 16 * mt + 4 * quad);
}
template <bool LROPE> DI void attn_q_tile(const Params& p, LAS uchar* lds, const QRaw& qr, const float (&qw0)[8], const float (&qw1)[8], int row, int pos, int hqa, int qi, int kt0, int kmin) {
    const int lane = threadIdx.x & 63, r = lane & 15, quad = lane >> 4;
    const float2* rope = (const float2*)(p.ws + WS_ROPE);
    float x0[8], x1[8];
    unpack8(qr.q0, x0); unpack8(qr.q1, x1);
    float ss = 0.f;
#pragma unroll
    for (int j = 0; j < 8; ++j) ss += x0[j] * x0[j] + x1[j] * x1[j];
    ss += __shfl_xor(ss, 16); ss += __shfl_xor(ss, 32);
    const float rstd = rsqrtf(ss * (1.0f / 64) + 1e-6f) ;
#pragma unroll
    for (int j = 0; j < 8; ++j) { x0[j] = x0[j] * rstd * qw0[j]; x1[j] = x1[j] * rstd * qw1[j]; }
#pragma unroll
    for (int j = 0; j < 8; ++j) { const float pj = __shfl_xor(x0[j], 16); float2 cs; if (LROPE) { const f32x2r c2 = *(const LAS f32x2r*)(lds + AT_R + qi * 64 + j * 8); cs = make_float2(c2.x, c2.y); } else cs = rope[(size_t)pos * 8 + j];
        const float rot = x0[j] * cs.x + (quad == 0 ? -pj : pj) * cs.y; x0[j] = (quad < 2) ? rot : x0[j]; }
#pragma unroll
    for (int j = 0; j < 8; ++j) { x0[j] *= 0.18033688011112042f; x1[j] *= 0.18033688011112042f; }
    const bf16x8 qf0 = __builtin_bit_cast(bf16x8, pack8(x0)), qf1 = __builtin_bit_cast(bf16x8, pack8(x1));
    const float sink = p.sinks[hqa] * 1.4426950408889634f;
    f32x4 s[9];
#pragma unroll
    for (int kt = 0; kt < 9; ++kt) { const int krow = (kt0 + kt) * 16 + r;
        const bf16x8 a0 = *(const LAS bf16x8*)(lds + AT_K + krow * KSTR + quad * 16), a1 = *(const LAS bf16x8*)(lds + AT_K + krow * KSTR + 64 + quad * 16);
        f32x4 acc = {0.f, 0.f, 0.f, 0.f}; acc = mfma16(a0, qf0, acc); acc = mfma16(a1, qf1, acc); s[kt] = acc; }
    float mx = sink;
#pragma unroll
    for (int kt = 0; kt < 9; ++kt) {
        if ((kt0 + kt) * 16 + 15 < kmin) { s[kt] = (f32x4){-INFINITY, -INFINITY, -INFINITY, -INFINITY}; }
        else {
            if (kt == 0) {
#pragma unroll
                for (int v = 0; v < 4; ++v) { const int ki = kt0 * 16 + quad * 4 + v; s[kt][v] = (ki > qi) ? s[kt][v] : -INFINITY; } }
            if (kt == 8) {
#pragma unroll
                for (int v = 0; v < 4; ++v) { const int ki = (kt0 + 8) * 16 + quad * 4 + v; s[kt][v] = (ki <= qi + 128) ? s[kt][v] : -INFINITY; } }
            mx = fmaxf(fmaxf(mx, fmaxf(s[kt][0], s[kt][1])), fmaxf(s[kt][2], s[kt][3])); } }
    mx = fmaxf(mx, __shfl_xor(mx, 16)); mx = fmaxf(mx, __shfl_xor(mx, 32));
    float sum = 0.f;
#pragma unroll
    for (int kt = 0; kt < 9; ++kt)
#pragma unroll
        for (int v = 0; v < 4; ++v) { const float e = __builtin_amdgcn_exp2f(s[kt][v] - mx); s[kt][v] = e; sum += e; }
    sum += __shfl_xor(sum, 16); sum += __shfl_xor(sum, 32);
    sum += __builtin_amdgcn_exp2f(sink - mx);
    const float inv = __builtin_amdgcn_rcpf(sum);
    f32x4 o[4];
#pragma unroll
    for (int mt = 0; mt < 4; ++mt) o[mt] = (f32x4){0.f, 0.f, 0.f, 0.f};
#pragma unroll
    for (int ks = 0; ks < 5; ++ks) {
        u32x4 pw; pw.x = pk2(s[2 * ks][0], s[2 * ks][1]); pw.y = pk2(s[2 * ks][2], s[2 * ks][3]);
        if (ks < 4) { pw.z = pk2(s[2 * ks + 1][0], s[2 * ks + 1][1]); pw.w = pk2(s[2 * ks + 1][2], s[2 * ks + 1][3]); } else { pw.z = 0u; pw.w = 0u; }
        const bf16x8 pb = __builtin_bit_cast(bf16x8, pw);
#pragma unroll
        for (int mt = 0; mt < 4; ++mt) { const int d = 16 * mt + r; const LAS uchar* vp = lds + AT_V + d * VSTR + ((kt0 + 2 * ks) * 16 + 4 * quad) * 2;
            u32x4 aw; const u32x2 lo = *(const LAS u32x2*)vp, hi = *(const LAS u32x2*)(vp + 32); aw.x = lo.x; aw.y = lo.y; aw.z = hi.x; aw.w = hi.y;
            o[mt] = mfma16(__builtin_bit_cast(bf16x8, aw), pb, o[mt]); } }
    bf16_t* mixed = (bf16_t*)(p.ws + WS_MIXED) + (size_t)row * DM;
#pragma unroll
    for (int mt = 0; mt < 4; ++mt) { const int col = hqa * 64 + 16 * mt + 4 * quad; const u32x2 gw = qr.gw[mt];
        u32x2 w; w.x = pk2(o[mt][0] * inv * silu(bflo(gw.x)), o[mt][1] * inv * silu(bfhi(gw.x))); w.y = pk2(o[mt][2] * inv * silu(bflo(gw.y)), o[mt][3] * inv * silu(bfhi(gw.y)));
        *(u32x2*)(mixed + col) = w; }
}

DI void attn_prompt_item(const Params& p, LAS uchar* lds, int item) {
    const int tid = threadIdx.x, wid = tid >> 6, lane = tid & 63, r = lane & 15;
    const int g = item & 1, blk = (item >> 1) & 63, b = item >> 7;
    const bf16_t* proj = (const bf16_t*)(p.ws + WS_PROJ); const float2* rope = (const float2*)(p.ws + WS_ROPE);
    const int hqa = g * 4 + (wid >> 1), qh = wid & 1;
    __syncthreads();
    float qw0[8], qw1[8];
    { const int quad = lane >> 4;
#pragma unroll
      for (int j = 0; j < 8; ++j) { qw0[j] = p.qnw[8 * quad + j]; qw1[j] = p.qnw[32 + 8 * quad + j]; } }
    u32x4 kr[2][2], vr[2][2]; float2 rp[2][8];
#pragma unroll
    for (int it = 0; it < 2; ++it) { const int u = tid + 512 * it, ki = u >> 2, pt = u & 3, tk = (blk - 1) * 128 + ki; const int tkc = tk < 0 ? 0 : tk;
        const bf16_t* rowp = proj + (size_t)(b * SEQ + tkc) * NPJ;
        kr[it][0] = *(const u32x4*)(rowp + C_AK + g * 64 + pt * 16); kr[it][1] = *(const u32x4*)(rowp + C_AK + g * 64 + pt * 16 + 8);
        vr[it][0] = *(const u32x4*)(rowp + C_AV + g * 64 + pt * 16); vr[it][1] = *(const u32x4*)(rowp + C_AV + g * 64 + pt * 16 + 8);
#pragma unroll
        for (int i = 0; i < 8; ++i) rp[it][i] = rope[(size_t)tkc * 8 + i]; }
    if (tid < 128) { u32x4 z; z.x = 0u; z.y = 0u; z.z = 0u; z.w = 0u; *(LAS u32x4*)(lds + AT_V + (tid >> 1) * VSTR + 512 + (tid & 1) * 16) = z; }
    QRaw qr[4];
#pragma unroll
    for (int i = 0; i < 4; ++i) attn_q_load(p, b * SEQ + blk * 128 + (qh * 4 + i) * 16 + r, hqa, qr[i]);
    { const float2 ra = rope[(size_t)blk * 1024 + tid], rb = rope[(size_t)blk * 1024 + 512 + tid];
      *(LAS f32x2r*)(lds + AT_R + tid * 8) = (f32x2r){ra.x, ra.y}; *(LAS f32x2r*)(lds + AT_R + (512 + tid) * 8) = (f32x2r){rb.x, rb.y}; }
#pragma unroll
    for (int it = 0; it < 2; ++it) { const int u = tid + 512 * it, ki = u >> 2, pt = u & 3;
        {
            float xk[16], xv[16]; float a[8], c[8];
            unpack8(kr[it][0], a); unpack8(kr[it][1], c);
#pragma unroll
            for (int j = 0; j < 8; ++j) { xk[j] = a[j]; xk[8 + j] = c[j]; }
            unpack8(vr[it][0], a); unpack8(vr[it][1], c);
#pragma unroll
            for (int j = 0; j < 8; ++j) { xv[j] = a[j]; xv[8 + j] = c[j]; }
            qk_norm_rope16p(xk, pt, p.knw, rp[it]);
            kv_to_lds(lds, ki, pt, xk, xv);
            if (blk == 63 && ki >= 128) { const size_t o = ((size_t)(b * 128 + ki - 128) * 2 + g) * 64 + pt * 16; store16f(p.out + O_KWP + o, xk); store16f(p.out + O_VWP + o, xv); } } }
    __syncthreads();
#pragma unroll 2
    for (int i = 0; i < 4; ++i) { const int qt = qh * 4 + i, qi = qt * 16 + r, tq = blk * 128 + qi;
        attn_q_tile<true>(p, lds, qr[0], qw0, qw1, b * SEQ + tq, tq, hqa, qi, qt, blk == 0 ? 128 : 0);
        qr[0] = qr[1]; qr[1] = qr[2]; qr[2] = qr[3]; }
}
DI void attn_sample_item(const Params& p, LAS uchar* lds, int item) {
    const int tid = threadIdx.x, wid = tid >> 6, lane = tid & 63, r = lane & 15;
    const int g = item & 1, b = item >> 1;
    const bf16_t* proj = (const bf16_t*)(p.ws + WS_PROJ); const float2* rope = (const float2*)(p.ws + WS_ROPE);
    __syncthreads();
    QRaw qrs; if (wid == 0) attn_q_load(p, NTP + b * 4 + (r >> 2), g * 4 + (r & 3), qrs);
    float qw0[8], qw1[8];
    { const int quad = lane >> 4;
#pragma unroll
      for (int j = 0; j < 8; ++j) { qw0[j] = p.qnw[8 * quad + j]; qw1[j] = p.qnw[32 + 8 * quad + j]; } }
    for (int u = tid; u < 640; u += 512) { const int ki = u >> 2, pt = u & 3;
        float xk[16], xv[16];
#pragma unroll
        for (int j = 0; j < 16; ++j) { xk[j] = 0.f; xv[j] = 0.f; }
        if (ki < 128) { const size_t o = ((size_t)(b * 128 + ki) * 2 + g) * 64 + pt * 16; load16f(p.ck + o, xk); load16f(p.cv + o, xv); }
        else { if (ki < 132) { const bf16_t* rowp = proj + (size_t)(NTP + b * 4 + ki - 128) * NPJ; load16bf(rowp + C_AK + g * 64 + pt * 16, xk); load16bf(rowp + C_AV + g * 64 + pt * 16, xv); }
               qk_norm_rope16(xk, pt, p.knw, rope + (size_t)(SEQ + (ki < 132 ? ki - 128 : 0)) * 8); }
        kv_to_lds(lds, ki, pt, xk, xv);
        if (ki >= 4 && ki < 132) { const size_t o = ((size_t)(b * 128 + ki - 4) * 2 + g) * 64 + pt * 16; store16f(p.out + O_KWS + o, xk); store16f(p.out + O_VWS + o, xv); }
    }
    __syncthreads();
    if (wid == 0) { const int t = r >> 2, hqa = g * 4 + (r & 3); attn_q_tile<false>(p, lds, qrs, qw0, qw1, NTP + b * 4 + t, SEQ + t, hqa, t, 0, 0); }
}

constexpr int TSTR = 272;
constexpr int ML_Q = 0, ML_K = 128 * TSTR, ML_V = ML_K + 128 * TSTR, ML_S = ML_V + 144 * TSTR, ML_AS = ML_S + 144 * TSTR, ML_END = ML_AS + 512;
static_assert(ML_END <= LDS_MAIN, "lds");

struct ConvIn { u32x4 row[11]; float4 w[4][2]; float4 bias[2]; };
DI void conv_issue(const Params& p, const bf16_t* proj, int b, int t0, int col, int ch, ConvIn& ci) {
#pragma unroll
    for (int i = 0; i < 11; ++i) { const int tt = t0 - 3 + i; ci.row[i] = *(const u32x4*)(proj + (size_t)(b * SEQ + (tt < 0 ? 0 : tt)) * NPJ + col); }
#pragma unroll
    for (int j = 0; j < 4; ++j) { ci.w[j][0] = *(const float4*)(p.conv_w + j * 1024 + ch); ci.w[j][1] = *(const float4*)(p.conv_w + j * 1024 + ch + 4); }
    ci.bias[0] = *(const float4*)(p.conv_b + ch); ci.bias[1] = *(const float4*)(p.conv_b + ch + 4);
}
typedef float f32x2 __attribute__((ext_vector_type(2)));
DI void conv_compute(const ConvIn& ci, int t0, float (&y)[8][8]) {
    f32x2 w[4][4], yy[8][4];
#pragma unroll
    for (int j = 0; j < 4; ++j) { w[j][0] = (f32x2){ci.w[j][0].x, ci.w[j][0].y}; w[j][1] = (f32x2){ci.w[j][0].z, ci.w[j][0].w}; w[j][2] = (f32x2){ci.w[j][1].x, ci.w[j][1].y}; w[j][3] = (f32x2){ci.w[j][1].z, ci.w[j][1].w}; }
    const f32x2 bs[4] = {(f32x2){ci.bias[0].x, ci.bias[0].y}, (f32x2){ci.bias[0].z, ci.bias[0].w}, (f32x2){ci.bias[1].x, ci.bias[1].y}, (f32x2){ci.bias[1].z, ci.bias[1].w}};
#pragma unroll
    for (int i = 0; i < 8; ++i)
#pragma unroll
        for (int q = 0; q < 4; ++q) yy[i][q] = bs[q];
#pragma unroll
    for (int r = 0; r < 11; ++r) { f32x2 x[4];
        const bool zero = (r < 3) && (t0 - 3 + r < 0);
#pragma unroll
        for (int q = 0; q < 4; ++q) { const unsigned wd = zero ? 0u : ci.row[r][q]; x[q] = (f32x2){bflo(wd), bfhi(wd)}; }
#pragma unroll
        for (int j = 0; j < 4; ++j) { const int i = r - j;
            if (i >= 0 && i < 8) {
#pragma unroll
                for (int q = 0; q < 4; ++q) yy[i][q] += w[j][q] * x[q]; } } }
#pragma unroll
    for (int i = 0; i < 8; ++i)
#pragma unroll
        for (int q = 0; q < 4; ++q) { const f32x2 v = yy[i][q], a = v * -1.4426950408889634f; f32x2 e; e.x = __builtin_amdgcn_exp2f(a.x); e.y = __builtin_amdgcn_exp2f(a.y);
            const f32x2 d = e + 1.0f; f32x2 rc; rc.x = __builtin_amdgcn_rcpf(d.x); rc.y = __builtin_amdgcn_rcpf(d.y); const f32x2 o = v * rc; y[i][2 * q] = o.x; y[i][2 * q + 1] = o.y; }
}
DI void vt_store8(LAS uchar* img, int d0, int s0, const u32x4 (&row)[8]) {
#pragma unroll
    for (int wd = 0; wd < 4; ++wd) { u32x4 ev, od;
        unsigned a[8];
#pragma unroll
        for (int i = 0; i < 8; ++i) a[i] = row[i][wd];
        ev.x = (a[0] & 0xffffu) | (a[1] << 16); ev.y = (a[2] & 0xffffu) | (a[3] << 16); ev.z = (a[4] & 0xffffu) | (a[5] << 16); ev.w = (a[6] & 0xffffu) | (a[7] << 16);
        od.x = (a[0] >> 16) | (a[1] & 0xffff0000u); od.y = (a[2] >> 16) | (a[3] & 0xffff0000u); od.z = (a[4] >> 16) | (a[5] & 0xffff0000u); od.w = (a[6] >> 16) | (a[7] & 0xffff0000u);
        *(LAS u32x4*)(img + (d0 + 2 * wd) * TSTR + s0 * 2) = ev; *(LAS u32x4*)(img + (d0 + 2 * wd + 1) * TSTR + s0 * 2) = od; }
}
DI void vt_aug_rows(LAS uchar* img, int tid) {
    if (tid < 256) { const int rr = tid >> 4, s8 = (tid & 15) * 8; const unsigned v = rr == 0 ? 0x3F803F80u : 0u; u32x4 w; w.x = v; w.y = v; w.z = v; w.w = v;
        *(LAS u32x4*)(img + (128 + rr) * TSTR + s8 * 2) = w; }
}

DI void mlstm_u_item(const Params& p, LAS uchar* lds, int item) {
    const int tid = threadIdx.x, wid = tid >> 6, lane = tid & 63, r = lane & 15, quad = lane >> 4;
    const int c = item & 63, bh = item >> 6, b = bh >> 2, h = bh & 3;
    const bf16_t* proj = (const bf16_t*)(p.ws + WS_PROJ); const float* gates = (const float*)(p.ws + WS_GATES); const float2* FM = (const float2*)(p.ws + WS_FM) + (size_t)bh * SEQ;
    LAS float* wks = (LAS float*)(lds + ML_AS);
    __syncthreads();
    if (tid < 256) {
        const int g8 = (tid & 15) * 8, s0 = (tid >> 4) * 8, t0 = c * CH + s0;
        ConvIn ci; conv_issue(p, proj, b, t0, C_MK + h * 128 + g8, 512 + h * 128 + g8, ci);
        if (tid < 128) { const int t = c * CH + tid; const float2 fe = FM[c * CH + CH - 1], fs = FM[t];
            wks[tid] = __expf(fe.x - fs.x + gates[(size_t)(b * SEQ + t) * 8 + h] - fe.y) * 0.08838834764831845f; }
        vt_aug_rows(lds + ML_V, tid);
        __syncthreads();
        float y[8][8]; conv_compute(ci, t0, y);
        const f32x4 wa = *(const LAS f32x4*)(wks + s0), wb = *(const LAS f32x4*)(wks + s0 + 4);
        const float wk[8] = {wa[0], wa[1], wa[2], wa[3], wb[0], wb[1], wb[2], wb[3]};
#pragma unroll
        for (int e = 0; e < 8; ++e) { float f[8];
#pragma unroll
            for (int i = 0; i < 8; ++i) f[i] = y[i][e] * wk[i];
            *(LAS u32x4*)(lds + ML_K + (g8 + e) * TSTR + s0 * 2) = pack8(f); }
    } else {
        const int vt = tid - 256, d8 = (vt & 15) * 8, s0 = (vt >> 4) * 8, t0 = c * CH + s0;
        u32x4 row[8];
#pragma unroll
        for (int i = 0; i < 8; ++i) row[i] = *(const u32x4*)(proj + (size_t)(b * SEQ + t0 + i) * NPJ + C_MV + h * 128 + d8);
        __syncthreads();
        vt_store8(lds + ML_V, d8, s0, row);
    }
    __syncthreads();
    f32x4 acc[9];
#pragma unroll
    for (int mt = 0; mt < 9; ++mt) acc[mt] = (f32x4){0.f, 0.f, 0.f, 0.f};
#pragma unroll
    for (int ks = 0; ks < 4; ++ks) { const bf16x8 bk = *(const LAS bf16x8*)(lds + ML_K + (16 * wid + r) * TSTR + ks * 64 + quad * 16);
#pragma unroll
        for (int mt = 0; mt < 9; ++mt) { const bf16x8 av = *(const LAS bf16x8*)(lds + ML_V + (16 * mt + r) * TSTR + ks * 64 + quad * 16); acc[mt] = mfma16(av, bk, acc[mt]); } }
    bf16_t* U = (bf16_t*)(p.ws + WS_UST) + (size_t)item * USZ;
#pragma unroll
    for (int mt = 0; mt < 9; ++mt)
#pragma unroll
        for (int v = 0; v < 4; ++v) { const int dv = 16 * mt + 4 * quad + v; if (dv <= 128) U[dv * 128 + 16 * wid + r] = f2bf(acc[mt][v]); }
}

DI void sample_outproj(const Params& p, int unit) {
    const int lane = threadIdx.x & 63, wid = threadIdx.x >> 6, r = lane & 15, quad = lane >> 4;
    const int m0 = (unit >> 4) * 32 + (wid >> 2) * 16, n0 = (unit & 15) * 64 + (wid & 3) * 16;
    const bf16_t* A = (const bf16_t*)(p.ws + WS_WTOUT) + (size_t)(n0 + r) * DM + 8 * quad;
    const bf16_t* B = (const bf16_t*)(p.ws + WS_MIXED) + (size_t)(NTP + m0 + r) * DM + 8 * quad;
    f32x4 acc0 = {0.f, 0.f, 0.f, 0.f}, acc1 = {0.f, 0.f, 0.f, 0.f};
    const f32x4 xres = *(const f32x4*)(p.x_s + (size_t)(m0 + r) * DM + n0 + 4 * quad);
#pragma unroll
    for (int hb = 0; hb < 4; ++hb) { bf16x8 af[8], bfr[8];
#pragma unroll
        for (int ks = 0; ks < 8; ++ks) { af[ks] = *(const bf16x8*)(A + (hb * 8 + ks) * 32); bfr[ks] = *(const bf16x8*)(B + (hb * 8 + ks) * 32); }
#pragma unroll
        for (int ks = 0; ks < 8; ks += 2) { acc0 = mfma16(af[ks], bfr[ks], acc0); acc1 = mfma16(af[ks + 1], bfr[ks + 1], acc1); } }
    const size_t o = (size_t)(m0 + r) * DM + n0 + 4 * quad;
    *(f32x4*)(p.out + O_Y + (size_t)NTP * DM + o) = acc0 + acc1 + xres;
}
DI void mlstm_scan(const Params& p, LAS uchar* lds) {
    const int tid = threadIdx.x, nb = gridDim.x, bid = blockIdx.x;
    const bf16_t* UST = (const bf16_t*)(p.ws + WS_UST); bf16_t* SBF = (bf16_t*)(p.ws + WS_SB);
    LAS float* dcs = (LAS float*)lds;
    for (int it = nb - 1 - bid; it < 256; it += nb) sample_outproj(p, it);
    const int per = (8 * USZ + nb - 1) / nb, base = bid * per;
    const int lim = (base + per < 8 * USZ) ? base + per : 8 * USZ;
    const int eA = base + tid, eB = base + 512 + tid; const bool hasA = eA < lim, hasB = (tid < 64) && (eB < lim);
    const int ea = hasA ? eA : 0, eb2 = hasB ? eB : 0;
    const int bhA = ea / USZ, idxA = ea - bhA * USZ, bhB = eb2 / USZ, idxB = eb2 - bhB * USZ;
    const unsigned offA = (unsigned)(bhA * NCH * USZ + idxA), offB = (unsigned)(bhB * NCH * USZ + idxB);
    float ua[64];
#pragma unroll
    for (int j = 0; j < 64; ++j) ua[j] = __uint_as_float((unsigned)(UST + (size_t)j * USZ)[offA] << 16);
    __syncthreads();
    { const int bh = tid >> 6, c = tid & 63; const float2* FM = (const float2*)(p.ws + WS_FM) + (size_t)bh * SEQ;
      const float2 fe = FM[c * CH + CH - 1]; float2 pv = make_float2(0.f, 0.f); if (c > 0) pv = FM[c * CH - 1];
      dcs[tid] = __expf(fe.x - pv.x + pv.y - fe.y);
      if (bid == 0 && c == 63) p.out[O_MP + bh] = fe.y; }
    __syncthreads();
    if (hasA) { float SA = 0.f;
#pragma unroll
        for (int j = 0; j < 64; ++j) { (SBF + (size_t)j * USZ)[offA] = f2bf(SA); SA = dcs[bhA * 64 + j] * SA + ua[j]; }
        if (idxA < 16384) { const int dv = idxA >> 7, dk = idxA & 127; p.out[O_CP + (size_t)bhA * 16384 + dk * 128 + dv] = SA; } else p.out[O_NP + bhA * 128 + idxA - 16384] = SA; }
    if (tid < 64) {
        if (hasB) { float SB = 0.f;
#pragma unroll 1
            for (int c0 = 0; c0 < 64; c0 += 32) { float ub[32]; const bf16_t* Ub = UST + (size_t)c0 * USZ; const LAS float* db = dcs + bhB * 64 + c0;
#pragma unroll
                for (int j = 0; j < 32; ++j) ub[j] = __uint_as_float((unsigned)(Ub + (size_t)j * USZ)[offB] << 16);
#pragma unroll
                for (int j = 0; j < 32; ++j) { (SBF + (size_t)(c0 + j) * USZ)[offB] = f2bf(SB); SB = db[j] * SB + ub[j]; } }
            if (idxB < 16384) { const int dv = idxB >> 7, dk = idxB & 127; p.out[O_CP + (size_t)bhB * 16384 + dk * 128 + dv] = SB; } else p.out[O_NP + bhB * 128 + idxB - 16384] = SB; } }
}

DI void mlstm_out_item(const Params& p, LAS uchar* lds, int item) {
    const int tid = threadIdx.x, wid = tid >> 6, lane = tid & 63, r = lane & 15, quad = lane >> 4;
    const int c = item & 63, bh = item >> 6, b = bh >> 2, h = bh & 3;
    const bf16_t* proj = (const bf16_t*)(p.ws + WS_PROJ); const float* gates = (const float*)(p.ws + WS_GATES); const float2* FM = (const float2*)(p.ws + WS_FM) + (size_t)bh * SEQ;
    __syncthreads();
    {
        const bf16_t* St = (const bf16_t*)(p.ws + WS_SB) + (size_t)item * USZ;
        u32x4 sv[5];
#pragma unroll
        for (int k = 0; k < 5; ++k) { const int u = tid + 512 * k, dv = u >> 4, d8 = (u & 15) * 8; const int dvc = dv <= 128 ? dv : 128;
            sv[k] = *(const u32x4*)(St + dvc * 128 + d8); }
        const int isk = (tid >> 4) & 1, g8 = (tid & 15) * 8, s0 = (tid >> 5) * 8, t0 = c * CH + s0;
        ConvIn ci; conv_issue(p, proj, b, t0, (isk ? C_MK : C_MQ) + h * 128 + g8, isk * 512 + h * 128 + g8, ci);
        const int vd8 = (tid & 15) * 8, vs0 = (tid >> 4) * 4;
        u32x4 vrow[4];
#pragma unroll
        for (int i = 0; i < 4; ++i) vrow[i] = *(const u32x4*)(proj + (size_t)(b * SEQ + c * CH + vs0 + i) * NPJ + C_MV + h * 128 + vd8);
        if (tid < 128) { const int t = c * CH + tid; ((LAS float*)(lds + ML_AS))[tid] = gates[(size_t)(b * SEQ + t) * 8 + h] - FM[t].x; }
        vt_aug_rows(lds + ML_V, tid);
#pragma unroll
        for (int k = 0; k < 5; ++k) { const int u = tid + 512 * k, dv = u >> 4, d8 = (u & 15) * 8;
            if (u < 144 * 16) { u32x4 w = sv[k]; if (dv > 128) { w.x = 0u; w.y = 0u; w.z = 0u; w.w = 0u; }
                *(LAS u32x4*)(lds + ML_S + dv * TSTR + d8 * 2) = w; } }
        float y[8][8]; conv_compute(ci, t0, y);
#pragma unroll
        for (int i = 0; i < 8; ++i) { float f[8];
#pragma unroll
            for (int e = 0; e < 8; ++e) f[e] = isk ? y[i][e] * 0.08838834764831845f : y[i][e];
            *(LAS u32x4*)(lds + (isk ? ML_K : ML_Q) + (s0 + i) * TSTR + g8 * 2) = pack8(f); }
#pragma unroll
        for (int wd = 0; wd < 4; ++wd) { const unsigned a0 = vrow[0][wd], a1 = vrow[1][wd], a2 = vrow[2][wd], a3 = vrow[3][wd]; u32x2 ev, od;
            ev.x = (a0 & 0xffffu) | (a1 << 16); ev.y = (a2 & 0xffffu) | (a3 << 16); od.x = (a0 >> 16) | (a1 & 0xffff0000u); od.y = (a2 >> 16) | (a3 & 0xffff0000u);
            *(LAS u32x2*)(lds + ML_V + (vd8 + 2 * wd) * TSTR + vs0 * 2) = ev; *(LAS u32x2*)(lds + ML_V + (vd8 + 2 * wd + 1) * TSTR + vs0 * 2) = od; }
    }
    const int ti = 16 * wid + r, t = c * CH + ti; const float2 ft = FM[t]; float2 f0 = make_float2(0.f, 0.f); if (c > 0) f0 = FM[c * CH - 1];
    const bf16_t* rowp = proj + (size_t)(b * SEQ + t) * NPJ; bf16_t* mixed = (bf16_t*)(p.ws + WS_MIXED) + (size_t)(b * SEQ + t) * DM + 512 + h * 128;
    u32x2 gws[8]; float4 nws[8];
#pragma unroll
    for (int mt = 0; mt < 8; ++mt) { const int dv = 16 * mt + 4 * quad; gws[mt] = *(const u32x2*)(rowp + C_G + h * 128 + dv); nws[mt] = *(const float4*)(p.mhw + h * 128 + dv); }
    __syncthreads();
    bf16x8 qf[4];
#pragma unroll
    for (int ks = 0; ks < 4; ++ks) qf[ks] = *(const LAS bf16x8*)(lds + ML_Q + (16 * wid + r) * TSTR + ks * 64 + quad * 16);
    const float winter = __expf(ft.x - f0.x + f0.y - ft.y), bt = ft.x - ft.y;
    f32x4 acc[9];
#pragma unroll
    for (int mt = 0; mt < 9; ++mt) acc[mt] = (f32x4){0.f, 0.f, 0.f, 0.f};
#pragma unroll
    for (int ks = 0; ks < 4; ++ks)
#pragma unroll
        for (int mt = 0; mt < 9; ++mt) { const bf16x8 a = *(const LAS bf16x8*)(lds + ML_S + (16 * mt + r) * TSTR + ks * 64 + quad * 16); acc[mt] = mfma16(a, qf[ks], acc[mt]); }
#pragma unroll
    for (int mt = 0; mt < 9; ++mt) acc[mt] *= winter;
    const LAS float* as = (const LAS float*)(lds + ML_AS);
    for (int sp = 0; sp <= (wid >> 1); ++sp) {
        u32x4 pw;
#pragma unroll
        for (int half = 0; half < 2; ++half) { const int st = 2 * sp + half; f32x4 c4 = {0.f, 0.f, 0.f, 0.f};
            if (st <= wid) {
#pragma unroll
                for (int ks = 0; ks < 4; ++ks) { const bf16x8 a = *(const LAS bf16x8*)(lds + ML_K + (16 * st + r) * TSTR + ks * 64 + quad * 16); c4 = mfma16(a, qf[ks], c4); }
                const f32x4 av = *(const LAS f32x4*)(as + 16 * st + 4 * quad);
#pragma unroll
                for (int v = 0; v < 4; ++v) { const int si = 16 * st + 4 * quad + v; c4[v] = (si <= ti) ? c4[v] * __expf(bt + av[v]) : 0.f; } }
            if (half == 0) { pw.x = pk2(c4[0], c4[1]); pw.y = pk2(c4[2], c4[3]); } else { pw.z = pk2(c4[0], c4[1]); pw.w = pk2(c4[2], c4[3]); } }
        const bf16x8 pb = __builtin_bit_cast(bf16x8, pw);
#pragma unroll
        for (int mt = 0; mt < 9; ++mt) { const LAS uchar* vp = lds + ML_V + (16 * mt + r) * TSTR + (32 * sp + 4 * quad) * 2;
            u32x4 aw; const u32x2 lo = *(const LAS u32x2*)vp, hi = *(const LAS u32x2*)(vp + 32); aw.x = lo.x; aw.y = lo.y; aw.z = hi.x; aw.w = hi.y;
            acc[mt] = mfma16(__builtin_bit_cast(bf16x8, aw), pb, acc[mt]); } }
    const float den = __shfl(acc[8][0], r);
    const float inv = __builtin_amdgcn_rcpf(fmaxf(fabsf(den), __expf(-ft.y)));
    float ss = 0.f;
#pragma unroll
    for (int mt = 0; mt < 8; ++mt)
#pragma unroll
        for (int v = 0; v < 4; ++v) { acc[mt][v] *= inv; ss += acc[mt][v] * acc[mt][v]; }
    ss += __shfl_xor(ss, 16); ss += __shfl_xor(ss, 32);
    const float rstd = rsqrtf(ss * (1.0f / 128) + 1e-6f);
#pragma unroll
    for (int mt = 0; mt < 8; ++mt) { const int dv = 16 * mt + 4 * quad; const u32x2 gw = gws[mt];
        const float4 nw = nws[mt];
        const f32x2 h0 = (f32x2){acc[mt][0], acc[mt][1]}, h1 = (f32x2){acc[mt][2], acc[mt][3]};
        const f32x2 y0 = h0 * rstd * (f32x2){nw.x, nw.y} * (f32x2){bflo(gw.x), bfhi(gw.x)}, y1 = h1 * rstd * (f32x2){nw.z, nw.w} * (f32x2){bflo(gw.y), bfhi(gw.y)};
        u32x2 w; w.x = pk2(y0.x, y0.y); w.y = pk2(y1.x, y1.y);
        *(u32x2*)(mixed + dv) = w; }
}

DI void mlstm_sample_item(const Params& p, LAS uchar* lds, int item) {
    const int tid = threadIdx.x, wid = tid >> 6, lane = tid & 63;
    const int h = item & 3, b = item >> 2;
    const bf16_t* proj = (const bf16_t*)(p.ws + WS_PROJ); const float* gates = (const float*)(p.ws + WS_GATES);
    LAS float* qs = (LAS float*)lds;
    LAS float* ks = qs + 512;
    LAS float* vs = ks + 512;
    LAS float* red = vs + 512;
    LAS float* dred = red + 2048;
    LAS float* sred = dred + 8;
    __syncthreads();
    const int dv = tid & 127, dkq = tid >> 7;
    const float* S0 = p.sC + ((size_t)(b * 4 + h) * 128 + dkq * 32) * 128 + dv;
    float S[32];
#pragma unroll
    for (int i = 0; i < 32; ++i) S[i] = S0[(size_t)i * 128];
    float nn = 0.f; if (tid < 128) nn = p.sn[(size_t)(b * 4 + h) * 128 + tid];
    const bf16_t* rowf = proj + (size_t)(NTP + b * 4 + (tid >> 7)) * NPJ;
    const unsigned ggr = rowf[C_G + h * 128 + dv]; const float mhr = p.mhw[h * 128 + dv];
    float cvs[2];
#pragma unroll
    for (int i = tid; i < 1024; i += 512) { const int t = i >> 8, lc = i & 255, ch = (lc < 128 ? 0 : 512) + h * 128 + (lc & 127);
        float y = p.conv_b[ch]; float xx[4], ww[4];
#pragma unroll
        for (int j = 0; j < 4; ++j) { const int tt = t - 3 + j; ww[j] = p.conv_w[j * 1024 + ch];
            if (tt < 0) xx[j] = p.sconv[(size_t)(b * 3 + 3 + tt) * 1024 + ch];
            else xx[j] = __uint_as_float((unsigned)proj[(size_t)(NTP + b * 4 + tt) * NPJ + C_MQ + ch] << 16); }
#pragma unroll
        for (int j = 0; j < 4; ++j) y += ww[j] * xx[j];
        cvs[i >> 9] = xx[3];
        y = silu(y);
        if (lc < 128) qs[t * 128 + lc] = y; else ks[t * 128 + (lc - 128)] = y * 0.08838834764831845f; }
    { const int t = tid >> 7, dv = tid & 127; vs[tid] = __uint_as_float((unsigned)proj[(size_t)(NTP + b * 4 + t) * NPJ + C_MV + h * 128 + dv] << 16); }
    float mt_[4], fd[4], iw[4];
    { float mprev = p.sm[b * 4 + h];
#pragma unroll
      for (int t = 0; t < 4; ++t) { const float* g = gates + (size_t)(NTP + b * 4 + t) * 8; const float li = g[h], lf = g[4 + h];
          const float m = fmaxf(lf + mprev, li); fd[t] = __expf(lf + mprev - m); iw[t] = __expf(li - m); mt_[t] = m; mprev = m; } }
    __syncthreads();
#pragma unroll
    for (int t = 0; t < 4; ++t) { const float vt = vs[t * 128 + dv] * iw[t]; float part = 0.f;
        f32x2 part2 = {0.f, 0.f};
#pragma unroll
        for (int i = 0; i < 32; i += 4) { const f32x4 k4 = *(const LAS f32x4*)(ks + t * 128 + dkq * 32 + i), q4 = *(const LAS f32x4*)(qs + t * 128 + dkq * 32 + i);
            f32x2 s01 = (f32x2){S[i], S[i + 1]}, s23 = (f32x2){S[i + 2], S[i + 3]};
            s01 = s01 * fd[t] + (f32x2){k4[0], k4[1]} * vt; s23 = s23 * fd[t] + (f32x2){k4[2], k4[3]} * vt;
            part2 += (f32x2){q4[0], q4[1]} * s01; part2 += (f32x2){q4[2], q4[3]} * s23;
            S[i] = s01.x; S[i + 1] = s01.y; S[i + 2] = s23.x; S[i + 3] = s23.y; }
        part = part2.x + part2.y;
        red[(dkq * 4 + t) * 128 + dv] = part;
        if (tid < 128) { nn = fd[t] * nn + iw[t] * ks[t * 128 + tid]; const float dp = wsum(qs[t * 128 + tid] * nn); if (lane == 0) dred[t * 2 + wid] = dp; } }
    float* Sout = p.out + O_CS + ((size_t)(b * 4 + h) * 128 + dkq * 32) * 128 + dv;
#pragma unroll
    for (int i = 0; i < 32; ++i) Sout[(size_t)i * 128] = S[i];
#pragma unroll
    for (int q = 0; q < 2; ++q) { const int i = tid + 512 * q, t = i >> 8, lc = i & 255, ch = (lc < 128 ? 0 : 512) + h * 128 + (lc & 127); if (t >= 1) p.out[O_CONVS + (size_t)(b * 3 + t - 1) * 1024 + ch] = cvs[q]; }
    if (tid < 128) p.out[O_NS + (size_t)(b * 4 + h) * 128 + tid] = nn;
    if (tid == 0) p.out[O_MS + b * 4 + h] = mt_[3];
    __syncthreads();
    { const int t = tid >> 7; const float num = red[(0 * 4 + t) * 128 + dv] + red[(1 * 4 + t) * 128 + dv] + red[(2 * 4 + t) * 128 + dv] + red[(3 * 4 + t) * 128 + dv];
      const float den = dred[t * 2] + dred[t * 2 + 1];
      const float mtv = t == 0 ? mt_[0] : t == 1 ? mt_[1] : t == 2 ? mt_[2] : mt_[3];
      const float hv = num / fmaxf(fabsf(den), __expf(-mtv));
      const float sq = wsum(hv * hv); if (lane == 0) sred[t * 2 + (wid & 1)] = sq;
      __syncthreads();
      const float rstd = rsqrtf((sred[t * 2] + sred[t * 2 + 1]) * (1.0f / 128) + 1e-6f);
      const size_t row = (size_t)(NTP + b * 4 + t);
      ((bf16_t*)(p.ws + WS_MIXED))[row * DM + 512 + h * 128 + dv] = f2bf(hv * rstd * mhr * __uint_as_float(ggr << 16)); }
}

DI void phase2(const Params& p, LAS uchar* lds) {
    const int nb = gridDim.x, bid = blockIdx.x, tid = threadIdx.x;
#ifndef REP_AP
#define REP_AP 1
#define REP_MU 1
#define REP_AS 1
#define REP_MS 1
#endif
    const bool late = ((bid >> 3) & 1) == 0;
    if (!late) { for (int it = bid; it < 256; it += nb) attn_sample_item(p, lds, it);
                 for (int it = bid; it < 512; it += nb) mlstm_sample_item(p, lds, it); }
    for (int it = bid; it < 256; it += nb) attn_prompt_item(p, lds, it);
    for (int it = bid; it < 512; it += nb) mlstm_u_item(p, lds, it);
    if (late) { for (int it = bid; it < 256; it += nb) attn_sample_item(p, lds, it);
                for (int it = bid; it < 512; it += nb) mlstm_sample_item(p, lds, it); }
    for (int i = bid * 512 + tid; i < 6144; i += nb * 512) { const int ch = i & 1023, rr = (i >> 10) % 3, b = i / 3072;
        p.out[O_CONVP + i] = __uint_as_float((unsigned)((const bf16_t*)(p.ws + WS_PROJ))[(size_t)(b * SEQ + SEQ - 3 + rr) * NPJ + C_MQ + ch] << 16); }
}
DI void phase4(const Params& p, LAS uchar* lds) {
    const int nb = gridDim.x, bid = blockIdx.x;
    for (int it = bid; it < 512; it += nb) mlstm_out_item(p, lds, it);
}

__global__ __launch_bounds__(512, 2) void hymba_mega(Params p, int ph_lo, int ph_hi) {
    extern __shared__ __attribute__((aligned(16))) unsigned char shm[];
    LAS uchar* lds = (LAS uchar*)shm;
    volatile LAS unsigned* st = (volatile LAS unsigned*)(lds + LDS_MAIN);
    if (threadIdx.x == 0) { st[0] = 0u; st[1] = 0u; }
    __syncthreads();
    const XcdBarrier xb = xcd_barrier_post((unsigned*)(p.ws + WS_BAR), st);
#ifdef PROBE_K
#define STAMP(i) ts[i] = wall_clock64();
    unsigned long long ts[7];
#else
#define STAMP(i)
#endif
#define RUNPH(n, call) if (ph_lo <= n && n < ph_hi) { if (ph_lo < n) xcd_barrier(xb); STAMP(n) call; }
    RUNPH(0, phase0(p, lds)) RUNPH(1, phase1(p, lds)) RUNPH(2, phase2(p, lds)) RUNPH(3, mlstm_scan(p, lds)) RUNPH(4, phase4(p, lds)) RUNPH(5, phase5(p, lds))
#ifdef PROBE_K
    xcd_barrier(xb); STAMP(6)
    if (blockIdx.x == 0 && threadIdx.x == 0) { const unsigned long long dt = (ts[PROBE_K + 1] - ts[PROBE_K]) * 4ull; while (wall_clock64() - ts[6] < dt) __builtin_amdgcn_s_sleep(8); }
#endif
}

#ifndef N_LAUNCHES
#define N_LAUNCHES 1
#endif
extern "C" void kernel_launch(void* const* d_in, const int* in_sizes, int n_in, void* d_out, int out_size, void* d_ws, size_t ws_size, hipStream_t stream) {
    static int grid = 0;
    if (grid == 0) {
        int dev = 0, cus = 0, per_cu = 0;
        hipGetDevice(&dev); hipDeviceGetAttribute(&cus, hipDeviceAttributeMultiprocessorCount, dev);
        if (hipFuncSetAttribute((const void*)hymba_mega, hipFuncAttributeMaxDynamicSharedMemorySize, LDS_BYTES) != hipSuccess) { fprintf(stderr, "hipFuncSetAttribute failed\n"); }
        if (hipOccupancyMaxActiveBlocksPerMultiprocessor(&per_cu, (const void*)hymba_mega, 512, LDS_BYTES) != hipSuccess || per_cu < 1) { fprintf(stderr, "occupancy query: %d\n", per_cu); per_cu = 1; }
        (void)hipGetLastError();
        grid = cus * per_cu;
        if (ws_size < WS_END || n_in != 18) { fprintf(stderr, "bad ws/n_in\n"); grid = -1; }
    }
    if (grid < 0) return;
    if (hipMemsetAsync((char*)d_ws + WS_BAR, 0, XCD_BAR_WORDS * sizeof(unsigned), stream) != hipSuccess) { fprintf(stderr, "memset failed\n"); return; }
    Params p{};
    p.x_p = (const float*)d_in[0]; p.x_s = (const float*)d_in[1]; p.ck = (const float*)d_in[2]; p.cv = (const float*)d_in[3]; p.sconv = (const float*)d_in[4];
    p.sC = (const float*)d_in[5]; p.sn = (const float*)d_in[6]; p.sm = (const float*)d_in[7]; p.norm_w = (const float*)d_in[8]; p.w_in = (const float*)d_in[9];
    p.b_gates = (const float*)d_in[10]; p.conv_w = (const float*)d_in[11]; p.conv_b = (const float*)d_in[12]; p.qnw = (const float*)d_in[13]; p.knw = (const float*)d_in[14];
    p.sinks = (const float*)d_in[15]; p.mhw = (const float*)d_in[16]; p.w_out = (const float*)d_in[17];
    p.out = (float*)d_out; p.ws = (uchar*)d_ws;
    if (N_LAUNCHES == 1) {
#ifdef PLAIN_LAUNCH
        hipLaunchKernelGGL(hymba_mega, dim3(grid), dim3(512), LDS_BYTES, stream, p, 0, 6);
#else
        int lo = 0, hi = 6; void* args[] = {&p, &lo, &hi};
        hipError_t e = hipLaunchCooperativeKernel((const void*)hymba_mega, dim3(grid), dim3(512), args, LDS_BYTES, stream);
        if (e != hipSuccess) fprintf(stderr, "cooperative launch failed: %s (grid %d)\n", hipGetErrorString(e), grid);
#endif
    } else {
#ifndef PHLIST
#define PHLIST {0, 1, 2, 3, 4, 5}
#endif
        const int phl[] = PHLIST;
        for (int i = 0; i < (int)(sizeof(phl) / sizeof(int)); ++i) hipLaunchKernelGGL(hymba_mega, dim3(grid), dim3(512), LDS_BYTES, stream, p, phl[i], phl[i] + 1);
    }
}
```

```cpp
#define N_LAUNCHES 1
#include <hip/hip_runtime.h>
#include <hip/hip_cooperative_groups.h>
#include <cstdio>
namespace cg = cooperative_groups;
#define LAS __attribute__((address_space(3)))
namespace pg8 {
#define PG8_LAS __attribute__((address_space(3)))
typedef unsigned short bf16_t;
typedef short bf16x8 __attribute__((ext_vector_type(8)));
typedef float f32x4 __attribute__((ext_vector_type(4)));
typedef unsigned u32x4 __attribute__((ext_vector_type(4)));
constexpr int BM = 256, BK = 64, HALF = 128, HTB = HALF * BK * 2  , STAGE_BYTES = 8 * HTB, NXCD = 8, WGM = 8;

__host__ __device__ __forceinline__ int lds_byte(int r, int c) { const int st = (r >> 4) * 2 + (c >> 5), rr = r & 15, cc = c & 31, ob = rr * 64 + cc * 2; return st * 1024 + (ob ^ (((ob >> 9) & 1) << 5)); }
__host__ __device__ __forceinline__ void stage_rc(int b, int& R, int& C) { const int st = b / 1024, sb = b % 1024, swz = sb ^ (((sb >> 9) & 1) << 5); R = (st >> 1) * 16 + swz / 64; C = (st & 1) * 32 + (swz % 64) / 2; }
__host__ __device__ __forceinline__ int perm32(int rho) { const int n = rho >> 4, i = rho & 15; return 8 * (i >> 2) + 4 * n + (i & 3); }

struct Unit { int pm, pn; };
struct Gemm { const bf16_t* A; const bf16_t* Bt; int M, N, K; };

struct StaticOrder {
    int nM, nN, nwg, G, c;
    __host__ __device__ void init(int M, int N, int G_, int c_) { nM = M / BM; nN = N / BM; nwg = nM * nN; G = G_; c = c_; }
    __host__ __device__ bool next(int i, Unit& u) const {
        const long L = (long)i * G + c; if (L >= nwg) return false;
        int wgid = (int)L; { const int q = nwg / NXCD, r = nwg % NXCD, xcd = wgid % NXCD, off = wgid / NXCD; wgid = (xcd < r ? xcd * (q + 1) : r * (q + 1) + (xcd - r) * q) + off; }
        const int nig = WGM * nN, gid = wgid / nig, fm = gid * WGM, gsz = (nM - fm) < WGM ? (nM - fm) : WGM;
        u.pm = fm + ((wgid % nig) % gsz); u.pn = (wgid % nig) / gsz; return true;
    }
    __device__ __forceinline__ void a_ready(const Unit&) const {}
    __device__ __forceinline__ void done(const Unit&) const {}
};
__device__ __forceinline__ unsigned cvt_pk_bf16(float lo, float hi) { unsigned r; asm volatile("v_cvt_pk_bf16_f32 %0, %1, %2" : "=v"(r) : "v"(lo), "v"(hi)); return r; }
template <class Epi, class Sched, bool STAMP = false>
__device__ __forceinline__ void gemm_phase(PG8_LAS unsigned char* lds, const Gemm g, const Sched& S, const Epi& E, unsigned long long* stamps) {
    const int tid = threadIdx.x, wid = __builtin_amdgcn_readfirstlane(tid >> 6), lane = tid & 63, wr = wid >> 2, wc = wid & 3, fr = lane & 15, fq = lane >> 4;
    const int K = g.K, nt = K / BK;
    int ts_lo = 0, ts_hi = 0, nts = 0; const unsigned long long rt_entry = STAMP ? (unsigned long long)wall_clock64() : 0ull;
#define PG8_STAMP() do { if (STAMP && wid == 0 && nts < 64) { const unsigned long long _c = (unsigned long long)clock64(); \
        ts_lo = (lane == nts) ? (int)(unsigned)_c : ts_lo; ts_hi = (lane == nts) ? (int)(unsigned)(_c >> 32) : ts_hi; ++nts; } } while (0)
    PG8_STAMP();
    unsigned voffA[2], voffB[2];
#pragma unroll
    for (int i = 0; i < 2; ++i) { int R, C; stage_rc(tid * 16 + i * 8192, R, C); const int Rb = Epi::PERM ? ((R & ~31) + perm32(R & 31)) : R;
        voffA[i] = (unsigned)(R * K + C) * 2u; voffB[i] = (unsigned)(Rb * K + C) * 2u; }
    const size_t kstep = (size_t)(BK * 2);
    const size_t hstep = (size_t)HALF * K * 2;
    const size_t tstep = 2 * hstep;
    const unsigned ldsw = (unsigned)wid * 1024u;
    const int aoff = lds_byte(wr * 64 + fr, fq * 8), boff = lds_byte(wc * 32 + fr, fq * 8);
#define PG8_SA(b, h) (((b) * 2 + (h)) * HTB)
#define PG8_SB(b, h) ((4 + (b) * 2 + (h)) * HTB)
#define PG8_STAGE(bufoff, gbase, voff) do { _Pragma("unroll") for (int _i = 0; _i < 2; ++_i) \
        __builtin_amdgcn_global_load_lds((const unsigned*)((const char*)(gbase) + (voff)[_i]), (PG8_LAS unsigned*)(lds + (bufoff) + ldsw + _i * 8192), 16, 0, 0); } while (0)
#define PG8_LDA(dst, b, h) do { _Pragma("unroll") for (int m = 0; m < 4; ++m) _Pragma("unroll") for (int k = 0; k < 2; ++k) dst[m][k] = *(const PG8_LAS bf16x8*)(lds + PG8_SA(b, h) + aoff + m * 2048 + k * 1024); } while (0)
#define PG8_LDB(dst, b, h) do { _Pragma("unroll") for (int n = 0; n < 2; ++n) _Pragma("unroll") for (int k = 0; k < 2; ++k) dst[n][k] = *(const PG8_LAS bf16x8*)(lds + PG8_SB(b, h) + boff + n * 2048 + k * 1024); } while (0)
#define PG8_MMA(ai, bj, At, Bt) do { __builtin_amdgcn_s_setprio(1); _Pragma("unroll") for (int m = 0; m < 4; ++m) _Pragma("unroll") for (int n = 0; n < 2; ++n) _Pragma("unroll") for (int k = 0; k < 2; ++k) \
        acc[ai][bj][m][n] = __builtin_amdgcn_mfma_f32_16x16x32_bf16(Bt[n][k], At[m][k], acc[ai][bj][m][n], 0, 0, 0); __builtin_amdgcn_s_setprio(0); } while (0)
#define PG8_WAIT_V(n) asm volatile("s_waitcnt vmcnt(" #n ")" ::: "memory")
#define PG8_WAIT_L(n) asm volatile("s_waitcnt lgkmcnt(" #n ")" ::: "memory")
#define PG8_BAR __builtin_amdgcn_s_barrier()
#define PG8_SCHED __builtin_amdgcn_sched_barrier(0)
    Unit cur, nxt; int ui = 0;
    if (!S.next(0, cur)) return;
    f32x4 acc[2][2][4][2];
#pragma unroll
    for (int a = 0; a < 2; ++a)
#pragma unroll
        for (int b = 0; b < 2; ++b)
#pragma unroll
            for (int m = 0; m < 4; ++m)
#pragma unroll
                for (int n = 0; n < 2; ++n) acc[a][b][m][n] = (f32x4){0.f, 0.f, 0.f, 0.f};
    bf16x8 At[4][2], B0[2][2], B1[2][2];
    const char* cA = (const char*)g.A + (size_t)cur.pm * tstep; const char* cB = (const char*)g.Bt + (size_t)cur.pn * tstep;
    S.a_ready(cur);
    PG8_STAGE(PG8_SB(0, 0), cB, voffB); PG8_STAGE(PG8_SA(0, 0), cA, voffA); PG8_STAGE(PG8_SB(0, 1), cB + hstep, voffB); PG8_STAGE(PG8_SA(0, 1), cA + hstep, voffA);
    if (wr == 1) PG8_BAR;
    PG8_WAIT_V(4); PG8_BAR;
    PG8_STAGE(PG8_SB(1, 0), cB + kstep, voffB); PG8_STAGE(PG8_SA(1, 0), cA + kstep, voffA); PG8_STAGE(PG8_SB(1, 1), cB + hstep + kstep, voffB);
    PG8_WAIT_V(6); PG8_BAR;
    PG8_STAMP();
    for (;;) {
        const bool has_next = S.next(ui + 1, nxt);
        const char* nA = has_next ? (const char*)g.A + (size_t)nxt.pm * tstep : cA; const char* nB = has_next ? (const char*)g.Bt + (size_t)nxt.pn * tstep : cB;
        for (int t = 0; t < nt; t += 2) {
            const bool last = (t == nt - 2);
            const char* a1 = cA + (size_t)(t + 1) * kstep;
            const char* a2 = last ? nA : cA + (size_t)(t + 2) * kstep; const char* b2 = last ? nB : cB + (size_t)(t + 2) * kstep;
            const char* a3 = a2 + kstep; const char* b3 = b2 + kstep;
            if (last && has_next) S.a_ready(nxt);
            PG8_LDB(B0, 0, 0); PG8_SCHED; PG8_LDA(At, 0, 0); PG8_STAGE(PG8_SA(1, 1), a1 + hstep, voffA);
            PG8_WAIT_L(8); PG8_BAR; PG8_WAIT_L(0); PG8_MMA(0, 0, At, B0); PG8_BAR; PG8_SCHED;
            PG8_LDB(B1, 0, 1); PG8_STAGE(PG8_SB(0, 0), b2, voffB);
            PG8_BAR; PG8_WAIT_L(0); PG8_MMA(0, 1, At, B1); PG8_BAR;
            PG8_LDA(At, 0, 1); PG8_STAGE(PG8_SA(0, 0), a2, voffA);
            PG8_BAR; PG8_WAIT_L(0); PG8_MMA(1, 0, At, B0); PG8_BAR; PG8_SCHED;
            PG8_STAGE(PG8_SB(0, 1), b2 + hstep, voffB);
            PG8_WAIT_V(6); PG8_BAR; PG8_MMA(1, 1, At, B1); PG8_BAR;
            PG8_LDB(B0, 1, 0); PG8_SCHED; PG8_LDA(At, 1, 0); PG8_STAGE(PG8_SA(0, 1), a2 + hstep, voffA);
            PG8_WAIT_L(8); PG8_BAR; PG8_WAIT_L(0); PG8_MMA(0, 0, At, B0); PG8_BAR; PG8_SCHED;
            PG8_LDB(B1, 1, 1); PG8_STAGE(PG8_SB(1, 0), b3, voffB);
            PG8_BAR; PG8_WAIT_L(0); PG8_MMA(0, 1, At, B1); PG8_BAR;
            PG8_LDA(At, 1, 1); PG8_STAGE(PG8_SA(1, 0), a3, voffA);
            PG8_BAR; PG8_WAIT_L(0); PG8_MMA(1, 0, At, B0); PG8_BAR; PG8_SCHED;
            PG8_STAGE(PG8_SB(1, 1), b3 + hstep, voffB);
            PG8_WAIT_V(6); PG8_BAR; PG8_MMA(1, 1, At, B1); PG8_BAR;
        }
        PG8_STAMP();
        if constexpr (!Epi::AFTER_DRAIN) { E(acc, cur, wr, wc, fr, fq); S.done(cur); }
        PG8_STAMP();
        if (!has_next) break;
#pragma unroll
        for (int a = 0; a < 2; ++a)
#pragma unroll
            for (int b = 0; b < 2; ++b)
#pragma unroll
                for (int m = 0; m < 4; ++m)
#pragma unroll
                    for (int n = 0; n < 2; ++n) acc[a][b][m][n] = (f32x4){0.f, 0.f, 0.f, 0.f};
        cur = nxt; cA = nA; cB = nB; ++ui;
    }
    PG8_WAIT_V(0);
    if (wr == 0) PG8_BAR;
    PG8_BAR;
    if constexpr (Epi::AFTER_DRAIN) { E.fused(acc, cur, wr, wc, fr, fq, lds, wid, lane); S.done(cur); }
    PG8_STAMP();
    if (STAMP && wid == 0) { stamps[lane] = lane < nts ? (((unsigned long long)(unsigned)ts_hi << 32) | (unsigned)ts_lo) : 0ull;
        if (lane == 62) stamps[62] = rt_entry; if (lane == 63) stamps[63] = (unsigned long long)wall_clock64(); }
#undef PG8_STAMP
#undef PG8_SA
#undef PG8_SB
#undef PG8_STAGE
#undef PG8_LDA
#undef PG8_LDB
#undef PG8_MMA
#undef PG8_WAIT_V
#undef PG8_WAIT_L
#undef PG8_BAR
#undef PG8_SCHED
}
}

#define XB_TMO      128
#define XB_XCNT(j)  (256  + 64 * (j))
#define XB_XSUB(j)  (1280 + 64 * (j))
#define XB_XGEN(j)  (2304 + 64 * (j))
#define XB_TOP      3328
#define XB_TOPGEN   3392
#define XCD_BAR_WORDS 3456
#define XB_SPIN_CAP (1u << 18)

__device__ __forceinline__ unsigned xb_ld(unsigned* p)              { return __hip_atomic_load(p, __ATOMIC_RELAXED, __HIP_MEMORY_SCOPE_AGENT); }
__device__ __forceinline__ unsigned xb_add(unsigned* p, unsigned v) { return __hip_atomic_fetch_add(p, v, __ATOMIC_RELAXED, __HIP_MEMORY_SCOPE_AGENT); }
__device__ __forceinline__ unsigned xb_xcc_id() { return (unsigned)__builtin_amdgcn_s_getreg((3 << 11) | 20) & 0xFu; }
#define XB_SPIN(cond, bar) do { unsigned _sp = 0; while (cond) { __builtin_amdgcn_s_sleep(1); \
    if ((++_sp & 255u) == 0u) { if (xb_ld(&(bar)[XB_TMO])) break; if (_sp > XB_SPIN_CAP) { atomicAdd(&(bar)[XB_TMO], 1u); break; } } } } while (0)

struct XcdBarrier {
    unsigned* bar; unsigned x;
    volatile LAS unsigned* st;
};

__device__ __forceinline__ XcdBarrier xcd_barrier_post(unsigned* bar, volatile LAS unsigned* st) {
    XcdBarrier b; b.bar = bar; b.x = xb_xcc_id(); b.st = st;
    if (threadIdx.x == 0) (void)xb_add(&bar[XB_XCNT(b.x)], 1u);
    return b;
}
__device__ __forceinline__ void xcd_barrier_complete(unsigned* bar, unsigned x, unsigned& nloc, unsigned& nx) {
    const unsigned G = gridDim.x * gridDim.y * gridDim.z;
    unsigned sum, cnt, mine, sp = 0u;
    for (;;) {
        sum = 0u; cnt = 0u; mine = 0u;
#pragma unroll
        for (unsigned j = 0; j < 16; ++j) { const unsigned c = xb_ld(&bar[XB_XCNT(j)]); sum += c; cnt += (c > 0u) ? 1u : 0u; mine = (j == x) ? c : mine; }
        if (sum == G) break;
        __builtin_amdgcn_s_sleep(1);
        if ((++sp & 255u) == 0u) { if (xb_ld(&bar[XB_TMO])) break; if (sp > XB_SPIN_CAP) { atomicAdd(&bar[XB_TMO], 1u); break; } }
    }
    nloc = mine > 0u ? mine : 1u; nx = cnt > 0u ? cnt : 1u;
}

__device__ __forceinline__ void xcd_barrier(const XcdBarrier& b) {
    asm volatile("s_waitcnt vmcnt(0)" ::: "memory");
    __syncthreads();
    if (threadIdx.x == 0) {
        unsigned* bar = b.bar;
        __builtin_amdgcn_s_waitcnt(0);
        unsigned nloc = b.st[0], nx = b.st[1];
        if (nloc == 0u) { xcd_barrier_complete(bar, b.x, nloc, nx); b.st[0] = nloc; b.st[1] = nx; }
        const unsigned old = xb_add(&bar[XB_XSUB(b.x)], 1u);
        const unsigned gen = old / nloc;
        if (old + 1u == (gen + 1u) * nloc) {
            __builtin_amdgcn_fence(__ATOMIC_RELEASE, "agent");
            asm volatile("s_waitcnt vmcnt(0)" ::: "memory");
            const unsigned og = xb_add(&bar[XB_TOP], 1u);
            const unsigned tg = og / nx;
            if (og + 1u == (tg + 1u) * nx) xb_add(&bar[XB_TOPGEN], 1u);
            else XB_SPIN(xb_ld(&bar[XB_TOPGEN]) == tg, bar);
            __builtin_amdgcn_fence(__ATOMIC_ACQUIRE, "agent");
            xb_add(&bar[XB_XGEN(b.x)], 1u);
            asm volatile("s_waitcnt vmcnt(0)" ::: "memory");
        } else {
            XB_SPIN(xb_ld(&bar[XB_XGEN(b.x)]) == gen, bar);
            __builtin_amdgcn_fence(__ATOMIC_ACQUIRE, "agent");
            asm volatile("s_waitcnt vmcnt(0)" ::: "memory");
        }
    }
    __syncthreads();
}

using pg8::bf16_t; using pg8::bf16x8; using pg8::f32x4; using pg8::u32x4;
#define DI __device__ __forceinline__
typedef unsigned char uchar;
typedef unsigned u32x2 __attribute__((ext_vector_type(2)));

constexpr int NTP = 16384, NTS = 512, NTOK = 16896, DM = 1024, DIN = 3848, NGE = 3840, NPJ = 3328, SEQ = 8192;
constexpr int C_AQ = 0, C_AK = 512, C_AV = 640, C_AG = 768, C_MQ = 1280, C_MK = 1792, C_MV = 2304, C_G = 2816;
constexpr int NCH = 64, CH = 128, USZ = 129 * 128;
constexpr size_t O_Y = 0, O_KWP = 17301504, O_VWP = 17334272, O_CONVP = 17367040, O_CP = 17373184, O_NP = 17504256, O_MP = 17505280,
                 O_KWS = 17505288, O_VWS = 19602440, O_CONVS = 21699592, O_CS = 22092808, O_NS = 30481416, O_MS = 30546952;
constexpr size_t WS_WTIN = 0, WS_WTOUT = 7864320, WS_H = 9961472, WS_GATES = 44564480, WS_ROPE = 45105152, WS_FM = 45637632,
                 WS_PROJ = 46161920, WS_UST = 175923200, WS_MIXED = 209739776, WS_BAR = 244342784, WS_SB = 244342784 + 16384, WS_END = WS_SB + 16908288;
constexpr int LDS_MAIN = 151552, LDS_BYTES = LDS_MAIN + 16;

struct Params {
    const float *x_p, *x_s, *ck, *cv, *sconv, *sC, *sn, *sm, *norm_w, *w_in, *b_gates, *conv_w, *conv_b, *qnw, *knw, *sinks, *mhw, *w_out;
    float* out; uchar* ws;
};

DI float bflo(unsigned w) { return __uint_as_float(w << 16); }
DI float bfhi(unsigned w) { return __uint_as_float(w & 0xffff0000u); }
DI unsigned pk2(float a, float b) { return pg8::cvt_pk_bf16(a, b); }
DI bf16_t f2bf(float f) { unsigned u = __float_as_uint(f); u += 0x7fffu + ((u >> 16) & 1u); return (bf16_t)(u >> 16); }
DI void unpack8(const u32x4 w, float (&f)[8]) { f[0] = bflo(w.x); f[1] = bfhi(w.x); f[2] = bflo(w.y); f[3] = bfhi(w.y); f[4] = bflo(w.z); f[5] = bfhi(w.z); f[6] = bflo(w.w); f[7] = bfhi(w.w); }
DI u32x4 pack8(const float (&f)[8]) { u32x4 w; w.x = pk2(f[0], f[1]); w.y = pk2(f[2], f[3]); w.z = pk2(f[4], f[5]); w.w = pk2(f[6], f[7]); return w; }
DI float wsum(float v) { for (int o = 32; o; o >>= 1) v += __shfl_xor(v, o); return v; }
DI float silu(float x) { return x * __builtin_amdgcn_rcpf(1.0f + __builtin_amdgcn_exp2f(-1.4426950408889634f * x)); }
DI float sigm(float x) { return __builtin_amdgcn_rcpf(1.0f + __builtin_amdgcn_exp2f(-1.4426950408889634f * x)); }
DI f32x4 mfma16(bf16x8 a, bf16x8 b, f32x4 c) { return __builtin_amdgcn_mfma_f32_16x16x32_bf16(a, b, c, 0, 0, 0); }

typedef float f32x2g __attribute__((ext_vector_type(2)));
DI void norm_row(const Params& p, const LAS float* wg, int row, const float4 (&xv)[4], const float4 (&nw)[4], float bgl, int lane) {
    bf16_t* H = (bf16_t*)(p.ws + WS_H); float* gates = (float*)(p.ws + WS_GATES);
    float ss = 0.f;
#pragma unroll
    for (int i = 0; i < 4; ++i) ss += xv[i].x * xv[i].x + xv[i].y * xv[i].y + xv[i].z * xv[i].z + xv[i].w * xv[i].w;
    ss = wsum(ss); const float rstd = rsqrtf(ss * (1.0f / DM) + 1e-6f);
    f32x2g g2[8];
#pragma unroll
    for (int j = 0; j < 8; ++j) g2[j] = (f32x2g){0.f, 0.f};
    u32x2 hw[4];
#pragma unroll
    for (int i = 0; i < 4; ++i) { const int d0 = i * 256 + lane * 4;
        const f32x2g ha = (f32x2g){xv[i].x, xv[i].y} * rstd * (f32x2g){nw[i].x, nw[i].y}, hb = (f32x2g){xv[i].z, xv[i].w} * rstd * (f32x2g){nw[i].z, nw[i].w};
        hw[i].x = pk2(ha.x, ha.y); hw[i].y = pk2(hb.x, hb.y);
#pragma unroll
        for (int j = 0; j < 8; ++j) { const f32x4 wv = *(const LAS f32x4*)(wg + j * 1024 + d0); g2[j] += ha * (f32x2g){wv[0], wv[1]}; g2[j] += hb * (f32x2g){wv[2], wv[3]}; } }
#pragma unroll
    for (int i = 0; i < 4; ++i) *(u32x2*)(H + (size_t)row * DM + i * 256 + lane * 4) = hw[i];
    float g[8];
#pragma unroll
    for (int j = 0; j < 8; ++j) g[j] = g2[j].x + g2[j].y;
    const bool b5 = lane & 32, b4 = lane & 16, b3 = lane & 8;
    float r1[4], r2[2], r3;
#pragma unroll
    for (int j = 0; j < 4; ++j) { const float mine = b5 ? g[4 + j] : g[j], other = b5 ? g[j] : g[4 + j]; r1[j] = mine + __shfl_xor(other, 32); }
#pragma unroll
    for (int j = 0; j < 2; ++j) { const float mine = b4 ? r1[2 + j] : r1[j], other = b4 ? r1[j] : r1[2 + j]; r2[j] = mine + __shfl_xor(other, 16); }
    { const float mine = b3 ? r2[1] : r2[0], other = b3 ? r2[0] : r2[1]; r3 = mine + __shfl_xor(other, 8); }
    r3 += __shfl_xor(r3, 4); r3 += __shfl_xor(r3, 2); r3 += __shfl_xor(r3, 1);
    const float z = r3 + bgl; const int gi = lane >> 3;
    const float lf = fminf(z, 0.f) - __logf(1.0f + __expf(-fabsf(z)));
    if ((lane & 7) == 0) gates[(size_t)row * 8 + gi] = gi < 4 ? z : lf;
}
DI void phase0(const Params& p, LAS uchar* lds) {
    const int tid = threadIdx.x, lane = tid & 63, wid = tid >> 6, nb = gridDim.x, bid = blockIdx.x;
    LAS float* tile = (LAS float*)lds;
#ifndef REP_TR
#define REP_TR 1
#define REP_ROW 1
#define REP_ROPE 1
#endif
    for (int rp = 0; rp < REP_TR; ++rp)
    for (int t0 = bid * 2; t0 < 960 + 256; t0 += nb * 2) {
        const float* src[2]; bf16_t* dst[2]; int ld[2], k0[2], n0[2], sc0[2];
#pragma unroll
        for (int q = 0; q < 2; ++q) { const int t = t0 + q;
            if (t < 960) { const int nt = t % 60, kt = t / 60; n0[q] = nt * 64; k0[q] = kt * 64; sc0[q] = n0[q] < 2816 ? n0[q] : (((n0[q] - 2816) & 255) < 128 ? 2816 + ((n0[q] - 2816) >> 8) * 128 + ((n0[q] - 2816) & 255) : 3336 + ((n0[q] - 2816) >> 8) * 128 + ((n0[q] - 2816) & 255) - 128); src[q] = p.w_in; ld[q] = DIN; dst[q] = (bf16_t*)(p.ws + WS_WTIN); }
            else { const int t2 = t - 960, nt = t2 % 16, kt = t2 / 16; n0[q] = nt * 64; k0[q] = kt * 64; sc0[q] = n0[q]; src[q] = p.w_out; ld[q] = DM; dst[q] = (bf16_t*)(p.ws + WS_WTOUT); } }
        float4 v[2][2];
#pragma unroll
        for (int q = 0; q < 2; ++q)
#pragma unroll
            for (int ps = 0; ps < 2; ++ps) { const int kk = (tid >> 4) + 32 * ps, nn4 = (tid & 15) * 4; v[q][ps] = *(const float4*)(src[q] + (size_t)(k0[q] + kk) * ld[q] + sc0[q] + nn4); }
#pragma unroll
        for (int q = 0; q < 2; ++q)
#pragma unroll
            for (int ps = 0; ps < 2; ++ps) { const int kk = (tid >> 4) + 32 * ps, nn4 = (tid & 15) * 4; LAS float* tl = tile + q * 4160 + kk * 65 + nn4; tl[0] = v[q][ps].x; tl[1] = v[q][ps].y; tl[2] = v[q][ps].z; tl[3] = v[q][ps].w; }
        __syncthreads();
#pragma unroll
        for (int q = 0; q < 2; ++q) { const int nn = tid >> 3, kk8 = (tid & 7) * 8; float f[8];
#pragma unroll
          for (int j = 0; j < 8; ++j) f[j] = tile[q * 4160 + (kk8 + j) * 65 + nn];
          *(u32x4*)(dst[q] + (size_t)(n0[q] + nn) * DM + k0[q] + kk8) = pack8(f); }
        __syncthreads();
    }
    { float2* rope = (float2*)(p.ws + WS_ROPE);
      for (int rp = 0; rp < REP_ROPE; ++rp)
      for (int idx = bid * 512 + tid; idx < 8200 * 8; idx += nb * 512) { const int pos = idx >> 3, i = idx & 7;
          const float invf = (float)exp(-(double)i * 0.125 * 13.122363377404328);
          const float ang = (float)pos * invf;
          const double q = rint((double)ang * 0.6366197723675814), r = (double)ang - q * 1.5707963267948966, r2 = r * r;
          const double s = r * (1.0 + r2 * (-1.0 / 6 + r2 * (1.0 / 120 + r2 * (-1.0 / 5040 + r2 * (1.0 / 362880 + r2 * (-1.0 / 39916800 + r2 * (1.0 / 6227020800.0)))))));
          const double c = 1.0 + r2 * (-0.5 + r2 * (1.0 / 24 + r2 * (-1.0 / 720 + r2 * (1.0 / 40320 + r2 * (-1.0 / 3628800 + r2 * (1.0 / 479001600.0))))));
          const int qi = ((int)q) & 3; double cs, sn;
          if (qi == 0) { sn = s; cs = c; } else if (qi == 1) { sn = c; cs = -s; } else if (qi == 2) { sn = -s; cs = -c; } else { sn = -c; cs = s; }
          rope[idx] = make_float2((float)cs, (float)sn); } }
    LAS float* wg = (LAS float*)(lds + 32768);
    for (int d = tid; d < DM; d += 512) { const float4 a = *(const float4*)(p.w_in + (size_t)d * DIN + 3328), b = *(const float4*)(p.w_in + (size_t)d * DIN + 3332);
        wg[d] = a.x; wg[1024 + d] = a.y; wg[2048 + d] = a.z; wg[3072 + d] = a.w; wg[4096 + d] = b.x; wg[5120 + d] = b.y; wg[6144 + d] = b.z; wg[7168 + d] = b.w; }
    __syncthreads();
    float4 nwr[4];
#pragma unroll
    for (int i = 0; i < 4; ++i) nwr[i] = *(const float4*)(p.norm_w + i * 256 + lane * 4);
    const float bgr = p.b_gates[lane >> 3];
    for (int rp = 0; rp < REP_ROW; ++rp)
    for (int row = bid * 8 + wid; row < NTOK; row += nb * 16) {
        const int row2 = row + nb * 8; const bool has2 = row2 < NTOK; const int r2 = has2 ? row2 : row;
        const float* xa = row < NTP ? p.x_p + (size_t)row * DM : p.x_s + (size_t)(row - NTP) * DM;
        const float* xb = r2 < NTP ? p.x_p + (size_t)r2 * DM : p.x_s + (size_t)(r2 - NTP) * DM;
        float4 va[4], vb[4];
#pragma unroll
        for (int i = 0; i < 4; ++i) va[i] = *(const float4*)(xa + i * 256 + lane * 4);
#pragma unroll
        for (int i = 0; i < 4; ++i) vb[i] = *(const float4*)(xb + i * 256 + lane * 4);
        norm_row(p, wg, row, va, nwr, bgr, lane);
        if (has2) norm_row(p, wg, row2, vb, nwr, bgr, lane);
    }
}

DI float block_excl_sum(float v, LAS float* red, int tid) {
    const int lane = tid & 63, wid = tid >> 6; float inc = v;
#pragma unroll
    for (int o = 1; o < 64; o <<= 1) { const float t = __shfl_up(inc, o); if (lane >= o) inc += t; }
    __syncthreads(); if (lane == 63) red[wid] = inc; __syncthreads();
    float base = 0.f;
#pragma unroll
    for (int w = 0; w < 8; ++w) base += (w < wid) ? red[w] : 0.f;
    return base + inc - v;
}
DI float block_excl_max(float v, LAS float* red, int tid) {
    const int lane = tid & 63, wid = tid >> 6; float inc = v;
#pragma unroll
    for (int o = 1; o < 64; o <<= 1) { const float t = __shfl_up(inc, o); if (lane >= o) inc = fmaxf(inc, t); }
    __syncthreads(); if (lane == 63) red[wid] = inc; __syncthreads();
    float base = -INFINITY;
#pragma unroll
    for (int w = 0; w < 8; ++w) base = fmaxf(base, (w < wid) ? red[w] : -INFINITY);
    float ex = __shfl_up(inc, 1); if (lane == 0) ex = -INFINITY;
    return fmaxf(base, ex);
}
DI void gate_scan(const Params& p, LAS uchar* lds, int bh) {
    const int tid = threadIdx.x, b = bh >> 2, h = bh & 3, t0 = tid * 16;
    const float* gates = (const float*)(p.ws + WS_GATES); float2* FM = (float2*)(p.ws + WS_FM) + (size_t)bh * SEQ;
    LAS float* red = (LAS float*)lds;
    float li[16], F[16];
    float run = 0.f;
#pragma unroll
    for (int j = 0; j < 16; ++j) { const float* g = gates + (size_t)(b * SEQ + t0 + j) * 8; li[j] = g[h]; run += g[4 + h]; F[j] = run; }
    const float base = block_excl_sum(run, red, tid);
    float mx = -INFINITY, ml[16];
#pragma unroll
    for (int j = 0; j < 16; ++j) { F[j] += base; mx = fmaxf(mx, li[j] - F[j]); ml[j] = mx; }
    const float mb = fmaxf(block_excl_max(mx, red, tid), 0.0f);
#pragma unroll
    for (int j = 0; j < 16; ++j) FM[t0 + j] = make_float2(F[j], F[j] + fmaxf(ml[j], mb));
    __syncthreads();
}

struct EpiProj {
    static constexpr bool PERM = true, AFTER_DRAIN = false;
    bf16_t* O;
    __device__ __forceinline__ void operator()(const f32x4 (&acc)[2][2][4][2], const pg8::Unit& u, int wr, int wc, int fr, int fq) const {
        const int row0 = u.pm * 256 + wr * 64 + fr;
        if (u.pn < 11) { const int col0 = u.pn * 256 + wc * 32 + 8 * fq; const bool gate = (u.pn == 3) || (u.pn == 4);
#pragma unroll
            for (int ai = 0; ai < 2; ++ai)
#pragma unroll
                for (int m = 0; m < 4; ++m) { bf16_t* rowp = O + (size_t)(row0 + ai * 128 + m * 16) * NPJ + col0;
#pragma unroll
                    for (int bj = 0; bj < 2; ++bj) { f32x4 v0 = acc[ai][bj][m][0], v1 = acc[ai][bj][m][1];
                        if (gate) {
#pragma unroll
                            for (int e = 0; e < 4; ++e) { v0[e] = silu(v0[e]); v1[e] = silu(v1[e]); } }
                        u32x4 w; w.x = pk2(v0[0], v0[1]); w.y = pk2(v0[2], v0[3]); w.z = pk2(v1[0], v1[1]); w.w = pk2(v1[2], v1[3]);
                        *(u32x4*)(rowp + bj * 128) = w; } }
        } else { const int col0 = C_G + (u.pn - 11) * 128 + wc * 32 + 8 * fq;
#pragma unroll
            for (int ai = 0; ai < 2; ++ai)
#pragma unroll
                for (int m = 0; m < 4; ++m) { float g[8];
#pragma unroll
                    for (int n = 0; n < 2; ++n)
#pragma unroll
                        for (int e = 0; e < 4; ++e) { const float o = acc[ai][0][m][n][e], z = acc[ai][1][m][n][e];
                            g[4 * n + e] = z * __builtin_amdgcn_rcpf((1.0f + __builtin_amdgcn_exp2f(-1.4426950408889634f * o)) * (1.0f + __builtin_amdgcn_exp2f(-1.4426950408889634f * z))); }
                    *(u32x4*)(O + (size_t)(row0 + ai * 128 + m * 16) * NPJ + col0) = pack8(g); }
        }
    }
};
struct EpiOut {
    static constexpr bool PERM = false, AFTER_DRAIN = false;
    float* Y; const float* xp;
    __device__ __forceinline__ void operator()(const f32x4 (&acc)[2][2][4][2], const pg8::Unit& u, int wr, int wc, int fr, int fq) const {
        const int row0 = u.pm * 256 + wr * 64 + fr, col0 = u.pn * 256 + wc * 32 + 4 * fq;
#pragma unroll
        for (int ai = 0; ai < 2; ++ai)
#pragma unroll
            for (int mp = 0; mp < 2; ++mp) { f32x4 xv[2][2][2];
#pragma unroll
                for (int mm = 0; mm < 2; ++mm) { const float* xr = xp + (size_t)(row0 + ai * 128 + (mp * 2 + mm) * 16) * DM + col0;
#pragma unroll
                    for (int bj = 0; bj < 2; ++bj)
#pragma unroll
                        for (int n = 0; n < 2; ++n) xv[mm][bj][n] = *(const f32x4*)(xr + bj * 128 + n * 16); }
#pragma unroll
                for (int mm = 0; mm < 2; ++mm) { float* yr = Y + (size_t)(row0 + ai * 128 + (mp * 2 + mm) * 16) * DM + col0;
#pragma unroll
                    for (int bj = 0; bj < 2; ++bj)
#pragma unroll
                        for (int n = 0; n < 2; ++n) *(f32x4*)(yr + bj * 128 + n * 16) = acc[ai][bj][mp * 2 + mm][n] + xv[mm][bj][n]; } }
    }
};
DI void phase1(const Params& p, LAS uchar* lds) {
    const int nb = gridDim.x, bid = blockIdx.x;
    if (bid >= nb - 8) gate_scan(p, lds, bid - (nb - 8));
    pg8::Gemm g; g.A = (const bf16_t*)(p.ws + WS_H); g.Bt = (const bf16_t*)(p.ws + WS_WTIN); g.M = NTOK; g.N = NGE; g.K = DM;
    pg8::StaticOrder S; S.init(g.M, g.N, nb, bid);
    EpiProj E; E.O = (bf16_t*)(p.ws + WS_PROJ);
    pg8::gemm_phase<EpiProj, pg8::StaticOrder, false>(lds, g, S, E, nullptr);
}
DI void phase5(const Params& p, LAS uchar* lds) {
    const int nb = gridDim.x, bid = blockIdx.x;
    pg8::Gemm g; g.A = (const bf16_t*)(p.ws + WS_MIXED); g.Bt = (const bf16_t*)(p.ws + WS_WTOUT); g.M = NTP; g.N = DM; g.K = DM;
    pg8::StaticOrder S; S.init(g.M, g.N, nb, bid);
    EpiOut E; E.Y = p.out + O_Y; E.xp = p.x_p;
    pg8::gemm_phase<EpiOut, pg8::StaticOrder, false>(lds, g, S, E, nullptr);
}

constexpr int KSTR = 144, VSTR = 560, AT_K = 0, AT_V = 272 * KSTR, AT_R = AT_V + 64 * VSTR;
typedef float f32x2r __attribute__((ext_vector_type(2)));

DI void qk_norm_rope16(float (&x)[16], int pt, const float* nw, const float2* rope_row) {
    float ss = 0.f;
#pragma unroll
    for (int j = 0; j < 16; ++j) ss += x[j] * x[j];
    ss += __shfl_xor(ss, 1); ss += __shfl_xor(ss, 2);
    const float rstd = rsqrtf(ss * (1.0f / 64) + 1e-6f);
#pragma unroll
    for (int j = 0; j < 16; ++j) x[j] = x[j] * rstd * nw[pt * 16 + j];
    if (pt == 0) {
#pragma unroll
        for (int i = 0; i < 8; ++i) { const float2 cs = rope_row[i]; const float a = x[i], b = x[i + 8]; x[i] = a * cs.x - b * cs.y; x[i + 8] = b * cs.x + a * cs.y; } }
}
DI void qk_norm_rope16p(float (&x)[16], int pt, const float* nw, const float2 (&rp)[8]) {
    float ss = 0.f;
#pragma unroll
    for (int j = 0; j < 16; ++j) ss += x[j] * x[j];
    ss += __shfl_xor(ss, 1); ss += __shfl_xor(ss, 2);
    const float rstd = rsqrtf(ss * (1.0f / 64) + 1e-6f);
#pragma unroll
    for (int j = 0; j < 16; ++j) x[j] = x[j] * rstd * nw[pt * 16 + j];
    if (pt == 0) {
#pragma unroll
        for (int i = 0; i < 8; ++i) { const float2 cs = rp[i]; const float a = x[i], b = x[i + 8]; x[i] = a * cs.x - b * cs.y; x[i + 8] = b * cs.x + a * cs.y; } }
}
DI void kv_to_lds(LAS uchar* lds, int ki, int pt, const float (&xk)[16], const float (&xv)[16]) {
    float a[8], b[8];
#pragma unroll
    for (int j = 0; j < 8; ++j) { a[j] = xk[j]; b[j] = xk[8 + j]; }
    *(LAS u32x4*)(lds + AT_K + ki * KSTR + pt * 32) = pack8(a); *(LAS u32x4*)(lds + AT_K + ki * KSTR + pt * 32 + 16) = pack8(b);
#pragma unroll
    for (int j = 0; j < 16; j += 2) { const unsigned w = pk2(xv[j], xv[j + 1]);
        *(LAS bf16_t*)(lds + AT_V + (pt * 16 + j) * VSTR + ki * 2) = (bf16_t)(w & 0xffffu); *(LAS bf16_t*)(lds + AT_V + (pt * 16 + j + 1) * VSTR + ki * 2) = (bf16_t)(w >> 16); }
}
DI void load16bf(const bf16_t* src, float (&x)[16]) { const u32x4 w0 = *(const u32x4*)src, w1 = *(const u32x4*)(src + 8); float a[8], b[8]; unpack8(w0, a); unpack8(w1, b);
#pragma unroll
    for (int j = 0; j < 8; ++j) { x[j] = a[j]; x[8 + j] = b[j]; } }
DI void load16f(const float* src, float (&x)[16]) {
#pragma unroll
    for (int j = 0; j < 4; ++j) { const float4 v = *(const float4*)(src + 4 * j); x[4 * j] = v.x; x[4 * j + 1] = v.y; x[4 * j + 2] = v.z; x[4 * j + 3] = v.w; } }
DI void store16f(float* dst, const float (&x)[16]) {
#pragma unroll
    for (int j = 0; j < 4; ++j) *(float4*)(dst + 4 * j) = make_float4(x[4 * j], x[4 * j + 1], x[4 * j + 2], x[4 * j + 3]); }

struct QRaw { u32x4 q0, q1; u32x2 gw[4]; };
DI void attn_q_load(const Params& p, int row, int hqa, QRaw& qr) {
    const int lane = threadIdx.x & 63, quad = lane >> 4;
    const bf16_t* rowp = (const bf16_t*)(p.ws + WS_PROJ) + (size_t)row * NPJ;
    qr.q0 = *(const u32x4*)(rowp + C_AQ + hqa * 64 + 8 * quad); qr.q1 = *(const u32x4*)(rowp + C_AQ + hqa * 64 + 32 + 8 * quad);
#pragma unroll
    for (int mt = 0; mt < 4; ++mt) qr.gw[mt] = *(const u32x2*)(rowp + C_AG + hqa * 64 + 16 * mt + 4 * quad);
}
template <bool LROPE> DI void attn_q_tile(const Params& p, LAS uchar* lds, const QRaw& qr, const float (&qw0)[8], const float (&qw1)[8], int row, int pos, int hqa, int qi, int kt0, int kmin) {
    const int lane = threadIdx.x & 63, r = lane & 15, quad = lane >> 4;
    const float2* rope = (const float2*)(p.ws + WS_ROPE);
    float x0[8], x1[8];
    unpack8(qr.q0, x0); unpack8(qr.q1, x1);
    float ss = 0.f;
#pragma unroll
    for (int j = 0; j < 8; ++j) ss += x0[j] * x0[j] + x1[j] * x1[j];
    ss += __shfl_xor(ss, 16); ss += __shfl_xor(ss, 32);
    const float rstd = rsqrtf(ss * (1.0f / 64) + 1e-6f) ;
#pragma unroll
    for (int j = 0; j < 8; ++j) { x0[j] = x0[j] * rstd * qw0[j]; x1[j] = x1[j] * rstd * qw1[j]; }
#pragma unroll
    for (int j = 0; j < 8; ++j) { const float pj = __shfl_xor(x0[j], 16); float2 cs; if (LROPE) { const f32x2r c2 = *(const LAS f32x2r*)(lds + AT_R + qi * 64 + j * 8); cs = make_float2(c2.x, c2.y); } else cs = rope[(size_t)pos * 8 + j];
        const float rot = x0[j] * cs.x + (quad == 0 ? -pj : pj) * cs.y; x0[j] = (quad < 2) ? rot : x0[j]; }
#pragma unroll
    for (int j = 0; j < 8; ++j) { x0[j] *= 0.18033688011112042f; x1[j] *= 0.18033688011112042f; }
    const bf16x8 qf0 = __builtin_bit_cast(bf16x8, pack8(x0)), qf1 = __builtin_bit_cast(bf16x8, pack8(x1));
    const float sink = p.sinks[hqa] * 1.4426950408889634f;
    f32x4 s[9];
#pragma unroll
    for (int kt = 0; kt < 9; ++kt) { const int krow = (kt0 + kt) * 16 + r;
        const bf16x8 a0 = *(const LAS bf16x8*)(lds + AT_K + krow * KSTR + quad * 16), a1 = *(const LAS bf16x8*)(lds + AT_K + krow * KSTR + 64 + quad * 16);
        f32x4 acc = {0.f, 0.f, 0.f, 0.f}; acc = mfma16(a0, qf0, acc); acc = mfma16(a1, qf1, acc); s[kt] = acc; }
    float mx = sink;
#pragma unroll
    for (int kt = 0; kt < 9; ++kt) {
        if ((kt0 + kt) * 16 + 15 < kmin) { s[kt] = (f32x4){-INFINITY, -INFINITY, -INFINITY, -INFINITY}; }
        else {
            if (kt == 0) {
#pragma unroll
                for (int v = 0; v < 4; ++v) { const int ki = kt0 * 16 + quad * 4 + v; s[kt][v] = (ki > qi) ? s[kt][v] : -INFINITY; } }
            if (kt == 8) {
#pragma unroll
                for (int v = 0; v < 4; ++v) { const int ki = (kt0 + 8) * 16 + quad * 4 + v; s[kt][v] = (ki <= qi + 128) ? s[kt][v] : -INFINITY; } }
            mx = fmaxf(fmaxf(mx, fmaxf(s[kt][0], s[kt][1])), fmaxf(s[kt][2], s[kt][3])); } }
    mx = fmaxf(mx, __shfl_xor(mx, 16)); mx = fmaxf(mx, __shfl_xor(mx, 32));
    float sum = 0.f;
#pragma unroll
    for (int kt = 0; kt < 9; ++kt)
#pragma unroll
        for (int v = 0; v < 4; ++v) { const float e = __builtin_amdgcn_exp2f(s[kt][v] - mx); s[kt][v] = e; sum += e; }
    sum += __shfl_xor(sum, 16); sum += __shfl_xor(sum, 32);
    sum += __builtin_amdgcn_exp2f(sink - mx);
    const float inv = __builtin_amdgcn_rcpf(sum);
    f32x4 o[4];
#pragma unroll
    for (int mt = 0; mt < 4; ++mt) o[mt] = (f32x4){0.f, 0.f, 0.f, 0.f};
#pragma unroll
    for (int ks = 0; ks < 5; ++ks) {
        u32x4 pw; pw.x = pk2(s[2 * ks][0], s[2 * ks][1]); pw.y = pk2(s[2 * ks][2], s[2 * ks][3]);
        if (ks < 4) { pw.z = pk2(s[2 * ks + 1][0], s[2 * ks + 1][1]); pw.w = pk2(s[2 * ks + 1][2], s[2 * ks + 1][3]); } else { pw.z = 0u; pw.w = 0u; }
        const bf16x8 pb = __builtin_bit_cast(bf16x8, pw);
#pragma unroll
        for (int mt = 0; mt < 4; ++mt) { const int d = 16 * mt + r; const LAS uchar* vp = lds + AT_V + d * VSTR + ((kt0 + 2 * ks) * 16 + 4 * quad) * 2;
            u32x4 aw; const u32x2 lo = *(const LAS u32x2*)vp, hi = *(const LAS u32x2*)(vp + 32); aw.x = lo.x; aw.y = lo.y; aw.z = hi.x; aw.w = hi.y;
            o[mt] = mfma16(__builtin_bit_cast(bf16x8, aw), pb, o[mt]); } }
    bf16_t* mixed = (bf16_t*)(p.ws + WS_MIXED) + (size_t)row * DM;
#pragma unroll
    for (int mt = 0; mt < 4; ++mt) { const int col = hqa * 64 + 16 * mt + 4 * quad; const u32x2 gw = qr.gw[mt];
        u32x2 w; w.x = pk2(o[mt][0] * inv * bflo(gw.x), o[mt][1] * inv * bfhi(gw.x)); w.y = pk2(o[mt][2] * inv * bflo(gw.y), o[mt][3] * inv * bfhi(gw.y));
        *(u32x2*)(mixed + col) = w; }
}

DI void attn_prompt_item(const Params& p, LAS uchar* lds, int item) {
    const int tid = threadIdx.x, wid = tid >> 6, lane = tid & 63, r = lane & 15;
    const int g = item & 1, blk = (item >> 1) & 63, b = item >> 7;
    const bf16_t* proj = (const bf16_t*)(p.ws + WS_PROJ); const float2* rope = (const float2*)(p.ws + WS_ROPE);
    const int hqa = g * 4 + (wid >> 1), qh = wid & 1;
    __syncthreads();
    float qw0[8], qw1[8];
    { const int quad = lane >> 4;
#pragma unroll
      for (int j = 0; j < 8; ++j) { qw0[j] = p.qnw[8 * quad + j]; qw1[j] = p.qnw[32 + 8 * quad + j]; } }
    u32x4 kr[2][2], vr[2][2]; float2 rp[2][8];
#pragma unroll
    for (int it = 0; it < 2; ++it) { const int u = tid + 512 * it, ki = u >> 2, pt = u & 3, tk = (blk - 1) * 128 + ki; const int tkc = tk < 0 ? 0 : tk;
        const bf16_t* rowp = proj + (size_t)(b * SEQ + tkc) * NPJ;
        kr[it][0] = *(const u32x4*)(rowp + C_AK + g * 64 + pt * 16); kr[it][1] = *(const u32x4*)(rowp + C_AK + g * 64 + pt * 16 + 8);
        vr[it][0] = *(const u32x4*)(rowp + C_AV + g * 64 + pt * 16); vr[it][1] = *(const u32x4*)(rowp + C_AV + g * 64 + pt * 16 + 8);
#pragma unroll
        for (int i = 0; i < 8; ++i) rp[it][i] = rope[(size_t)tkc * 8 + i]; }
    if (tid < 128) { u32x4 z; z.x = 0u; z.y = 0u; z.z = 0u; z.w = 0u; *(LAS u32x4*)(lds + AT_V + (tid >> 1) * VSTR + 512 + (tid & 1) * 16) = z; }
    QRaw qr[4];
#pragma unroll
    for (int i = 0; i < 4; ++i) attn_q_load(p, b * SEQ + blk * 128 + (qh * 4 + i) * 16 + r, hqa, qr[i]);
    { const float2 ra = rope[(size_t)blk * 1024 + tid], rb = rope[(size_t)blk * 1024 + 512 + tid];
      *(LAS f32x2r*)(lds + AT_R + tid * 8) = (f32x2r){ra.x, ra.y}; *(LAS f32x2r*)(lds + AT_R + (512 + tid) * 8) = (f32x2r){rb.x, rb.y}; }
#pragma unroll
    for (int it = 0; it < 2; ++it) { const int u = tid + 512 * it, ki = u >> 2, pt = u & 3;
        {
            float xk[16], xv[16]; float a[8], c[8];
            unpack8(kr[it][0], a); unpack8(kr[it][1], c);
#pragma unroll
            for (int j = 0; j < 8; ++j) { xk[j] = a[j]; xk[8 + j] = c[j]; }
            unpack8(vr[it][0], a); unpack8(vr[it][1], c);
#pragma unroll
            for (int j = 0; j < 8; ++j) { xv[j] = a[j]; xv[8 + j] = c[j]; }
            qk_norm_rope16p(xk, pt, p.knw, rp[it]);
            kv_to_lds(lds, ki, pt, xk, xv);
            if (blk == 63 && ki >= 128) { const size_t o = ((size_t)(b * 128 + ki - 128) * 2 + g) * 64 + pt * 16; store16f(p.out + O_KWP + o, xk); store16f(p.out + O_VWP + o, xv); } } }
    __syncthreads();
#pragma unroll 2
    for (int i = 0; i < 4; ++i) { const int qt = qh * 4 + i, qi = qt * 16 + r, tq = blk * 128 + qi;
        attn_q_tile<true>(p, lds, qr[0], qw0, qw1, b * SEQ + tq, tq, hqa, qi, qt, blk == 0 ? 128 : 0);
        qr[0] = qr[1]; qr[1] = qr[2]; qr[2] = qr[3]; }
}
DI void attn_sample_item(const Params& p, LAS uchar* lds, int item) {
    const int tid = threadIdx.x, wid = tid >> 6, lane = tid & 63, r = lane & 15;
    const int g = item & 1, b = item >> 1;
    const bf16_t* proj = (const bf16_t*)(p.ws + WS_PROJ); const float2* rope = (const float2*)(p.ws + WS_ROPE);
    __syncthreads();
    QRaw qrs; if (wid == 0) attn_q_load(p, NTP + b * 4 + (r >> 2), g * 4 + (r & 3), qrs);
    float qw0[8], qw1[8];
    { const int quad = lane >> 4;
#pragma unroll
      for (int j = 0; j < 8; ++j) { qw0[j] = p.qnw[8 * quad + j]; qw1[j] = p.qnw[32 + 8 * quad + j]; } }
    for (int u = tid; u < 640; u += 512) { const int ki = u >> 2, pt = u & 3;
        float xk[16], xv[16];
#pragma unroll
        for (int j = 0; j < 16; ++j) { xk[j] = 0.f; xv[j] = 0.f; }
        if (ki < 128) { const size_t o = ((size_t)(b * 128 + ki) * 2 + g) * 64 + pt * 16; load16f(p.ck + o, xk); load16f(p.cv + o, xv); }
        else { if (ki < 132) { const bf16_t* rowp = proj + (size_t)(NTP + b * 4 + ki - 128) * NPJ; load16bf(rowp + C_AK + g * 64 + pt * 16, xk); load16bf(rowp + C_AV + g * 64 + pt * 16, xv); }
               qk_norm_rope16(xk, pt, p.knw, rope + (size_t)(SEQ + (ki < 132 ? ki - 128 : 0)) * 8); }
        kv_to_lds(lds, ki, pt, xk, xv);
        if (ki >= 4 && ki < 132) { const size_t o = ((size_t)(b * 128 + ki - 4) * 2 + g) * 64 + pt * 16; store16f(p.out + O_KWS + o, xk); store16f(p.out + O_VWS + o, xv); }
    }
    __syncthreads();
    if (wid == 0) { const int t = r >> 2, hqa = g * 4 + (r & 3); attn_q_tile<false>(p, lds, qrs, qw0, qw1, NTP + b * 4 + t, SEQ + t, hqa, t, 0, 0); }
}

constexpr int TSTR = 272;
constexpr int ML_Q = 0, ML_K = 128 * TSTR, ML_V = ML_K + 128 * TSTR, ML_S = ML_V + 144 * TSTR, ML_AS = ML_S + 144 * TSTR, ML_END = ML_AS + 512;
static_assert(ML_END <= LDS_MAIN, "lds");

struct ConvIn { u32x4 row[11]; float4 w[4][2]; float4 bias[2]; };
DI void conv_issue(const Params& p, const bf16_t* proj, int b, int t0, int col, int ch, ConvIn& ci) {
#pragma unroll
    for (int i = 0; i < 11; ++i) { const int tt = t0 - 3 + i; ci.row[i] = *(const u32x4*)(proj + (size_t)(b * SEQ + (tt < 0 ? 0 : tt)) * NPJ + col); }
#pragma unroll
    for (int j = 0; j < 4; ++j) { ci.w[j][0] = *(const float4*)(p.conv_w + j * 1024 + ch); ci.w[j][1] = *(const float4*)(p.conv_w + j * 1024 + ch + 4); }
    ci.bias[0] = *(const float4*)(p.conv_b + ch); ci.bias[1] = *(const float4*)(p.conv_b + ch + 4);
}
typedef float f32x2 __attribute__((ext_vector_type(2)));
DI void conv_compute(const ConvIn& ci, int t0, float (&y)[8][8]) {
    f32x2 w[4][4], yy[8][4];
#pragma unroll
    for (int j = 0; j < 4; ++j) { w[j][0] = (f32x2){ci.w[j][0].x, ci.w[j][0].y}; w[j][1] = (f32x2){ci.w[j][0].z, ci.w[j][0].w}; w[j][2] = (f32x2){ci.w[j][1].x, ci.w[j][1].y}; w[j][3] = (f32x2){ci.w[j][1].z, ci.w[j][1].w}; }
    const f32x2 bs[4] = {(f32x2){ci.bias[0].x, ci.bias[0].y}, (f32x2){ci.bias[0].z, ci.bias[0].w}, (f32x2){ci.bias[1].x, ci.bias[1].y}, (f32x2){ci.bias[1].z, ci.bias[1].w}};
#pragma unroll
    for (int i = 0; i < 8; ++i)
#pragma unroll
        for (int q = 0; q < 4; ++q) yy[i][q] = bs[q];
#pragma unroll
    for (int r = 0; r < 11; ++r) { f32x2 x[4];
        const bool zero = (r < 3) && (t0 - 3 + r < 0);
#pragma unroll
        for (int q = 0; q < 4; ++q) { const unsigned wd = zero ? 0u : ci.row[r][q]; x[q] = (f32x2){bflo(wd), bfhi(wd)}; }
#pragma unroll
        for (int j = 0; j < 4; ++j) { const int i = r - j;
            if (i >= 0 && i < 8) {
#pragma unroll
                for (int q = 0; q < 4; ++q) yy[i][q] += w[j][q] * x[q]; } } }
#pragma unroll
    for (int i = 0; i < 8; ++i)
#pragma unroll
        for (int q = 0; q < 4; ++q) { const f32x2 v = yy[i][q], a = v * -1.4426950408889634f; f32x2 e; e.x = __builtin_amdgcn_exp2f(a.x); e.y = __builtin_amdgcn_exp2f(a.y);
            const f32x2 d = e + 1.0f; f32x2 rc; rc.x = __builtin_amdgcn_rcpf(d.x); rc.y = __builtin_amdgcn_rcpf(d.y); const f32x2 o = v * rc; y[i][2 * q] = o.x; y[i][2 * q + 1] = o.y; }
}
DI void vt_store8(LAS uchar* img, int d0, int s0, const u32x4 (&row)[8]) {
#pragma unroll
    for (int wd = 0; wd < 4; ++wd) { u32x4 ev, od;
        unsigned a[8];
#pragma unroll
        for (int i = 0; i < 8; ++i) a[i] = row[i][wd];
        ev.x = (a[0] & 0xffffu) | (a[1] << 16); ev.y = (a[2] & 0xffffu) | (a[3] << 16); ev.z = (a[4] & 0xffffu) | (a[5] << 16); ev.w = (a[6] & 0xffffu) | (a[7] << 16);
        od.x = (a[0] >> 16) | (a[1] & 0xffff0000u); od.y = (a[2] >> 16) | (a[3] & 0xffff0000u); od.z = (a[4] >> 16) | (a[5] & 0xffff0000u); od.w = (a[6] >> 16) | (a[7] & 0xffff0000u);
        *(LAS u32x4*)(img + (d0 + 2 * wd) * TSTR + s0 * 2) = ev; *(LAS u32x4*)(img + (d0 + 2 * wd + 1) * TSTR + s0 * 2) = od; }
}
DI void vt_aug_rows(LAS uchar* img, int tid) {
    if (tid < 256) { const int rr = tid >> 4, s8 = (tid & 15) * 8; const unsigned v = rr == 0 ? 0x3F803F80u : 0u; u32x4 w; w.x = v; w.y = v; w.z = v; w.w = v;
        *(LAS u32x4*)(img + (128 + rr) * TSTR + s8 * 2) = w; }
}

DI void mlstm_u_item(const Params& p, LAS uchar* lds, int item) {
    const int tid = threadIdx.x, wid = tid >> 6, lane = tid & 63, r = lane & 15, quad = lane >> 4;
    const int c = item & 63, bh = item >> 6, b = bh >> 2, h = bh & 3;
    const bf16_t* proj = (const bf16_t*)(p.ws + WS_PROJ); const float* gates = (const float*)(p.ws + WS_GATES); const float2* FM = (const float2*)(p.ws + WS_FM) + (size_t)bh * SEQ;
    LAS float* wks = (LAS float*)(lds + ML_AS);
    __syncthreads();
    if (tid < 256) {
        const int g8 = (tid & 15) * 8, s0 = (tid >> 4) * 8, t0 = c * CH + s0;
        ConvIn ci; conv_issue(p, proj, b, t0, C_MK + h * 128 + g8, 512 + h * 128 + g8, ci);
        if (tid < 128) { const int t = c * CH + tid; const float2 fe = FM[c * CH + CH - 1], fs = FM[t];
            wks[tid] = __expf(fe.x - fs.x + gates[(size_t)(b * SEQ + t) * 8 + h] - fe.y) * 0.08838834764831845f; }
        vt_aug_rows(lds + ML_V, tid);
        __syncthreads();
        float y[8][8]; conv_compute(ci, t0, y);
        const f32x4 wa = *(const LAS f32x4*)(wks + s0), wb = *(const LAS f32x4*)(wks + s0 + 4);
        const float wk[8] = {wa[0], wa[1], wa[2], wa[3], wb[0], wb[1], wb[2], wb[3]};
#pragma unroll
        for (int e = 0; e < 8; ++e) { float f[8];
#pragma unroll
            for (int i = 0; i < 8; ++i) f[i] = y[i][e] * wk[i];
            *(LAS u32x4*)(lds + ML_K + (g8 + e) * TSTR + s0 * 2) = pack8(f); }
    } else {
        const int vt = tid - 256, d8 = (vt & 15) * 8, s0 = (vt >> 4) * 8, t0 = c * CH + s0;
        u32x4 row[8];
#pragma unroll
        for (int i = 0; i < 8; ++i) row[i] = *(const u32x4*)(proj + (size_t)(b * SEQ + t0 + i) * NPJ + C_MV + h * 128 + d8);
        __syncthreads();
        vt_store8(lds + ML_V, d8, s0, row);
    }
    __syncthreads();
    f32x4 acc[9];
#pragma unroll
    for (int mt = 0; mt < 9; ++mt) acc[mt] = (f32x4){0.f, 0.f, 0.f, 0.f};
#pragma unroll
    for (int ks = 0; ks < 4; ++ks) { const bf16x8 bk = *(const LAS bf16x8*)(lds + ML_K + (16 * wid + r) * TSTR + ks * 64 + quad * 16);
#pragma unroll
        for (int mt = 0; mt < 9; ++mt) { const bf16x8 av = *(const LAS bf16x8*)(lds + ML_V + (16 * mt + r) * TSTR + ks * 64 + quad * 16); acc[mt] = mfma16(av, bk, acc[mt]); } }
    bf16_t* U = (bf16_t*)(p.ws + WS_UST) + (size_t)item * USZ;
#pragma unroll
    for (int mt = 0; mt < 9; ++mt)
#pragma unroll
        for (int v = 0; v < 4; ++v) { const int dv = 16 * mt + 4 * quad + v; if (dv <= 128) U[dv * 128 + 16 * wid + r] = f2bf(acc[mt][v]); }
}

DI void sample_outproj(const Params& p, int unit) {
    const int lane = threadIdx.x & 63, wid = threadIdx.x >> 6, r = lane & 15, quad = lane >> 4;
    const int m0 = (unit >> 4) * 32 + (wid >> 2) * 16, n0 = (unit & 15) * 64 + (wid & 3) * 16;
    const bf16_t* A = (const bf16_t*)(p.ws + WS_WTOUT) + (size_t)(n0 + r) * DM + 8 * quad;
    const bf16_t* B = (const bf16_t*)(p.ws + WS_MIXED) + (size_t)(NTP + m0 + r) * DM + 8 * quad;
    f32x4 acc0 = {0.f, 0.f, 0.f, 0.f}, acc1 = {0.f, 0.f, 0.f, 0.f};
    const f32x4 xres = *(const f32x4*)(p.x_s + (size_t)(m0 + r) * DM + n0 + 4 * quad);
#pragma unroll
    for (int hb = 0; hb < 4; ++hb) { bf16x8 af[8], bfr[8];
#pragma unroll
        for (int ks = 0; ks < 8; ++ks) { af[ks] = *(const bf16x8*)(A + (hb * 8 + ks) * 32); bfr[ks] = *(const bf16x8*)(B + (hb * 8 + ks) * 32); }
#pragma unroll
        for (int ks = 0; ks < 8; ks += 2) { acc0 = mfma16(af[ks], bfr[ks], acc0); acc1 = mfma16(af[ks + 1], bfr[ks + 1], acc1); } }
    const size_t o = (size_t)(m0 + r) * DM + n0 + 4 * quad;
    *(f32x4*)(p.out + O_Y + (size_t)NTP * DM + o) = acc0 + acc1 + xres;
}
DI void mlstm_scan(const Params& p, LAS uchar* lds) {
    const int tid = threadIdx.x, nb = gridDim.x, bid = blockIdx.x;
    const bf16_t* UST = (const bf16_t*)(p.ws + WS_UST); bf16_t* SBF = (bf16_t*)(p.ws + WS_SB);
    LAS float* dcs = (LAS float*)lds;
    for (int it = nb - 1 - bid; it < 256; it += nb) sample_outproj(p, it);
    const int per = (8 * USZ + nb - 1) / nb, base = bid * per;
    const int lim = (base + per < 8 * USZ) ? base + per : 8 * USZ;
    const int eA = base + tid, eB = base + 512 + tid; const bool hasA = eA < lim, hasB = (tid < 64) && (eB < lim);
    const int ea = hasA ? eA : 0, eb2 = hasB ? eB : 0;
    const int bhA = ea / USZ, idxA = ea - bhA * USZ, bhB = eb2 / USZ, idxB = eb2 - bhB * USZ;
    const unsigned offA = (unsigned)(bhA * NCH * USZ + idxA), offB = (unsigned)(bhB * NCH * USZ + idxB);
    float ua[64];
#pragma unroll
    for (int j = 0; j < 64; ++j) ua[j] = __uint_as_float((unsigned)(UST + (size_t)j * USZ)[offA] << 16);
    __syncthreads();
    { const int bh = tid >> 6, c = tid & 63; const float2* FM = (const float2*)(p.ws + WS_FM) + (size_t)bh * SEQ;
      const float2 fe = FM[c * CH + CH - 1]; float2 pv = make_float2(0.f, 0.f); if (c > 0) pv = FM[c * CH - 1];
      dcs[tid] = __expf(fe.x - pv.x + pv.y - fe.y);
      if (bid == 0 && c == 63) p.out[O_MP + bh] = fe.y; }
    __syncthreads();
    if (hasA) { float SA = 0.f;
#pragma unroll
        for (int j = 0; j < 64; ++j) { (SBF + (size_t)j * USZ)[offA] = f2bf(SA); SA = dcs[bhA * 64 + j] * SA + ua[j]; }
        if (idxA < 16384) { const int dv = idxA >> 7, dk = idxA & 127; p.out[O_CP + (size_t)bhA * 16384 + dk * 128 + dv] = SA; } else p.out[O_NP + bhA * 128 + idxA - 16384] = SA; }
    if (tid < 64) {
        if (hasB) { float SB = 0.f;
#pragma unroll 1
            for (int c0 = 0; c0 < 64; c0 += 32) { float ub[32]; const bf16_t* Ub = UST + (size_t)c0 * USZ; const LAS float* db = dcs + bhB * 64 + c0;
#pragma unroll
                for (int j = 0; j < 32; ++j) ub[j] = __uint_as_float((unsigned)(Ub + (size_t)j * USZ)[offB] << 16);
#pragma unroll
                for (int j = 0; j < 32; ++j) { (SBF + (size_t)(c0 + j) * USZ)[offB] = f2bf(SB); SB = db[j] * SB + ub[j]; } }
            if (idxB < 16384) { const int dv = idxB >> 7, dk = idxB & 127; p.out[O_CP + (size_t)bhB * 16384 + dk * 128 + dv] = SB; } else p.out[O_NP + bhB * 128 + idxB - 16384] = SB; } }
}

DI void mlstm_out_item(const Params& p, LAS uchar* lds, int item) {
    const int tid = threadIdx.x, wid = tid >> 6, lane = tid & 63, r = lane & 15, quad = lane >> 4;
    const int c = item & 63, bh = item >> 6, b = bh >> 2, h = bh & 3;
    const bf16_t* proj = (const bf16_t*)(p.ws + WS_PROJ); const float* gates = (const float*)(p.ws + WS_GATES); const float2* FM = (const float2*)(p.ws + WS_FM) + (size_t)bh * SEQ;
    __syncthreads();
    {
        const bf16_t* St = (const bf16_t*)(p.ws + WS_SB) + (size_t)item * USZ;
        u32x4 sv[5];
#pragma unroll
        for (int k = 0; k < 5; ++k) { const int u = tid + 512 * k, dv = u >> 4, d8 = (u & 15) * 8; const int dvc = dv <= 128 ? dv : 128;
            sv[k] = *(const u32x4*)(St + dvc * 128 + d8); }
        const int isk = (tid >> 4) & 1, g8 = (tid & 15) * 8, s0 = (tid >> 5) * 8, t0 = c * CH + s0;
        ConvIn ci; conv_issue(p, proj, b, t0, (isk ? C_MK : C_MQ) + h * 128 + g8, isk * 512 + h * 128 + g8, ci);
        const int vd8 = (tid & 15) * 8, vs0 = (tid >> 4) * 4;
        u32x4 vrow[4];
#pragma unroll
        for (int i = 0; i < 4; ++i) vrow[i] = *(const u32x4*)(proj + (size_t)(b * SEQ + c * CH + vs0 + i) * NPJ + C_MV + h * 128 + vd8);
        if (tid < 128) { const int t = c * CH + tid; ((LAS float*)(lds + ML_AS))[tid] = gates[(size_t)(b * SEQ + t) * 8 + h] - FM[t].x; }
        vt_aug_rows(lds + ML_V, tid);
#pragma unroll
        for (int k = 0; k < 5; ++k) { const int u = tid + 512 * k, dv = u >> 4, d8 = (u & 15) * 8;
            if (u < 144 * 16) { u32x4 w = sv[k]; if (dv > 128) { w.x = 0u; w.y = 0u; w.z = 0u; w.w = 0u; }
                *(LAS u32x4*)(lds + ML_S + dv * TSTR + d8 * 2) = w; } }
        float y[8][8]; conv_compute(ci, t0, y);
#pragma unroll
        for (int i = 0; i < 8; ++i) { float f[8];
#pragma unroll
            for (int e = 0; e < 8; ++e) f[e] = isk ? y[i][e] * 0.08838834764831845f : y[i][e];
            *(LAS u32x4*)(lds + (isk ? ML_K : ML_Q) + (s0 + i) * TSTR + g8 * 2) = pack8(f); }
#pragma unroll
        for (int wd = 0; wd < 4; ++wd) { const unsigned a0 = vrow[0][wd], a1 = vrow[1][wd], a2 = vrow[2][wd], a3 = vrow[3][wd]; u32x2 ev, od;
            ev.x = (a0 & 0xffffu) | (a1 << 16); ev.y = (a2 & 0xffffu) | (a3 << 16); od.x = (a0 >> 16) | (a1 & 0xffff0000u); od.y = (a2 >> 16) | (a3 & 0xffff0000u);
            *(LAS u32x2*)(lds + ML_V + (vd8 + 2 * wd) * TSTR + vs0 * 2) = ev; *(LAS u32x2*)(lds + ML_V + (vd8 + 2 * wd + 1) * TSTR + vs0 * 2) = od; }
    }
    const int ti = 16 * wid + r, t = c * CH + ti; const float2 ft = FM[t]; float2 f0 = make_float2(0.f, 0.f); if (c > 0) f0 = FM[c * CH - 1];
    const bf16_t* rowp = proj + (size_t)(b * SEQ + t) * NPJ; bf16_t* mixed = (bf16_t*)(p.ws + WS_MIXED) + (size_t)(b * SEQ + t) * DM + 512 + h * 128;
    u32x2 gws[8]; float4 nws[8];
#pragma unroll
    for (int mt = 0; mt < 8; ++mt) { const int dv = 16 * mt + 4 * quad; gws[mt] = *(const u32x2*)(rowp + C_G + h * 128 + dv); nws[mt] = *(const float4*)(p.mhw + h * 128 + dv); }
    __syncthreads();
    bf16x8 qf[4];
#pragma unroll
    for (int ks = 0; ks < 4; ++ks) qf[ks] = *(const LAS bf16x8*)(lds + ML_Q + (16 * wid + r) * TSTR + ks * 64 + quad * 16);
    const float winter = __expf(ft.x - f0.x + f0.y - ft.y), bt = ft.x - ft.y;
    f32x4 acc[9];
#pragma unroll
    for (int mt = 0; mt < 9; ++mt) acc[mt] = (f32x4){0.f, 0.f, 0.f, 0.f};
#pragma unroll
    for (int ks = 0; ks < 4; ++ks)
#pragma unroll
        for (int mt = 0; mt < 9; ++mt) { const bf16x8 a = *(const LAS bf16x8*)(lds + ML_S + (16 * mt + r) * TSTR + ks * 64 + quad * 16); acc[mt] = mfma16(a, qf[ks], acc[mt]); }
#pragma unroll
    for (int mt = 0; mt < 9; ++mt) acc[mt] *= winter;
    const LAS float* as = (const LAS float*)(lds + ML_AS);
    for (int sp = 0; sp <= (wid >> 1); ++sp) {
        u32x4 pw;
#pragma unroll
        for (int half = 0; half < 2; ++half) { const int st = 2 * sp + half; f32x4 c4 = {0.f, 0.f, 0.f, 0.f};
            if (st <= wid) {
#pragma unroll
                for (int ks = 0; ks < 4; ++ks) { const bf16x8 a = *(const LAS bf16x8*)(lds + ML_K + (16 * st + r) * TSTR + ks * 64 + quad * 16); c4 = mfma16(a, qf[ks], c4); }
                const f32x4 av = *(const LAS f32x4*)(as + 16 * st + 4 * quad);
#pragma unroll
                for (int v = 0; v < 4; ++v) { const int si = 16 * st + 4 * quad + v; c4[v] = (si <= ti) ? c4[v] * __expf(bt + av[v]) : 0.f; } }
            if (half == 0) { pw.x = pk2(c4[0], c4[1]); pw.y = pk2(c4[2], c4[3]); } else { pw.z = pk2(c4[0], c4[1]); pw.w = pk2(c4[2], c4[3]); } }
        const bf16x8 pb = __builtin_bit_cast(bf16x8, pw);
#pragma unroll
        for (int mt = 0; mt < 9; ++mt) { const LAS uchar* vp = lds + ML_V + (16 * mt + r) * TSTR + (32 * sp + 4 * quad) * 2;
            u32x4 aw; const u32x2 lo = *(const LAS u32x2*)vp, hi = *(const LAS u32x2*)(vp + 32); aw.x = lo.x; aw.y = lo.y; aw.z = hi.x; aw.w = hi.y;
            acc[mt] = mfma16(__builtin_bit_cast(bf16x8, aw), pb, acc[mt]); } }
    const float den = __shfl(acc[8][0], r);
    const float inv = __builtin_amdgcn_rcpf(fmaxf(fabsf(den), __expf(-ft.y)));
    float ss = 0.f;
#pragma unroll
    for (int mt = 0; mt < 8; ++mt)
#pragma unroll
        for (int v = 0; v < 4; ++v) { acc[mt][v] *= inv; ss += acc[mt][v] * acc[mt][v]; }
    ss += __shfl_xor(ss, 16); ss += __shfl_xor(ss, 32);
    const float rstd = rsqrtf(ss * (1.0f / 128) + 1e-6f);
#pragma unroll
    for (int mt = 0; mt < 8; ++mt) { const int dv = 16 * mt + 4 * quad; const u32x2 gw = gws[mt];
        const float4 nw = nws[mt];
        const f32x2 h0 = (f32x2){acc[mt][0], acc[mt][1]}, h1 = (f32x2){acc[mt][2], acc[mt][3]};
        const f32x2 y0 = h0 * rstd * (f32x2){nw.x, nw.y} * (f32x2){bflo(gw.x), bfhi(gw.x)}, y1 = h1 * rstd * (f32x2){nw.z, nw.w} * (f32x2){bflo(gw.y), bfhi(gw.y)};
        u32x2 w; w.x = pk2(y0.x, y0.y); w.y = pk2(y1.x, y1.y);
        *(u32x2*)(mixed + dv) = w; }
}

DI void mlstm_sample_item(const Params& p, LAS uchar* lds, int item) {
    const int tid = threadIdx.x, wid = tid >> 6, lane = tid & 63;
    const int h = item & 3, b = item >> 2;
    const bf16_t* proj = (const bf16_t*)(p.ws + WS_PROJ); const float* gates = (const float*)(p.ws + WS_GATES);
    LAS float* qs = (LAS float*)lds;
    LAS float* ks = qs + 512;
    LAS float* vs = ks + 512;
    LAS float* red = vs + 512;
    LAS float* dred = red + 2048;
    LAS float* sred = dred + 8;
    __syncthreads();
    const int dv = tid & 127, dkq = tid >> 7;
    const float* S0 = p.sC + ((size_t)(b * 4 + h) * 128 + dkq * 32) * 128 + dv;
    float S[32];
#pragma unroll
    for (int i = 0; i < 32; ++i) S[i] = S0[(size_t)i * 128];
    float nn = 0.f; if (tid < 128) nn = p.sn[(size_t)(b * 4 + h) * 128 + tid];
    const bf16_t* rowf = proj + (size_t)(NTP + b * 4 + (tid >> 7)) * NPJ;
    const unsigned ggr = rowf[C_G + h * 128 + dv]; const float mhr = p.mhw[h * 128 + dv];
    float cvs[2];
#pragma unroll
    for (int i = tid; i < 1024; i += 512) { const int t = i >> 8, lc = i & 255, ch = (lc < 128 ? 0 : 512) + h * 128 + (lc & 127);
        float y = p.conv_b[ch]; float xx[4], ww[4];
#pragma unroll
        for (int j = 0; j < 4; ++j) { const int tt = t - 3 + j; ww[j] = p.conv_w[j * 1024 + ch];
            if (tt < 0) xx[j] = p.sconv[(size_t)(b * 3 + 3 + tt) * 1024 + ch];
            else xx[j] = __uint_as_float((unsigned)proj[(size_t)(NTP + b * 4 + tt) * NPJ + C_MQ + ch] << 16); }
#pragma unroll
        for (int j = 0; j < 4; ++j) y += ww[j] * xx[j];
        cvs[i >> 9] = xx[3];
        y = silu(y);
        if (lc < 128) qs[t * 128 + lc] = y; else ks[t * 128 + (lc - 128)] = y * 0.08838834764831845f; }
    { const int t = tid >> 7, dv = tid & 127; vs[tid] = __uint_as_float((unsigned)proj[(size_t)(NTP + b * 4 + t) * NPJ + C_MV + h * 128 + dv] << 16); }
    float mt_[4], fd[4], iw[4];
    { float mprev = p.sm[b * 4 + h];
#pragma unroll
      for (int t = 0; t < 4; ++t) { const float* g = gates + (size_t)(NTP + b * 4 + t) * 8; const float li = g[h], lf = g[4 + h];
          const float m = fmaxf(lf + mprev, li); fd[t] = __expf(lf + mprev - m); iw[t] = __expf(li - m); mt_[t] = m; mprev = m; } }
    __syncthreads();
#pragma unroll
    for (int t = 0; t < 4; ++t) { const float vt = vs[t * 128 + dv] * iw[t]; float part = 0.f;
        f32x2 part2 = {0.f, 0.f};
#pragma unroll
        for (int i = 0; i < 32; i += 4) { const f32x4 k4 = *(const LAS f32x4*)(ks + t * 128 + dkq * 32 + i), q4 = *(const LAS f32x4*)(qs + t * 128 + dkq * 32 + i);
            f32x2 s01 = (f32x2){S[i], S[i + 1]}, s23 = (f32x2){S[i + 2], S[i + 3]};
            s01 = s01 * fd[t] + (f32x2){k4[0], k4[1]} * vt; s23 = s23 * fd[t] + (f32x2){k4[2], k4[3]} * vt;
            part2 += (f32x2){q4[0], q4[1]} * s01; part2 += (f32x2){q4[2], q4[3]} * s23;
            S[i] = s01.x; S[i + 1] = s01.y; S[i + 2] = s23.x; S[i + 3] = s23.y; }
        part = part2.x + part2.y;
        red[(dkq * 4 + t) * 128 + dv] = part;
        if (tid < 128) { nn = fd[t] * nn + iw[t] * ks[t * 128 + tid]; const float dp = wsum(qs[t * 128 + tid] * nn); if (lane == 0) dred[t * 2 + wid] = dp; } }
    float* Sout = p.out + O_CS + ((size_t)(b * 4 + h) * 128 + dkq * 32) * 128 + dv;
#pragma unroll
    for (int i = 0; i < 32; ++i) Sout[(size_t)i * 128] = S[i];
#pragma unroll
    for (int q = 0; q < 2; ++q) { const int i = tid + 512 * q, t = i >> 8, lc = i & 255, ch = (lc < 128 ? 0 : 512) + h * 128 + (lc & 127); if (t >= 1) p.out[O_CONVS + (size_t)(b * 3 + t - 1) * 1024 + ch] = cvs[q]; }
    if (tid < 128) p.out[O_NS + (size_t)(b * 4 + h) * 128 + tid] = nn;
    if (tid == 0) p.out[O_MS + b * 4 + h] = mt_[3];
    __syncthreads();
    { const int t = tid >> 7; const float num = red[(0 * 4 + t) * 128 + dv] + red[(1 * 4 + t) * 128 + dv] + red[(2 * 4 + t) * 128 + dv] + red[(3 * 4 + t) * 128 + dv];
      const float den = dred[t * 2] + dred[t * 2 + 1];
      const float mtv = t == 0 ? mt_[0] : t == 1 ? mt_[1] : t == 2 ? mt_[2] : mt_[3];
      const float hv = num / fmaxf(fabsf(den), __expf(-mtv));
      const float sq = wsum(hv * hv); if (lane == 0) sred[t * 2 + (wid & 1)] = sq;
      __syncthreads();
      const float rstd = rsqrtf((sred[t * 2] + sred[t * 2 + 1]) * (1.0f / 128) + 1e-6f);
      const size_t row = (size_t)(NTP + b * 4 + t);
      ((bf16_t*)(p.ws + WS_MIXED))[row * DM + 512 + h * 128 + dv] = f2bf(hv * rstd * mhr * __uint_as_float(ggr << 16)); }
}

DI void phase2(const Params& p, LAS uchar* lds) {
    const int nb = gridDim.x, bid = blockIdx.x, tid = threadIdx.x;
#ifndef REP_AP
#define REP_AP 1
#define REP_MU 1
#define REP_AS 1
#define REP_MS 1
#endif
    const bool late = ((bid >> 3) & 1) == 0;
    if (!late) { for (int it = bid; it < 256; it += nb) attn_sample_item(p, lds, it);
                 for (int it = bid; it < 512; it += nb) mlstm_sample_item(p, lds, it); }
    for (int it = bid; it < 256; it += nb) attn_prompt_item(p, lds, it);
    for (int it = bid; it < 512; it += nb) mlstm_u_item(p, lds, it);
    if (late) { for (int it = bid; it < 256; it += nb) attn_sample_item(p, lds, it);
                for (int it = bid; it < 512; it += nb) mlstm_sample_item(p, lds, it); }
    for (int i = bid * 512 + tid; i < 6144; i += nb * 512) { const int ch = i & 1023, rr = (i >> 10) % 3, b = i / 3072;
        p.out[O_CONVP + i] = __uint_as_float((unsigned)((const bf16_t*)(p.ws + WS_PROJ))[(size_t)(b * SEQ + SEQ - 3 + rr) * NPJ + C_MQ + ch] << 16); }
}
DI void phase4(const Params& p, LAS uchar* lds) {
    const int nb = gridDim.x, bid = blockIdx.x;
    for (int it = bid; it < 512; it += nb) mlstm_out_item(p, lds, it);
}

__global__ __launch_bounds__(512, 2) void hymba_mega(Params p, int ph_lo, int ph_hi) {
    extern __shared__ __attribute__((aligned(16))) unsigned char shm[];
    LAS uchar* lds = (LAS uchar*)shm;
    volatile LAS unsigned* st = (volatile LAS unsigned*)(lds + LDS_MAIN);
    if (threadIdx.x == 0) { st[0] = 0u; st[1] = 0u; }
    __syncthreads();
    const XcdBarrier xb = xcd_barrier_post((unsigned*)(p.ws + WS_BAR), st);
#ifdef PROBE_K
#define STAMP(i) ts[i] = wall_clock64();
    unsigned long long ts[7];
#else
#define STAMP(i)
#endif
#define RUNPH(n, call) if (ph_lo <= n && n < ph_hi) { if (ph_lo < n) xcd_barrier(xb); STAMP(n) call; }
    RUNPH(0, phase0(p, lds)) RUNPH(1, phase1(p, lds)) RUNPH(2, phase2(p, lds)) RUNPH(3, mlstm_scan(p, lds)) RUNPH(4, phase4(p, lds)) RUNPH(5, phase5(p, lds))
#ifdef PROBE_K
    xcd_barrier(xb); STAMP(6)
    if (blockIdx.x == 0 && threadIdx.x == 0) { const unsigned long long dt = (ts[PROBE_K + 1] - ts[PROBE_K]) * 4ull; while (wall_clock64() - ts[6] < dt) __builtin_amdgcn_s_sleep(8); }
#endif
}

#ifndef N_LAUNCHES
#define N_LAUNCHES 1
#endif
extern "C" void kernel_launch(void* const* d_in, const int* in_sizes, int n_in, void* d_out, int out_size, void* d_ws, size_t ws_size, hipStream_t stream) {
    static int grid = 0;
    if (grid == 0) {
        int dev = 0, cus = 0, per_cu = 0;
        hipGetDevice(&dev); hipDeviceGetAttribute(&cus, hipDeviceAttributeMultiprocessorCount, dev);
        if (hipFuncSetAttribute((const void*)hymba_mega, hipFuncAttributeMaxDynamicSharedMemorySize, LDS_BYTES) != hipSuccess) { fprintf(stderr, "hipFuncSetAttribute failed\n"); }
        if (hipOccupancyMaxActiveBlocksPerMultiprocessor(&per_cu, (const void*)hymba_mega, 512, LDS_BYTES) != hipSuccess || per_cu < 1) { fprintf(stderr, "occupancy query: %d\n", per_cu); per_cu = 1; }
        (void)hipGetLastError();
        grid = cus * per_cu;
        if (ws_size < WS_END || n_in != 18) { fprintf(stderr, "bad ws/n_in\n"); grid = -1; }
    }
    if (grid < 0) return;
    if (hipMemsetAsync((char*)d_ws + WS_BAR, 0, XCD_BAR_WORDS * sizeof(unsigned), stream) != hipSuccess) { fprintf(stderr, "memset failed\n"); return; }
    Params p{};
    p.x_p = (const float*)d_in[0]; p.x_s = (const float*)d_in[1]; p.ck = (const float*)d_in[2]; p.cv = (const float*)d_in[3]; p.sconv = (const float*)d_in[4];
    p.sC = (const float*)d_in[5]; p.sn = (const float*)d_in[6]; p.sm = (const float*)d_in[7]; p.norm_w = (const float*)d_in[8]; p.w_in = (const float*)d_in[9];
    p.b_gates = (const float*)d_in[10]; p.conv_w = (const float*)d_in[11]; p.conv_b = (const float*)d_in[12]; p.qnw = (const float*)d_in[13]; p.knw = (const float*)d_in[14];
    p.sinks = (const float*)d_in[15]; p.mhw = (const float*)d_in[16]; p.w_out = (const float*)d_in[17];
    p.out = (float*)d_out; p.ws = (uchar*)d_ws;
    if (N_LAUNCHES == 1) {
#ifdef PLAIN_LAUNCH
        hipLaunchKernelGGL(hymba_mega, dim3(grid), dim3(512), LDS_BYTES, stream, p, 0, 6);
#else
        int lo = 0, hi = 6; void* args[] = {&p, &lo, &hi};
        hipError_t e = hipLaunchCooperativeKernel((const void*)hymba_mega, dim3(grid), dim3(512), args, LDS_BYTES, stream);
        if (e != hipSuccess) fprintf(stderr, "cooperative launch failed: %s (grid %d)\n", hipGetErrorString(e), grid);
#endif
    } else {
#ifndef PHLIST
#define PHLIST {0, 1, 2, 3, 4, 5}
#endif
        const int phl[] = PHLIST;
        for (int i = 0; i < (int)(sizeof(phl) / sizeof(int)); ++i) hipLaunchKernelGGL(hymba_mega, dim3(grid), dim3(512), LDS_BYTES, stream, p, phl[i], phl[i] + 1);
    }
}
```

```cpp
#define N_LAUNCHES 1
#include <hip/hip_runtime.h>
#include <hip/hip_cooperative_groups.h>
#include <cstdio>
namespace cg = cooperative_groups;
#define LAS __attribute__((address_space(3)))
namespace pg8 {
#define PG8_LAS __attribute__((address_space(3)))
typedef unsigned short bf16_t;
typedef short bf16x8 __attribute__((ext_vector_type(8)));
typedef float f32x4 __attribute__((ext_vector_type(4)));
typedef unsigned u32x4 __attribute__((ext_vector_type(4)));
constexpr int BM = 256, BK = 64, HALF = 128, HTB = HALF * BK * 2  , STAGE_BYTES = 8 * HTB, NXCD = 8, WGM = 8;

__host__ __device__ __forceinline__ int lds_byte(int r, int c) { const int st = (r >> 4) * 2 + (c >> 5), rr = r & 15, cc = c & 31, ob = rr * 64 + cc * 2; return st * 1024 + (ob ^ (((ob >> 9) & 1) << 5)); }
__host__ __device__ __forceinline__ void stage_rc(int b, int& R, int& C) { const int st = b / 1024, sb = b % 1024, swz = sb ^ (((sb >> 9) & 1) << 5); R = (st >> 1) * 16 + swz / 64; C = (st & 1) * 32 + (swz % 64) / 2; }
__host__ __device__ __forceinline__ int perm32(int rho) { const int n = rho >> 4, i = rho & 15; return 8 * (i >> 2) + 4 * n + (i & 3); }

struct Unit { int pm, pn; };
struct Gemm { const bf16_t* A; const bf16_t* Bt; int M, N, K; };

struct StaticOrder {
    int nM, nN, nwg, G, c;
    __host__ __device__ void init(int M, int N, int G_, int c_) { nM = M / BM; nN = N / BM; nwg = nM * nN; G = G_; c = c_; }
    __host__ __device__ bool next(int i, Unit& u) const {
        const long L = (long)i * G + c; if (L >= nwg) return false;
        int wgid = (int)L; { const int q = nwg / NXCD, r = nwg % NXCD, xcd = wgid % NXCD, off = wgid / NXCD; wgid = (xcd < r ? xcd * (q + 1) : r * (q + 1) + (xcd - r) * q) + off; }
        const int nig = WGM * nN, gid = wgid / nig, fm = gid * WGM, gsz = (nM - fm) < WGM ? (nM - fm) : WGM;
        u.pm = fm + ((wgid % nig) % gsz); u.pn = (wgid % nig) / gsz; return true;
    }
    __device__ __forceinline__ void a_ready(const Unit&) const {}
    __device__ __forceinline__ void done(const Unit&) const {}
};
__device__ __forceinline__ unsigned cvt_pk_bf16(float lo, float hi) { unsigned r; asm volatile("v_cvt_pk_bf16_f32 %0, %1, %2" : "=v"(r) : "v"(lo), "v"(hi)); return r; }
template <class Epi, class Sched, bool STAMP = false>
__device__ __forceinline__ void gemm_phase(PG8_LAS unsigned char* lds, const Gemm g, const Sched& S, const Epi& E, unsigned long long* stamps) {
    const int tid = threadIdx.x, wid = __builtin_amdgcn_readfirstlane(tid >> 6), lane = tid & 63, wr = wid >> 2, wc = wid & 3, fr = lane & 15, fq = lane >> 4;
    const int K = g.K, nt = K / BK;
    int ts_lo = 0, ts_hi = 0, nts = 0; const unsigned long long rt_entry = STAMP ? (unsigned long long)wall_clock64() : 0ull;
#define PG8_STAMP() do { if (STAMP && wid == 0 && nts < 64) { const unsigned long long _c = (unsigned long long)clock64(); \
        ts_lo = (lane == nts) ? (int)(unsigned)_c : ts_lo; ts_hi = (lane == nts) ? (int)(unsigned)(_c >> 32) : ts_hi; ++nts; } } while (0)
    PG8_STAMP();
    unsigned voffA[2], voffB[2];
#pragma unroll
    for (int i = 0; i < 2; ++i) { int R, C; stage_rc(tid * 16 + i * 8192, R, C); const int Rb = Epi::PERM ? ((R & ~31) + perm32(R & 31)) : R;
        voffA[i] = (unsigned)(R * K + C) * 2u; voffB[i] = (unsigned)(Rb * K + C) * 2u; }
    const size_t kstep = (size_t)(BK * 2);
    const size_t hstep = (size_t)HALF * K * 2;
    const size_t tstep = 2 * hstep;
    const unsigned ldsw = (unsigned)wid * 1024u;
    const int aoff = lds_byte(wr * 64 + fr, fq * 8), boff = lds_byte(wc * 32 + fr, fq * 8);
#define PG8_SA(b, h) (((b) * 2 + (h)) * HTB)
#define PG8_SB(b, h) ((4 + (b) * 2 + (h)) * HTB)
#define PG8_STAGE(bufoff, gbase, voff) do { _Pragma("unroll") for (int _i = 0; _i < 2; ++_i) \
        __builtin_amdgcn_global_load_lds((const unsigned*)((const char*)(gbase) + (voff)[_i]), (PG8_LAS unsigned*)(lds + (bufoff) + ldsw + _i * 8192), 16, 0, 0); } while (0)
#define PG8_LDA(dst, b, h) do { _Pragma("unroll") for (int m = 0; m < 4; ++m) _Pragma("unroll") for (int k = 0; k < 2; ++k) dst[m][k] = *(const PG8_LAS bf16x8*)(lds + PG8_SA(b, h) + aoff + m * 2048 + k * 1024); } while (0)
#define PG8_LDB(dst, b, h) do { _Pragma("unroll") for (int n = 0; n < 2; ++n) _Pragma("unroll") for (int k = 0; k < 2; ++k) dst[n][k] = *(const PG8_LAS bf16x8*)(lds + PG8_SB(b, h) + boff + n * 2048 + k * 1024); } while (0)
#define PG8_MMA(ai, bj, At, Bt) do { __builtin_amdgcn_s_setprio(1); _Pragma("unroll") for (int m = 0; m < 4; ++m) _Pragma("unroll") for (int n = 0; n < 2; ++n) _Pragma("unroll") for (int k = 0; k < 2; ++k) \
        acc[ai][bj][m][n] = __builtin_amdgcn_mfma_f32_16x16x32_bf16(Bt[n][k], At[m][k], acc[ai][bj][m][n], 0, 0, 0); __builtin_amdgcn_s_setprio(0); } while (0)
#define PG8_WAIT_V(n) asm volatile("s_waitcnt vmcnt(" #n ")" ::: "memory")
#define PG8_WAIT_L(n) asm volatile("s_waitcnt lgkmcnt(" #n ")" ::: "memory")
#define PG8_BAR __builtin_amdgcn_s_barrier()
#define PG8_SCHED __builtin_amdgcn_sched_barrier(0)
    Unit cur, nxt; int ui = 0;
    if (!S.next(0, cur)) return;
    f32x4 acc[2][2][4][2];
#pragma unroll
    for (int a = 0; a < 2; ++a)
#pragma unroll
        for (int b = 0; b < 2; ++b)
#pragma unroll
            for (int m = 0; m < 4; ++m)
#pragma unroll
                for (int n = 0; n < 2; ++n) acc[a][b][m][n] = (f32x4){0.f, 0.f, 0.f, 0.f};
    bf16x8 At[4][2], B0[2][2], B1[2][2];
    const char* cA = (const char*)g.A + (size_t)cur.pm * tstep; const char* cB = (const char*)g.Bt + (size_t)cur.pn * tstep;
    S.a_ready(cur);
    PG8_STAGE(PG8_SB(0, 0), cB, voffB); PG8_STAGE(PG8_SA(0, 0), cA, voffA); PG8_STAGE(PG8_SB(0, 1), cB + hstep, voffB); PG8_STAGE(PG8_SA(0, 1), cA + hstep, voffA);
    if (wr == 1) PG8_BAR;
    PG8_WAIT_V(4); PG8_BAR;
    PG8_STAGE(PG8_SB(1, 0), cB + kstep, voffB); PG8_STAGE(PG8_SA(1, 0), cA + kstep, voffA); PG8_STAGE(PG8_SB(1, 1), cB + hstep + kstep, voffB);
    PG8_WAIT_V(6); PG8_BAR;
    PG8_STAMP();
    for (;;) {
        const bool has_next = S.next(ui + 1, nxt);
        const char* nA = has_next ? (const char*)g.A + (size_t)nxt.pm * tstep : cA; const char* nB = has_next ? (const char*)g.Bt + (size_t)nxt.pn * tstep : cB;
        for (int t = 0; t < nt; t += 2) {
            const bool last = (t == nt - 2);
            const char* a1 = cA + (size_t)(t + 1) * kstep;
            const char* a2 = last ? nA : cA + (size_t)(t + 2) * kstep; const char* b2 = last ? nB : cB + (size_t)(t + 2) * kstep;
            const char* a3 = a2 + kstep; const char* b3 = b2 + kstep;
            if (last && has_next) S.a_ready(nxt);
            PG8_LDB(B0, 0, 0); PG8_SCHED; PG8_LDA(At, 0, 0); PG8_STAGE(PG8_SA(1, 1), a1 + hstep, voffA);
            PG8_WAIT_L(8); PG8_BAR; PG8_WAIT_L(0); PG8_MMA(0, 0, At, B0); PG8_BAR; PG8_SCHED;
            PG8_LDB(B1, 0, 1); PG8_STAGE(PG8_SB(0, 0), b2, voffB);
            PG8_BAR; PG8_WAIT_L(0); PG8_MMA(0, 1, At, B1); PG8_BAR;
            PG8_LDA(At, 0, 1); PG8_STAGE(PG8_SA(0, 0), a2, voffA);
            PG8_BAR; PG8_WAIT_L(0); PG8_MMA(1, 0, At, B0); PG8_BAR; PG8_SCHED;
            PG8_STAGE(PG8_SB(0, 1), b2 + hstep, voffB);
            PG8_WAIT_V(6); PG8_BAR; PG8_MMA(1, 1, At, B1); PG8_BAR;
            PG8_LDB(B0, 1, 0); PG8_SCHED; PG8_LDA(At, 1, 0); PG8_STAGE(PG8_SA(0, 1), a2 + hstep, voffA);
            PG8_WAIT_L(8); PG8_BAR; PG8_WAIT_L(0); PG8_MMA(0, 0, At, B0); PG8_BAR; PG8_SCHED;
            PG8_LDB(B1, 1, 1); PG8_STAGE(PG8_SB(1, 0), b3, voffB);
            PG8_BAR; PG8_WAIT_L(0); PG8_MMA(0, 1, At, B1); PG8_BAR;
            PG8_LDA(At, 1, 1); PG8_STAGE(PG8_SA(1, 0), a3, voffA);
            PG8_BAR; PG8_WAIT_L(0); PG8_MMA(1, 0, At, B0); PG8_BAR; PG8_SCHED;
            PG8_STAGE(PG8_SB(1, 1), b3 + hstep, voffB);
            PG8_WAIT_V(6); PG8_BAR; PG8_MMA(1, 1, At, B1); PG8_BAR;
        }
        PG8_STAMP();
        if constexpr (!Epi::AFTER_DRAIN) { E(acc, cur, wr, wc, fr, fq); S.done(cur); }
        PG8_STAMP();
        if (!has_next) break;
#pragma unroll
        for (int a = 0; a < 2; ++a)
#pragma unroll
            for (int b = 0; b < 2; ++b)
#pragma unroll
                for (int m = 0; m < 4; ++m)
#pragma unroll
                    for (int n = 0; n < 2; ++n) acc[a][b][m][n] = (f32x4){0.f, 0.f, 0.f, 0.f};
        cur = nxt; cA = nA; cB = nB; ++ui;
    }
    PG8_WAIT_V(0);
    if (wr == 0) PG8_BAR;
    PG8_BAR;
    if constexpr (Epi::AFTER_DRAIN) { E.fused(acc, cur, wr, wc, fr, fq, lds, wid, lane); S.done(cur); }
    PG8_STAMP();
    if (STAMP && wid == 0) { stamps[lane] = lane < nts ? (((unsigned long long)(unsigned)ts_hi << 32) | (unsigned)ts_lo) : 0ull;
        if (lane == 62) stamps[62] = rt_entry; if (lane == 63) stamps[63] = (unsigned long long)wall_clock64(); }
#undef PG8_STAMP
#undef PG8_SA
#undef PG8_SB
#undef PG8_STAGE
#undef PG8_LDA
#undef PG8_LDB
#undef PG8_MMA
#undef PG8_WAIT_V
#undef PG8_WAIT_L
#undef PG8_BAR
#undef PG8_SCHED
}
}

#define XB_TMO      128
#define XB_XCNT(j)  (256  + 64 * (j))
#define XB_XSUB(j)  (1280 + 64 * (j))
#define XB_XGEN(j)  (2304 + 64 * (j))
#define XB_TOP      3328
#define XB_TOPGEN   3392
#define XCD_BAR_WORDS 3456
#define XB_SPIN_CAP (1u << 18)

__device__ __forceinline__ unsigned xb_ld(unsigned* p)              { return __hip_atomic_load(p, __ATOMIC_RELAXED, __HIP_MEMORY_SCOPE_AGENT); }
__device__ __forceinline__ unsigned xb_add(unsigned* p, unsigned v) { return __hip_atomic_fetch_add(p, v, __ATOMIC_RELAXED, __HIP_MEMORY_SCOPE_AGENT); }
__device__ __forceinline__ unsigned xb_xcc_id() { return (unsigned)__builtin_amdgcn_s_getreg((3 << 11) | 20) & 0xFu; }
#define XB_SPIN(cond, bar) do { unsigned _sp = 0; while (cond) { __builtin_amdgcn_s_sleep(1); \
    if ((++_sp & 255u) == 0u) { if (xb_ld(&(bar)[XB_TMO])) break; if (_sp > XB_SPIN_CAP) { atomicAdd(&(bar)[XB_TMO], 1u); break; } } } } while (0)

struct XcdBarrier {
    unsigned* bar; unsigned x;
    volatile LAS unsigned* st;
};

__device__ __forceinline__ XcdBarrier xcd_barrier_post(unsigned* bar, volatile LAS unsigned* st) {
    XcdBarrier b; b.bar = bar; b.x = xb_xcc_id(); b.st = st;
    if (threadIdx.x == 0) (void)xb_add(&bar[XB_XCNT(b.x)], 1u);
    return b;
}
__device__ __forceinline__ void xcd_barrier_complete(unsigned* bar, unsigned x, unsigned& nloc, unsigned& nx) {
    const unsigned G = gridDim.x * gridDim.y * gridDim.z;
    unsigned sum, cnt, mine, sp = 0u;
    for (;;) {
        sum = 0u; cnt = 0u; mine = 0u;
#pragma unroll
        for (unsigned j = 0; j < 16; ++j) { const unsigned c = xb_ld(&bar[XB_XCNT(j)]); sum += c; cnt += (c > 0u) ? 1u : 0u; mine = (j == x) ? c : mine; }
        if (sum == G) break;
        __builtin_amdgcn_s_sleep(1);
        if ((++sp & 255u) == 0u) { if (xb_ld(&bar[XB_TMO])) break; if (sp > XB_SPIN_CAP) { atomicAdd(&bar[XB_TMO], 1u); break; } }
    }
    nloc = mine > 0u ? mine : 1u; nx = cnt > 0u ? cnt : 1u;
}

__device__ __forceinline__ void xcd_barrier(const XcdBarrier& b) {
    asm volatile("s_waitcnt vmcnt(0)" ::: "memory");
    __syncthreads();
    if (threadIdx.x == 0) {
        unsigned* bar = b.bar;
        __builtin_amdgcn_s_waitcnt(0);
        unsigned nloc = b.st[0], nx = b.st[1];
        if (nloc == 0u) { xcd_barrier_complete(bar, b.x, nloc, nx); b.st[0] = nloc; b.st[1] = nx; }
        const unsigned old = xb_add(&bar[XB_XSUB(b.x)], 1u);
        const unsigned gen = old / nloc;
        if (old + 1u == (gen + 1u) * nloc) {
            __builtin_amdgcn_fence(__ATOMIC_RELEASE, "agent");
            asm volatile("s_waitcnt vmcnt(0)" ::: "memory");
            const unsigned og = xb_add(&bar[XB_TOP], 1u);
            const unsigned tg = og / nx;
            if (og + 1u == (tg + 1u) * nx) xb_add(&bar[XB_TOPGEN], 1u);
            else XB_SPIN(xb_ld(&bar[XB_TOPGEN]) == tg, bar);
            __builtin_amdgcn_fence(__ATOMIC_ACQUIRE, "agent");
            xb_add(&bar[XB_XGEN(b.x)], 1u);
            asm volatile("s_waitcnt vmcnt(0)" ::: "memory");
        } else {
            XB_SPIN(xb_ld(&bar[XB_XGEN(b.x)]) == gen, bar);
            __builtin_amdgcn_fence(__ATOMIC_ACQUIRE, "agent");
            asm volatile("s_waitcnt vmcnt(0)" ::: "memory");
        }
    }
    __syncthreads();
}

using pg8::bf16_t; using pg8::bf16x8; using pg8::f32x4; using pg8::u32x4;
#define DI __device__ __forceinline__
typedef unsigned char uchar;
typedef unsigned u32x2 __attribute__((ext_vector_type(2)));

constexpr int NTP = 16384, NTS = 512, NTOK = 16896, DM = 1024, DIN = 3848, NGE = 3840, NPJ = 3328, SEQ = 8192;
constexpr int C_AQ = 0, C_AK = 512, C_AV = 640, C_AG = 768, C_MQ = 1280, C_MK = 1792, C_MV = 2304, C_G = 2816;
constexpr int NCH = 64, CH = 128, USZ = 129 * 128;
constexpr size_t O_Y = 0, O_KWP = 17301504, O_VWP = 17334272, O_CONVP = 17367040, O_CP = 17373184, O_NP = 17504256, O_MP = 17505280,
                 O_KWS = 17505288, O_VWS = 19602440, O_CONVS = 21699592, O_CS = 22092808, O_NS = 30481416, O_MS = 30546952;
constexpr size_t WS_WTIN = 0, WS_WTOUT = 7864320, WS_H = 9961472, WS_GATES = 44564480, WS_ROPE = 45105152, WS_FM = 45637632,
                 WS_PROJ = 46161920, WS_UST = 175923200, WS_MIXED = 209739776, WS_BAR = 244342784, WS_SB = 244342784 + 16384, WS_END = WS_SB + 16908288;
constexpr int LDS_MAIN = 151552, LDS_BYTES = LDS_MAIN + 16;

struct Params {
    const float *x_p, *x_s, *ck, *cv, *sconv, *sC, *sn, *sm, *norm_w, *w_in, *b_gates, *conv_w, *conv_b, *qnw, *knw, *sinks, *mhw, *w_out;
    float* out; uchar* ws;
};

DI float bflo(unsigned w) { return __uint_as_float(w << 16); }
DI float bfhi(unsigned w) { return __uint_as_float(w & 0xffff0000u); }
DI unsigned pk2(float a, float b) { return pg8::cvt_pk_bf16(a, b); }
DI bf16_t f2bf(float f) { unsigned u = __float_as_uint(f); u += 0x7fffu + ((u >> 16) & 1u); return (bf16_t)(u >> 16); }
DI void unpack8(const u32x4 w, float (&f)[8]) { f[0] = bflo(w.x); f[1] = bfhi(w.x); f[2] = bflo(w.y); f[3] = bfhi(w.y); f[4] = bflo(w.z); f[5] = bfhi(w.z); f[6] = bflo(w.w); f[7] = bfhi(w.w); }
DI u32x4 pack8(const float (&f)[8]) { u32x4 w; w.x = pk2(f[0], f[1]); w.y = pk2(f[2], f[3]); w.z = pk2(f[4], f[5]); w.w = pk2(f[6], f[7]); return w; }
DI float wsum(float v) { for (int o = 32; o; o >>= 1) v += __shfl_xor(v, o); return v; }
DI float silu(float x) { return x * __builtin_amdgcn_rcpf(1.0f + __builtin_amdgcn_exp2f(-1.4426950408889634f * x)); }
DI float sigm(float x) { return __builtin_amdgcn_rcpf(1.0f + __builtin_amdgcn_exp2f(-1.4426950408889634f * x)); }
DI f32x4 mfma16(bf16x8 a, bf16x8 b, f32x4 c) { return __builtin_amdgcn_mfma_f32_16x16x32_bf16(a, b, c, 0, 0, 0); }

typedef float f32x2g __attribute__((ext_vector_type(2)));
DI void norm_row(const Params& p, const LAS float* wg, int row, const float4 (&xv)[4], const float4 (&nw)[4], float bgl, int lane) {
    bf16_t* H = (bf16_t*)(p.ws + WS_H); float* gates = (float*)(p.ws + WS_GATES);
    float ss = 0.f;
#pragma unroll
    for (int i = 0; i < 4; ++i) ss += xv[i].x * xv[i].x + xv[i].y * xv[i].y + xv[i].z * xv[i].z + xv[i].w * xv[i].w;
    ss = wsum(ss); const float rstd = rsqrtf(ss * (1.0f / DM) + 1e-6f);
    f32x2g g2[8];
#pragma unroll
    for (int j = 0; j < 8; ++j) g2[j] = (f32x2g){0.f, 0.f};
    u32x2 hw[4];
#pragma unroll
    for (int i = 0; i < 4; ++i) { const int d0 = i * 256 + lane * 4;
        const f32x2g ha = (f32x2g){xv[i].x, xv[i].y} * rstd * (f32x2g){nw[i].x, nw[i].y}, hb = (f32x2g){xv[i].z, xv[i].w} * rstd * (f32x2g){nw[i].z, nw[i].w};
        hw[i].x = pk2(ha.x, ha.y); hw[i].y = pk2(hb.x, hb.y);
#pragma unroll
        for (int j = 0; j < 8; ++j) { const f32x4 wv = *(const LAS f32x4*)(wg + j * 1024 + d0); g2[j] += ha * (f32x2g){wv[0], wv[1]}; g2[j] += hb * (f32x2g){wv[2], wv[3]}; } }
#pragma unroll
    for (int i = 0; i < 4; ++i) *(u32x2*)(H + (size_t)row * DM + i * 256 + lane * 4) = hw[i];
    float g[8];
#pragma unroll
    for (int j = 0; j < 8; ++j) g[j] = g2[j].x + g2[j].y;
    const bool b5 = lane & 32, b4 = lane & 16, b3 = lane & 8;
    float r1[4], r2[2], r3;
#pragma unroll
    for (int j = 0; j < 4; ++j) { const float mine = b5 ? g[4 + j] : g[j], other = b5 ? g[j] : g[4 + j]; r1[j] = mine + __shfl_xor(other, 32); }
#pragma unroll
    for (int j = 0; j < 2; ++j) { const float mine = b4 ? r1[2 + j] : r1[j], other = b4 ? r1[j] : r1[2 + j]; r2[j] = mine + __shfl_xor(other, 16); }
    { const float mine = b3 ? r2[1] : r2[0], other = b3 ? r2[0] : r2[1]; r3 = mine + __shfl_xor(other, 8); }
    r3 += __shfl_xor(r3, 4); r3 += __shfl_xor(r3, 2); r3 += __shfl_xor(r3, 1);
    const float z = r3 + bgl; const int gi = lane >> 3;
    const float lf = fminf(z, 0.f) - __logf(1.0f + __expf(-fabsf(z)));
    if ((lane & 7) == 0) gates[(size_t)row * 8 + gi] = gi < 4 ? z : lf;
}
DI void transpose_tiles(const Params& p, LAS uchar* lds, int tlo, int thi, int part, int nparts) {
    const int tid = threadIdx.x;
    LAS float* tile = (LAS float*)lds;
    for (int t0 = tlo + part * 2; t0 < thi; t0 += nparts * 2) {
        const float* src[2]; bf16_t* dst[2]; int ld[2], k0[2], n0[2], sc0[2];
#pragma unroll
        for (int q = 0; q < 2; ++q) { const int t = t0 + q;
            if (t < 960) { const int nt = t % 60, kt = t / 60; n0[q] = nt * 64; k0[q] = kt * 64; sc0[q] = n0[q] < 2816 ? n0[q] : (((n0[q] - 2816) & 255) < 128 ? 2816 + ((n0[q] - 2816) >> 8) * 128 + ((n0[q] - 2816) & 255) : 3336 + ((n0[q] - 2816) >> 8) * 128 + ((n0[q] - 2816) & 255) - 128); src[q] = p.w_in; ld[q] = DIN; dst[q] = (bf16_t*)(p.ws + WS_WTIN); }
            else { const int t2 = t - 960, nt = t2 % 16, kt = t2 / 16; n0[q] = nt * 64; k0[q] = kt * 64; sc0[q] = n0[q]; src[q] = p.w_out; ld[q] = DM; dst[q] = (bf16_t*)(p.ws + WS_WTOUT); } }
        float4 v[2][2];
#pragma unroll
        for (int q = 0; q < 2; ++q)
#pragma unroll
            for (int ps = 0; ps < 2; ++ps) { const int kk = (tid >> 4) + 32 * ps, nn4 = (tid & 15) * 4; v[q][ps] = *(const float4*)(src[q] + (size_t)(k0[q] + kk) * ld[q] + sc0[q] + nn4); }
#pragma unroll
        for (int q = 0; q < 2; ++q)
#pragma unroll
            for (int ps = 0; ps < 2; ++ps) { const int kk = (tid >> 4) + 32 * ps, nn4 = (tid & 15) * 4; LAS float* tl = tile + q * 4160 + kk * 65 + nn4; tl[0] = v[q][ps].x; tl[1] = v[q][ps].y; tl[2] = v[q][ps].z; tl[3] = v[q][ps].w; }
        __syncthreads();
#pragma unroll
        for (int q = 0; q < 2; ++q) { const int nn = tid >> 3, kk8 = (tid & 7) * 8; float f[8];
#pragma unroll
          for (int j = 0; j < 8; ++j) f[j] = tile[q * 4160 + (kk8 + j) * 65 + nn];
          *(u32x4*)(dst[q] + (size_t)(n0[q] + nn) * DM + k0[q] + kk8) = pack8(f); }
        __syncthreads();
    }
}
DI void rope_table(const Params& p, int part, int nparts) {
    const int tid = threadIdx.x;
    { float2* rope = (float2*)(p.ws + WS_ROPE);
      for (int idx = part * 512 + tid; idx < 8200 * 8; idx += nparts * 512) { const int pos = idx >> 3, i = idx & 7;
          const float invf = (float)exp(-(double)i * 0.125 * 13.122363377404328);
          const float ang = (float)pos * invf;
          const double q = rint((double)ang * 0.6366197723675814), r = (double)ang - q * 1.5707963267948966, r2 = r * r;
          const double s = r * (1.0 + r2 * (-1.0 / 6 + r2 * (1.0 / 120 + r2 * (-1.0 / 5040 + r2 * (1.0 / 362880 + r2 * (-1.0 / 39916800 + r2 * (1.0 / 6227020800.0)))))));
          const double c = 1.0 + r2 * (-0.5 + r2 * (1.0 / 24 + r2 * (-1.0 / 720 + r2 * (1.0 / 40320 + r2 * (-1.0 / 3628800 + r2 * (1.0 / 479001600.0))))));
          const int qi = ((int)q) & 3; double cs, sn;
          if (qi == 0) { sn = s; cs = c; } else if (qi == 1) { sn = c; cs = -s; } else if (qi == 2) { sn = -s; cs = -c; } else { sn = -c; cs = s; }
          rope[idx] = make_float2((float)cs, (float)sn); } }
}
DI void phase0(const Params& p, LAS uchar* lds) {
    const int tid = threadIdx.x, lane = tid & 63, wid = tid >> 6, nb = gridDim.x, bid = blockIdx.x;
#ifndef REP_TR
#define REP_TR 1
#define REP_ROW 1
#define REP_ROPE 1
#endif
    transpose_tiles(p, lds, 0, 960, bid, nb);
    LAS float* wg = (LAS float*)(lds + 32768);
    for (int d = tid; d < DM; d += 512) { const float4 a = *(const float4*)(p.w_in + (size_t)d * DIN + 3328), b = *(const float4*)(p.w_in + (size_t)d * DIN + 3332);
        wg[d] = a.x; wg[1024 + d] = a.y; wg[2048 + d] = a.z; wg[3072 + d] = a.w; wg[4096 + d] = b.x; wg[5120 + d] = b.y; wg[6144 + d] = b.z; wg[7168 + d] = b.w; }
    __syncthreads();
    float4 nwr[4];
#pragma unroll
    for (int i = 0; i < 4; ++i) nwr[i] = *(const float4*)(p.norm_w + i * 256 + lane * 4);
    const float bgr = p.b_gates[lane >> 3];
    for (int rp = 0; rp < REP_ROW; ++rp)
    for (int row = bid * 8 + wid; row < NTOK; row += nb * 16) {
        const int row2 = row + nb * 8; const bool has2 = row2 < NTOK; const int r2 = has2 ? row2 : row;
        const float* xa = row < NTP ? p.x_p + (size_t)row * DM : p.x_s + (size_t)(row - NTP) * DM;
        const float* xb = r2 < NTP ? p.x_p + (size_t)r2 * DM : p.x_s + (size_t)(r2 - NTP) * DM;
        float4 va[4], vb[4];
#pragma unroll
        for (int i = 0; i < 4; ++i) va[i] = *(const float4*)(xa + i * 256 + lane * 4);
#pragma unroll
        for (int i = 0; i < 4; ++i) vb[i] = *(const float4*)(xb + i * 256 + lane * 4);
        norm_row(p, wg, row, va, nwr, bgr, lane);
        if (has2) norm_row(p, wg, row2, vb, nwr, bgr, lane);
    }
}

DI float block_excl_sum(float v, LAS float* red, int tid) {
    const int lane = tid & 63, wid = tid >> 6; float inc = v;
#pragma unroll
    for (int o = 1; o < 64; o <<= 1) { const float t = __shfl_up(inc, o); if (lane >= o) inc += t; }
    __syncthreads(); if (lane == 63) red[wid] = inc; __syncthreads();
    float base = 0.f;
#pragma unroll
    for (int w = 0; w < 8; ++w) base += (w < wid) ? red[w] : 0.f;
    return base + inc - v;
}
DI float block_excl_max(float v, LAS float* red, int tid) {
    const int lane = tid & 63, wid = tid >> 6; float inc = v;
#pragma unroll
    for (int o = 1; o < 64; o <<= 1) { const float t = __shfl_up(inc, o); if (lane >= o) inc = fmaxf(inc, t); }
    __syncthreads(); if (lane == 63) red[wid] = inc; __syncthreads();
    float base = -INFINITY;
#pragma unroll
    for (int w = 0; w < 8; ++w) base = fmaxf(base, (w < wid) ? red[w] : -INFINITY);
    float ex = __shfl_up(inc, 1); if (lane == 0) ex = -INFINITY;
    return fmaxf(base, ex);
}
DI void gate_scan(const Params& p, LAS uchar* lds, int bh) {
    const int tid = threadIdx.x, b = bh >> 2, h = bh & 3, t0 = tid * 16;
    const float* gates = (const float*)(p.ws + WS_GATES); float2* FM = (float2*)(p.ws + WS_FM) + (size_t)bh * SEQ;
    LAS float* red = (LAS float*)lds;
    float li[16], F[16];
    float run = 0.f;
#pragma unroll
    for (int j = 0; j < 16; ++j) { const float* g = gates + (size_t)(b * SEQ + t0 + j) * 8; li[j] = g[h]; run += g[4 + h]; F[j] = run; }
    const float base = block_excl_sum(run, red, tid);
    float mx = -INFINITY, ml[16];
#pragma unroll
    for (int j = 0; j < 16; ++j) { F[j] += base; mx = fmaxf(mx, li[j] - F[j]); ml[j] = mx; }
    const float mb = fmaxf(block_excl_max(mx, red, tid), 0.0f);
#pragma unroll
    for (int j = 0; j < 16; ++j) FM[t0 + j] = make_float2(F[j], F[j] + fmaxf(ml[j], mb));
    __syncthreads();
}

struct EpiProj {
    static constexpr bool PERM = true, AFTER_DRAIN = false;
    bf16_t* O;
    __device__ __forceinline__ void operator()(const f32x4 (&acc)[2][2][4][2], const pg8::Unit& u, int wr, int wc, int fr, int fq) const {
        const int row0 = u.pm * 256 + wr * 64 + fr;
        if (u.pn < 11) { const int col0 = u.pn * 256 + wc * 32 + 8 * fq; const bool gate = (u.pn == 3) || (u.pn == 4);
#pragma unroll
            for (int ai = 0; ai < 2; ++ai)
#pragma unroll
                for (int m = 0; m < 4; ++m) { bf16_t* rowp = O + (size_t)(row0 + ai * 128 + m * 16) * NPJ + col0;
#pragma unroll
                    for (int bj = 0; bj < 2; ++bj) { f32x4 v0 = acc[ai][bj][m][0], v1 = acc[ai][bj][m][1];
                        if (gate) {
#pragma unroll
                            for (int e = 0; e < 4; ++e) { v0[e] = silu(v0[e]); v1[e] = silu(v1[e]); } }
                        u32x4 w; w.x = pk2(v0[0], v0[1]); w.y = pk2(v0[2], v0[3]); w.z = pk2(v1[0], v1[1]); w.w = pk2(v1[2], v1[3]);
                        *(u32x4*)(rowp + bj * 128) = w; } }
        } else { const int col0 = C_G + (u.pn - 11) * 128 + wc * 32 + 8 * fq;
#pragma unroll
            for (int ai = 0; ai < 2; ++ai)
#pragma unroll
                for (int m = 0; m < 4; ++m) { float g[8];
#pragma unroll
                    for (int n = 0; n < 2; ++n)
#pragma unroll
                        for (int e = 0; e < 4; ++e) { const float o = acc[ai][0][m][n][e], z = acc[ai][1][m][n][e];
                            g[4 * n + e] = z * __builtin_amdgcn_rcpf((1.0f + __builtin_amdgcn_exp2f(-1.4426950408889634f * o)) * (1.0f + __builtin_amdgcn_exp2f(-1.4426950408889634f * z))); }
                    *(u32x4*)(O + (size_t)(row0 + ai * 128 + m * 16) * NPJ + col0) = pack8(g); }
        }
    }
};
struct EpiOut {
    static constexpr bool PERM = false, AFTER_DRAIN = false;
    float* Y; const float* xp;
    __device__ __forceinline__ void operator()(const f32x4 (&acc)[2][2][4][2], const pg8::Unit& u, int wr, int wc, int fr, int fq) const {
        const int row0 = u.pm * 256 + wr * 64 + fr, col0 = u.pn * 256 + wc * 32 + 4 * fq;
#pragma unroll
        for (int ai = 0; ai < 2; ++ai)
#pragma unroll
            for (int mp = 0; mp < 2; ++mp) { f32x4 xv[2][2][2];
#pragma unroll
                for (int mm = 0; mm < 2; ++mm) { const float* xr = xp + (size_t)(row0 + ai * 128 + (mp * 2 + mm) * 16) * DM + col0;
#pragma unroll
                    for (int bj = 0; bj < 2; ++bj)
#pragma unroll
                        for (int n = 0; n < 2; ++n) xv[mm][bj][n] = *(const f32x4*)(xr + bj * 128 + n * 16); }
#pragma unroll
                for (int mm = 0; mm < 2; ++mm) { float* yr = Y + (size_t)(row0 + ai * 128 + (mp * 2 + mm) * 16) * DM + col0;
#pragma unroll
                    for (int bj = 0; bj < 2; ++bj)
#pragma unroll
                        for (int n = 0; n < 2; ++n) *(f32x4*)(yr + bj * 128 + n * 16) = acc[ai][bj][mp * 2 + mm][n] + xv[mm][bj][n]; } }
    }
};
DI void phase1(const Params& p, LAS uchar* lds) {
    const int nb = gridDim.x, bid = blockIdx.x;
    if (bid >= nb - 8) gate_scan(p, lds, bid - (nb - 8));
    {
        const int nun = (NTOK / 256) * (NGE / 256), rounds = (nun + nb - 1) / nb, first_light = nun - (rounds - 1) * nb;
        int part = bid - first_light, nparts = nb - 8 - first_light;
        if (nparts < 8) { part = bid; nparts = nb; }
        if (part >= 0 && part < nparts) { transpose_tiles(p, lds, 960, 960 + 256, part, nparts); rope_table(p, part, nparts); }
    }
    pg8::Gemm g; g.A = (const bf16_t*)(p.ws + WS_H); g.Bt = (const bf16_t*)(p.ws + WS_WTIN); g.M = NTOK; g.N = NGE; g.K = DM;
    pg8::StaticOrder S; S.init(g.M, g.N, nb, bid);
    EpiProj E; E.O = (bf16_t*)(p.ws + WS_PROJ);
    pg8::gemm_phase<EpiProj, pg8::StaticOrder, false>(lds, g, S, E, nullptr);
}
DI void phase5(const Params& p, LAS uchar* lds) {
    const int nb = gridDim.x, bid = blockIdx.x;
    pg8::Gemm g; g.A = (const bf16_t*)(p.ws + WS_MIXED); g.Bt = (const bf16_t*)(p.ws + WS_WTOUT); g.M = NTP; g.N = DM; g.K = DM;
    pg8::StaticOrder S; S.init(g.M, g.N, nb, bid);
    EpiOut E; E.Y = p.out + O_Y; E.xp = p.x_p;
    pg8::gemm_phase<EpiOut, pg8::StaticOrder, false>(lds, g, S, E, nullptr);
}

constexpr int KSTR = 144, VSTR = 560, AT_K = 0, AT_V = 272 * KSTR, AT_R = AT_V + 64 * VSTR;
typedef float f32x2r __attribute__((ext_vector_type(2)));

DI void qk_norm_rope16(float (&x)[16], int pt, const float* nw, const float2* rope_row) {
    float ss = 0.f;
#pragma unroll
    for (int j = 0; j < 16; ++j) ss += x[j] * x[j];
    ss += __shfl_xor(ss, 1); ss += __shfl_xor(ss, 2);
    const float rstd = rsqrtf(ss * (1.0f / 64) + 1e-6f);
#pragma unroll
    for (int j = 0; j < 16; ++j) x[j] = x[j] * rstd * nw[pt * 16 + j];
    if (pt == 0) {
#pragma unroll
        for (int i = 0; i < 8; ++i) { const float2 cs = rope_row[i]; const float a = x[i], b = x[i + 8]; x[i] = a * cs.x - b * cs.y; x[i + 8] = b * cs.x + a * cs.y; } }
}
DI void qk_norm_rope16p(float (&x)[16], int pt, const float* nw, const float2 (&rp)[8]) {
    float ss = 0.f;
#pragma unroll
    for (int j = 0; j < 16; ++j) ss += x[j] * x[j];
    ss += __shfl_xor(ss, 1); ss += __shfl_xor(ss, 2);
    const float rstd = rsqrtf(ss * (1.0f / 64) + 1e-6f);
#pragma unroll
    for (int j = 0; j < 16; ++j) x[j] = x[j] * rstd * nw[pt * 16 + j];
    if (pt == 0) {
#pragma unroll
        for (int i = 0; i < 8; ++i) { const float2 cs = rp[i]; const float a = x[i], b = x[i + 8]; x[i] = a * cs.x - b * cs.y; x[i + 8] = b * cs.x + a * cs.y; } }
}
DI void kv_to_lds(LAS uchar* lds, int ki, int pt, const float (&xk)[16], const float (&xv)[16]) {
    float a[8], b[8];
#pragma unroll
    for (int j = 0; j < 8; ++j) { a[j] = xk[j]; b[j] = xk[8 + j]; }
    *(LAS u32x4*)(lds + AT_K + ki * KSTR + pt * 32) = pack8(a); *(LAS u32x4*)(lds + AT_K + ki * KSTR + pt * 32 + 16) = pack8(b);
#pragma unroll
    for (int j = 0; j < 16; j += 2) { const unsigned w = pk2(xv[j], xv[j + 1]);
        *(LAS bf16_t*)(lds + AT_V + (pt * 16 + j) * VSTR + ki * 2) = (bf16_t)(w & 0xffffu); *(LAS bf16_t*)(lds + AT_V + (pt * 16 + j + 1) * VSTR + ki * 2) = (bf16_t)(w >> 16); }
}
DI void load16bf(const bf16_t* src, float (&x)[16]) { const u32x4 w0 = *(const u32x4*)src, w1 = *(const u32x4*)(src + 8); float a[8], b[8]; unpack8(w0, a); unpack8(w1, b);
#pragma unroll
    for (int j = 0; j < 8; ++j) { x[j] = a[j]; x[8 + j] = b[j]; } }
DI void load16f(const float* src, float (&x)[16]) {
#pragma unroll
    for (int j = 0; j < 4; ++j) { const float4 v = *(const float4*)(src + 4 * j); x[4 * j] = v.x; x[4 * j + 1] = v.y; x[4 * j + 2] = v.z; x[4 * j + 3] = v.w; } }
DI void store16f(float* dst, const float (&x)[16]) {
#pragma unroll
    for (int j = 0; j < 4; ++j) *(float4*)(dst + 4 * j) = make_float4(x[4 * j], x[4 * j + 1], x[4 * j + 2], x[4 * j + 3]); }

struct QRaw { u32x4 q0, q1; u32x2 gw[4]; };
DI void attn_q_load(const Params& p, int row, int hqa, QRaw& qr) {
    const int lane = threadIdx.x & 63, quad = lane >> 4;
    const bf16_t* rowp = (const bf16_t*)(p.ws + WS_PROJ) + (size_t)row * NPJ;
    qr.q0 = *(const u32x4*)(rowp + C_AQ + hqa * 64 + 8 * quad); qr.q1 = *(const u32x4*)(rowp + C_AQ + hqa * 64 + 32 + 8 * quad);
#pragma unroll
    for (int mt = 0; mt < 4; ++mt) qr.gw[mt] = *(const u32x2*)(rowp + C_AG + hqa * 64 + 16 * mt + 4 * quad);
}
template <bool LROPE> DI void attn_q_tile(const Params& p, LAS uchar* lds, const QRaw& qr, const float (&qw0)[8], const float (&qw1)[8], int row, int pos, int hqa, int qi, int kt0, int kmin) {
    const int lane = threadIdx.x & 63, r = lane & 15, quad = lane >> 4;
    const float2* rope = (const float2*)(p.ws + WS_ROPE);
    float x0[8], x1[8];
    unpack8(qr.q0, x0); unpack8(qr.q1, x1);
    float ss = 0.f;
#pragma unroll
    for (int j = 0; j < 8; ++j) ss += x0[j] * x0[j] + x1[j] * x1[j];
    ss += __shfl_xor(ss, 16); ss += __shfl_xor(ss, 32);
    const float rstd = rsqrtf(ss * (1.0f / 64) + 1e-6f) ;
#pragma unroll
    for (int j = 0; j < 8; ++j) { x0[j] = x0[j] * rstd * qw0[j]; x1[j] = x1[j] * rstd * qw1[j]; }
#pragma unroll
    for (int j = 0; j < 8; ++j) { const float pj = __shfl_xor(x0[j], 16); float2 cs; if (LROPE) { const f32x2r c2 = *(const LAS f32x2r*)(lds + AT_R + qi * 64 + j * 8); cs = make_float2(c2.x, c2.y); } else cs = rope[(size_t)pos * 8 + j];
        const float rot = x0[j] * cs.x + (quad == 0 ? -pj : pj) * cs.y; x0[j] = (quad < 2) ? rot : x0[j]; }
#pragma unroll
    for (int j = 0; j < 8; ++j) { x0[j] *= 0.18033688011112042f; x1[j] *= 0.18033688011112042f; }
    const bf16x8 qf0 = __builtin_bit_cast(bf16x8, pack8(x0)), qf1 = __builtin_bit_cast(bf16x8, pack8(x1));
    const float sink = p.sinks[hqa] * 1.4426950408889634f;
    f32x4 s[9];
#pragma unroll
    for (int kt = 0; kt < 9; ++kt) { const int krow = (kt0 + kt) * 16 + r;
        const bf16x8 a0 = *(const LAS bf16x8*)(lds + AT_K + krow * KSTR + quad * 16), a1 = *(const LAS bf16x8*)(lds + AT_K + krow * KSTR + 64 + quad * 16);
        f32x4 acc = {0.f, 0.f, 0.f, 0.f}; acc = mfma16(a0, qf0, acc); acc = mfma16(a1, qf1, acc); s[kt] = acc; }
    float mx = sink;
#pragma unroll
    for (int kt = 0; kt < 9; ++kt) {
        if ((kt0 + kt) * 16 + 15 < kmin) { s[kt] = (f32x4){-INFINITY, -INFINITY, -INFINITY, -INFINITY}; }
        else {
            if (kt == 0) {
#pragma unroll
                for (int v = 0; v < 4; ++v) { const int ki = kt0 * 16 + quad * 4 + v; s[kt][v] = (ki > qi) ? s[kt][v] : -INFINITY; } }
            if (kt == 8) {
#pragma unroll
                for (int v = 0; v < 4; ++v) { const int ki = (kt0 + 8) * 16 + quad * 4 + v; s[kt][v] = (ki <= qi + 128) ? s[kt][v] : -INFINITY; } }
            mx = fmaxf(fmaxf(mx, fmaxf(s[kt][0], s[kt][1])), fmaxf(s[kt][2], s[kt][3])); } }
    mx = fmaxf(mx, __shfl_xor(mx, 16)); mx = fmaxf(mx, __shfl_xor(mx, 32));
    float sum = 0.f;
#pragma unroll
    for (int kt = 0; kt < 9; ++kt)
#pragma unroll
        for (int v = 0; v < 4; ++v) { const float e = __builtin_amdgcn_exp2f(s[kt][v] - mx); s[kt][v] = e; sum += e; }
    sum += __shfl_xor(sum, 16); sum += __shfl_xor(sum, 32);
    sum += __builtin_amdgcn_exp2f(sink - mx);
    const float inv = __builtin_amdgcn_rcpf(sum);
    f32x4 o[4];
#pragma unroll
    for (int mt = 0; mt < 4; ++mt) o[mt] = (f32x4){0.f, 0.f, 0.f, 0.f};
#pragma unroll
    for (int ks = 0; ks < 5; ++ks) {
        u32x4 pw; pw.x = pk2(s[2 * ks][0], s[2 * ks][1]); pw.y = pk2(s[2 * ks][2], s[2 * ks][3]);
        if (ks < 4) { pw.z = pk2(s[2 * ks + 1][0], s[2 * ks + 1][1]); pw.w = pk2(s[2 * ks + 1][2], s[2 * ks + 1][3]); } else { pw.z = 0u; pw.w = 0u; }
        const bf16x8 pb = __builtin_bit_cast(bf16x8, pw);
#pragma unroll
        for (int mt = 0; mt < 4; ++mt) { const int d = 16 * mt + r; const LAS uchar* vp = lds + AT_V + d * VSTR + ((kt0 + 2 * ks) * 16 + 4 * quad) * 2;
            u32x4 aw; const u32x2 lo = *(const LAS u32x2*)vp, hi = *(const LAS u32x2*)(vp + 32); aw.x = lo.x; aw.y = lo.y; aw.z = hi.x; aw.w = hi.y;
            o[mt] = mfma16(__builtin_bit_cast(bf16x8, aw), pb, o[mt]); } }
    bf16_t* mixed = (bf16_t*)(p.ws + WS_MIXED) + (size_t)row * DM;
#pragma unroll
    for (int mt = 0; mt < 4; ++mt) { const int col = hqa * 64 + 16 * mt + 4 * quad; const u32x2 gw = qr.gw[mt];
        u32x2 w; w.x = pk2(o[mt][0] * inv * bflo(gw.x), o[mt][1] * inv * bfhi(gw.x)); w.y = pk2(o[mt][2] * inv * bflo(gw.y), o[mt][3] * inv * bfhi(gw.y));
        *(u32x2*)(mixed + col) = w; }
}

DI void attn_prompt_item(const Params& p, LAS uchar* lds, int item) {
    const int tid = threadIdx.x, wid = tid >> 6, lane = tid & 63, r = lane & 15;
    const int g = item & 1, blk = (item >> 1) & 63, b = item >> 7;
    const bf16_t* proj = (const bf16_t*)(p.ws + WS_PROJ); const float2* rope = (const float2*)(p.ws + WS_ROPE);
    const int hqa = g * 4 + (wid >> 1), qh = wid & 1;
    __syncthreads();
    float qw0[8], qw1[8];
    { const int quad = lane >> 4;
#pragma unroll
      for (int j = 0; j < 8; ++j) { qw0[j] = p.qnw[8 * quad + j]; qw1[j] = p.qnw[32 + 8 * quad + j]; } }
    u32x4 kr[2][2], vr[2][2]; float2 rp[2][8];
#pragma unroll
    for (int it = 0; it < 2; ++it) { const int u = tid + 512 * it, ki = u >> 2, pt = u & 3, tk = (blk - 1) * 128 + ki; const int tkc = tk < 0 ? 0 : tk;
        const bf16_t* rowp = proj + (size_t)(b * SEQ + tkc) * NPJ;
        kr[it][0] = *(const u32x4*)(rowp + C_AK + g * 64 + pt * 16); kr[it][1] = *(const u32x4*)(rowp + C_AK + g * 64 + pt * 16 + 8);
        vr[it][0] = *(const u32x4*)(rowp + C_AV + g * 64 + pt * 16); vr[it][1] = *(const u32x4*)(rowp + C_AV + g * 64 + pt * 16 + 8);
#pragma unroll
        for (int i = 0; i < 8; ++i) rp[it][i] = rope[(size_t)tkc * 8 + i]; }
    if (tid < 128) { u32x4 z; z.x = 0u; z.y = 0u; z.z = 0u; z.w = 0u; *(LAS u32x4*)(lds + AT_V + (tid >> 1) * VSTR + 512 + (tid & 1) * 16) = z; }
    QRaw qr[4];
#pragma unroll
    for (int i = 0; i < 4; ++i) attn_q_load(p, b * SEQ + blk * 128 + (qh * 4 + i) * 16 + r, hqa, qr[i]);
    { const float2 ra = rope[(size_t)blk * 1024 + tid], rb = rope[(size_t)blk * 1024 + 512 + tid];
      *(LAS f32x2r*)(lds + AT_R + tid * 8) = (f32x2r){ra.x, ra.y}; *(LAS f32x2r*)(lds + AT_R + (512 + tid) * 8) = (f32x2r){rb.x, rb.y}; }
#pragma unroll
    for (int it = 0; it < 2; ++it) { const int u = tid + 512 * it, ki = u >> 2, pt = u & 3;
        {
            float xk[16], xv[16]; float a[8], c[8];
            unpack8(kr[it][0], a); unpack8(kr[it][1], c);
#pragma unroll
            for (int j = 0; j < 8; ++j) { xk[j] = a[j]; xk[8 + j] = c[j]; }
            unpack8(vr[it][0], a); unpack8(vr[it][1], c);
#pragma unroll
            for (int j = 0; j < 8; ++j) { xv[j] = a[j]; xv[8 + j] = c[j]; }
            qk_norm_rope16p(xk, pt, p.knw, rp[it]);
            kv_to_lds(lds, ki, pt, xk, xv);
            if (blk == 63 && ki >= 128) { const size_t o = ((size_t)(b * 128 + ki - 128) * 2 + g) * 64 + pt * 16; store16f(p.out + O_KWP + o, xk); store16f(p.out + O_VWP + o, xv); } } }
    __syncthreads();
#pragma unroll 2
    for (int i = 0; i < 4; ++i) { const int qt = qh * 4 + i, qi = qt * 16 + r, tq = blk * 128 + qi;
        attn_q_tile<true>(p, lds, qr[0], qw0, qw1, b * SEQ + tq, tq, hqa, qi, qt, blk == 0 ? 128 : 0);
        qr[0] = qr[1]; qr[1] = qr[2]; qr[2] = qr[3]; }
}
DI void attn_sample_item(const Params& p, LAS uchar* lds, int item) {
    const int tid = threadIdx.x, wid = tid >> 6, lane = tid & 63, r = lane & 15;
    const int g = item & 1, b = item >> 1;
    const bf16_t* proj = (const bf16_t*)(p.ws + WS_PROJ); const float2* rope = (const float2*)(p.ws + WS_ROPE);
    __syncthreads();
    QRaw qrs; if (wid == 0) attn_q_load(p, NTP + b * 4 + (r >> 2), g * 4 + (r & 3), qrs);
    float qw0[8], qw1[8];
    { const int quad = lane >> 4;
#pragma unroll
      for (int j = 0; j < 8; ++j) { qw0[j] = p.qnw[8 * quad + j]; qw1[j] = p.qnw[32 + 8 * quad + j]; } }
    for (int u = tid; u < 640; u += 512) { const int ki = u >> 2, pt = u & 3;
        float xk[16], xv[16];
#pragma unroll
        for (int j = 0; j < 16; ++j) { xk[j] = 0.f; xv[j] = 0.f; }
        if (ki < 128) { const size_t o = ((size_t)(b * 128 + ki) * 2 + g) * 64 + pt * 16; load16f(p.ck + o, xk); load16f(p.cv + o, xv); }
        else { if (ki < 132) { const bf16_t* rowp = proj + (size_t)(NTP + b * 4 + ki - 128) * NPJ; load16bf(rowp + C_AK + g * 64 + pt * 16, xk); load16bf(rowp + C_AV + g * 64 + pt * 16, xv); }
               qk_norm_rope16(xk, pt, p.knw, rope + (size_t)(SEQ + (ki < 132 ? ki - 128 : 0)) * 8); }
        kv_to_lds(lds, ki, pt, xk, xv);
        if (ki >= 4 && ki < 132) { const size_t o = ((size_t)(b * 128 + ki - 4) * 2 + g) * 64 + pt * 16; store16f(p.out + O_KWS + o, xk); store16f(p.out + O_VWS + o, xv); }
    }
    __syncthreads();
    if (wid == 0) { const int t = r >> 2, hqa = g * 4 + (r & 3); attn_q_tile<false>(p, lds, qrs, qw0, qw1, NTP + b * 4 + t, SEQ + t, hqa, t, 0, 0); }
}

constexpr int TSTR = 272;
constexpr int ML_Q = 0, ML_K = 128 * TSTR, ML_V = ML_K + 128 * TSTR, ML_S = ML_V + 144 * TSTR, ML_AS = ML_S + 144 * TSTR, ML_END = ML_AS + 512;
static_assert(ML_END <= LDS_MAIN, "lds");

struct ConvIn { u32x4 row[11]; float4 w[4][2]; float4 bias[2]; };
DI void conv_issue(const Params& p, const bf16_t* proj, int b, int t0, int col, int ch, ConvIn& ci) {
#pragma unroll
    for (int i = 0; i < 11; ++i) { const int tt = t0 - 3 + i; ci.row[i] = *(const u32x4*)(proj + (size_t)(b * SEQ + (tt < 0 ? 0 : tt)) * NPJ + col); }
#pragma unroll
    for (int j = 0; j < 4; ++j) { ci.w[j][0] = *(const float4*)(p.conv_w + j * 1024 + ch); ci.w[j][1] = *(const float4*)(p.conv_w + j * 1024 + ch + 4); }
    ci.bias[0] = *(const float4*)(p.conv_b + ch); ci.bias[1] = *(const float4*)(p.conv_b + ch + 4);
}
typedef float f32x2 __attribute__((ext_vector_type(2)));
DI void conv_compute(const ConvIn& ci, int t0, float (&y)[8][8]) {
    f32x2 w[4][4], yy[8][4];
#pragma unroll
    for (int j = 0; j < 4; ++j) { w[j][0] = (f32x2){ci.w[j][0].x, ci.w[j][0].y}; w[j][1] = (f32x2){ci.w[j][0].z, ci.w[j][0].w}; w[j][2] = (f32x2){ci.w[j][1].x, ci.w[j][1].y}; w[j][3] = (f32x2){ci.w[j][1].z, ci.w[j][1].w}; }
    const f32x2 bs[4] = {(f32x2){ci.bias[0].x, ci.bias[0].y}, (f32x2){ci.bias[0].z, ci.bias[0].w}, (f32x2){ci.bias[1].x, ci.bias[1].y}, (f32x2){ci.bias[1].z, ci.bias[1].w}};
#pragma unroll
    for (int i = 0; i < 8; ++i)
#pragma unroll
        for (int q = 0; q < 4; ++q) yy[i][q] = bs[q];
#pragma unroll
    for (int r = 0; r < 11; ++r) { f32x2 x[4];
        const bool zero = (r < 3) && (t0 - 3 + r < 0);
#pragma unroll
        for (int q = 0; q < 4; ++q) { const unsigned wd = zero ? 0u : ci.row[r][q]; x[q] = (f32x2){bflo(wd), bfhi(wd)}; }
#pragma unroll
        for (int j = 0; j < 4; ++j) { const int i = r - j;
            if (i >= 0 && i < 8) {
#pragma unroll
                for (int q = 0; q < 4; ++q) yy[i][q] += w[j][q] * x[q]; } } }
#pragma unroll
    for (int i = 0; i < 8; ++i)
#pragma unroll
        for (int q = 0; q < 4; ++q) { const f32x2 v = yy[i][q], a = v * -1.4426950408889634f; f32x2 e; e.x = __builtin_amdgcn_exp2f(a.x); e.y = __builtin_amdgcn_exp2f(a.y);
            const f32x2 d = e + 1.0f; f32x2 rc; rc.x = __builtin_amdgcn_rcpf(d.x); rc.y = __builtin_amdgcn_rcpf(d.y); const f32x2 o = v * rc; y[i][2 * q] = o.x; y[i][2 * q + 1] = o.y; }
}
DI void vt_store8(LAS uchar* img, int d0, int s0, const u32x4 (&row)[8]) {
#pragma unroll
    for (int wd = 0; wd < 4; ++wd) { u32x4 ev, od;
        unsigned a[8];
#pragma unroll
        for (int i = 0; i < 8; ++i) a[i] = row[i][wd];
        ev.x = (a[0] & 0xffffu) | (a[1] << 16); ev.y = (a[2] & 0xffffu) | (a[3] << 16); ev.z = (a[4] & 0xffffu) | (a[5] << 16); ev.w = (a[6] & 0xffffu) | (a[7] << 16);
        od.x = (a[0] >> 16) | (a[1] & 0xffff0000u); od.y = (a[2] >> 16) | (a[3] & 0xffff0000u); od.z = (a[4] >> 16) | (a[5] & 0xffff0000u); od.w = (a[6] >> 16) | (a[7] & 0xffff0000u);
        *(LAS u32x4*)(img + (d0 + 2 * wd) * TSTR + s0 * 2) = ev; *(LAS u32x4*)(img + (d0 + 2 * wd + 1) * TSTR + s0 * 2) = od; }
}
DI void vt_aug_rows(LAS uchar* img, int tid) {
    if (tid < 256) { const int rr = tid >> 4, s8 = (tid & 15) * 8; const unsigned v = rr == 0 ? 0x3F803F80u : 0u; u32x4 w; w.x = v; w.y = v; w.z = v; w.w = v;
        *(LAS u32x4*)(img + (128 + rr) * TSTR + s8 * 2) = w; }
}

DI void mlstm_u_item(const Params& p, LAS uchar* lds, int item) {
    const int tid = threadIdx.x, wid = tid >> 6, lane = tid & 63, r = lane & 15, quad = lane >> 4;
    const int c = item & 63, bh = item >> 6, b = bh >> 2, h = bh & 3;
    const bf16_t* proj = (const bf16_t*)(p.ws + WS_PROJ); const float* gates = (const float*)(p.ws + WS_GATES); const float2* FM = (const float2*)(p.ws + WS_FM) + (size_t)bh * SEQ;
    LAS float* wks = (LAS float*)(lds + ML_AS);
    __syncthreads();
    if (tid < 256) {
        const int g8 = (tid & 15) * 8, s0 = (tid >> 4) * 8, t0 = c * CH + s0;
        ConvIn ci; conv_issue(p, proj, b, t0, C_MK + h * 128 + g8, 512 + h * 128 + g8, ci);
        if (tid < 128) { const int t = c * CH + tid; const float2 fe = FM[c * CH + CH - 1], fs = FM[t];
            wks[tid] = __expf(fe.x - fs.x + gates[(size_t)(b * SEQ + t) * 8 + h] - fe.y) * 0.08838834764831845f; }
        vt_aug_rows(lds + ML_V, tid);
        __syncthreads();
        float y[8][8]; conv_compute(ci, t0, y);
        const f32x4 wa = *(const LAS f32x4*)(wks + s0), wb = *(const LAS f32x4*)(wks + s0 + 4);
        const float wk[8] = {wa[0], wa[1], wa[2], wa[3], wb[0], wb[1], wb[2], wb[3]};
#pragma unroll
        for (int e = 0; e < 8; ++e) { float f[8];
#pragma unroll
            for (int i = 0; i < 8; ++i) f[i] = y[i][e] * wk[i];
            *(LAS u32x4*)(lds + ML_K + (g8 + e) * TSTR + s0 * 2) = pack8(f); }
    } else {
        const int vt = tid - 256, d8 = (vt & 15) * 8, s0 = (vt >> 4) * 8, t0 = c * CH + s0;
        u32x4 row[8];
#pragma unroll
        for (int i = 0; i < 8; ++i) row[i] = *(const u32x4*)(proj + (size_t)(b * SEQ + t0 + i) * NPJ + C_MV + h * 128 + d8);
        __syncthreads();
        vt_store8(lds + ML_V, d8, s0, row);
    }
    __syncthreads();
    f32x4 acc[9];
#pragma unroll
    for (int mt = 0; mt < 9; ++mt) acc[mt] = (f32x4){0.f, 0.f, 0.f, 0.f};
#pragma unroll
    for (int ks = 0; ks < 4; ++ks) { const bf16x8 bk = *(const LAS bf16x8*)(lds + ML_K + (16 * wid + r) * TSTR + ks * 64 + quad * 16);
#pragma unroll
        for (int mt = 0; mt < 9; ++mt) { const bf16x8 av = *(const LAS bf16x8*)(lds + ML_V + (16 * mt + r) * TSTR + ks * 64 + quad * 16); acc[mt] = mfma16(av, bk, acc[mt]); } }
    bf16_t* U = (bf16_t*)(p.ws + WS_UST) + (size_t)item * USZ;
#pragma unroll
    for (int mt = 0; mt < 9; ++mt)
#pragma unroll
        for (int v = 0; v < 4; ++v) { const int dv = 16 * mt + 4 * quad + v; if (dv <= 128) U[dv * 128 + 16 * wid + r] = f2bf(acc[mt][v]); }
}

DI void sample_outproj(const Params& p, int unit) {
    const int lane = threadIdx.x & 63, wid = threadIdx.x >> 6, r = lane & 15, quad = lane >> 4;
    const int m0 = (unit >> 4) * 32 + (wid >> 2) * 16, n0 = (unit & 15) * 64 + (wid & 3) * 16;
    const bf16_t* A = (const bf16_t*)(p.ws + WS_WTOUT) + (size_t)(n0 + r) * DM + 8 * quad;
    const bf16_t* B = (const bf16_t*)(p.ws + WS_MIXED) + (size_t)(NTP + m0 + r) * DM + 8 * quad;
    f32x4 acc0 = {0.f, 0.f, 0.f, 0.f}, acc1 = {0.f, 0.f, 0.f, 0.f};
    const f32x4 xres = *(const f32x4*)(p.x_s + (size_t)(m0 + r) * DM + n0 + 4 * quad);
#pragma unroll
    for (int hb = 0; hb < 4; ++hb) { bf16x8 af[8], bfr[8];
#pragma unroll
        for (int ks = 0; ks < 8; ++ks) { af[ks] = *(const bf16x8*)(A + (hb * 8 + ks) * 32); bfr[ks] = *(const bf16x8*)(B + (hb * 8 + ks) * 32); }
#pragma unroll
        for (int ks = 0; ks < 8; ks += 2) { acc0 = mfma16(af[ks], bfr[ks], acc0); acc1 = mfma16(af[ks + 1], bfr[ks + 1], acc1); } }
    const size_t o = (size_t)(m0 + r) * DM + n0 + 4 * quad;
    *(f32x4*)(p.out + O_Y + (size_t)NTP * DM + o) = acc0 + acc1 + xres;
}
DI void mlstm_scan(const Params& p, LAS uchar* lds) {
    const int tid = threadIdx.x, nb = gridDim.x, bid = blockIdx.x;
    const bf16_t* UST = (const bf16_t*)(p.ws + WS_UST); bf16_t* SBF = (bf16_t*)(p.ws + WS_SB);
    LAS float* dcs = (LAS float*)lds;
    for (int it = nb - 1 - bid; it < 256; it += nb) sample_outproj(p, it);
    const int per = (8 * USZ + nb - 1) / nb, base = bid * per;
    const int lim = (base + per < 8 * USZ) ? base + per : 8 * USZ;
    const int eA = base + tid, eB = base + 512 + tid; const bool hasA = eA < lim, hasB = (tid < 64) && (eB < lim);
    const int ea = hasA ? eA : 0, eb2 = hasB ? eB : 0;
    const int bhA = ea / USZ, idxA = ea - bhA * USZ, bhB = eb2 / USZ, idxB = eb2 - bhB * USZ;
    const unsigned offA = (unsigned)(bhA * NCH * USZ + idxA), offB = (unsigned)(bhB * NCH * USZ + idxB);
    float ua[64];
#pragma unroll
    for (int j = 0; j < 64; ++j) ua[j] = __uint_as_float((unsigned)(UST + (size_t)j * USZ)[offA] << 16);
    __syncthreads();
    { const int bh = tid >> 6, c = tid & 63; const float2* FM = (const float2*)(p.ws + WS_FM) + (size_t)bh * SEQ;
      const float2 fe = FM[c * CH + CH - 1]; float2 pv = make_float2(0.f, 0.f); if (c > 0) pv = FM[c * CH - 1];
      dcs[tid] = __expf(fe.x - pv.x + pv.y - fe.y);
      if (bid == 0 && c == 63) p.out[O_MP + bh] = fe.y; }
    __syncthreads();
    if (hasA) { float SA = 0.f;
#pragma unroll
        for (int j = 0; j < 64; ++j) { (SBF + (size_t)j * USZ)[offA] = f2bf(SA); SA = dcs[bhA * 64 + j] * SA + ua[j]; }
        if (idxA < 16384) { const int dv = idxA >> 7, dk = idxA & 127; p.out[O_CP + (size_t)bhA * 16384 + dk * 128 + dv] = SA; } else p.out[O_NP + bhA * 128 + idxA - 16384] = SA; }
    if (tid < 64) {
        if (hasB) { float SB = 0.f;
#pragma unroll 1
            for (int c0 = 0; c0 < 64; c0 += 32) { float ub[32]; const bf16_t* Ub = UST + (size_t)c0 * USZ; const LAS float* db = dcs + bhB * 64 + c0;
#pragma unroll
                for (int j = 0; j < 32; ++j) ub[j] = __uint_as_float((unsigned)(Ub + (size_t)j * USZ)[offB] << 16);
#pragma unroll
                for (int j = 0; j < 32; ++j) { (SBF + (size_t)(c0 + j) * USZ)[offB] = f2bf(SB); SB = db[j] * SB + ub[j]; } }
            if (idxB < 16384) { const int dv = idxB >> 7, dk = idxB & 127; p.out[O_CP + (size_t)bhB * 16384 + dk * 128 + dv] = SB; } else p.out[O_NP + bhB * 128 + idxB - 16384] = SB; } }
}

DI void mlstm_out_item(const Params& p, LAS uchar* lds, int item) {
    const int tid = threadIdx.x, wid = tid >> 6, lane = tid & 63, r = lane & 15, quad = lane >> 4;
    const int c = item & 63, bh = item >> 6, b = bh >> 2, h = bh & 3;
    const bf16_t* proj = (const bf16_t*)(p.ws + WS_PROJ); const float* gates = (const float*)(p.ws + WS_GATES); const float2* FM = (const float2*)(p.ws + WS_FM) + (size_t)bh * SEQ;
    __syncthreads();
    {
        const bf16_t* St = (const bf16_t*)(p.ws + WS_SB) + (size_t)item * USZ;
        u32x4 sv[5];
#pragma unroll
        for (int k = 0; k < 5; ++k) { const int u = tid + 512 * k, dv = u >> 4, d8 = (u & 15) * 8; const int dvc = dv <= 128 ? dv : 128;
            sv[k] = *(const u32x4*)(St + dvc * 128 + d8); }
        const int isk = (tid >> 4) & 1, g8 = (tid & 15) * 8, s0 = (tid >> 5) * 8, t0 = c * CH + s0;
        ConvIn ci; conv_issue(p, proj, b, t0, (isk ? C_MK : C_MQ) + h * 128 + g8, isk * 512 + h * 128 + g8, ci);
        const int vd8 = (tid & 15) * 8, vs0 = (tid >> 4) * 4;
        u32x4 vrow[4];
#pragma unroll
        for (int i = 0; i < 4; ++i) vrow[i] = *(const u32x4*)(proj + (size_t)(b * SEQ + c * CH + vs0 + i) * NPJ + C_MV + h * 128 + vd8);
        if (tid < 128) { const int t = c * CH + tid; ((LAS float*)(lds + ML_AS))[tid] = gates[(size_t)(b * SEQ + t) * 8 + h] - FM[t].x; }
        vt_aug_rows(lds + ML_V, tid);
#pragma unroll
        for (int k = 0; k < 5; ++k) { const int u = tid + 512 * k, dv = u >> 4, d8 = (u & 15) * 8;
            if (u < 144 * 16) { u32x4 w = sv[k]; if (dv > 128) { w.x = 0u; w.y = 0u; w.z = 0u; w.w = 0u; }
                *(LAS u32x4*)(lds + ML_S + dv * TSTR + d8 * 2) = w; } }
        float y[8][8]; conv_compute(ci, t0, y);
#pragma unroll
        for (int i = 0; i < 8; ++i) { float f[8];
#pragma unroll
            for (int e = 0; e < 8; ++e) f[e] = isk ? y[i][e] * 0.08838834764831845f : y[i][e];
            *(LAS u32x4*)(lds + (isk ? ML_K : ML_Q) + (s0 + i) * TSTR + g8 * 2) = pack8(f); }
#pragma unroll
        for (int wd = 0; wd < 4; ++wd) { const unsigned a0 = vrow[0][wd], a1 = vrow[1][wd], a2 = vrow[2][wd], a3 = vrow[3][wd]; u32x2 ev, od;
            ev.x = (a0 & 0xffffu) | (a1 << 16); ev.y = (a2 & 0xffffu) | (a3 << 16); od.x = (a0 >> 16) | (a1 & 0xffff0000u); od.y = (a2 >> 16) | (a3 & 0xffff0000u);
            *(LAS u32x2*)(lds + ML_V + (vd8 + 2 * wd) * TSTR + vs0 * 2) = ev; *(LAS u32x2*)(lds + ML_V + (vd8 + 2 * wd + 1) * TSTR + vs0 * 2) = od; }
    }
    const int ti = 16 * wid + r, t = c * CH + ti; const float2 ft = FM[t]; float2 f0 = make_float2(0.f, 0.f); if (c > 0) f0 = FM[c * CH - 1];
    const bf16_t* rowp = proj + (size_t)(b * SEQ + t) * NPJ; bf16_t* mixed = (bf16_t*)(p.ws + WS_MIXED) + (size_t)(b * SEQ + t) * DM + 512 + h * 128;
    u32x2 gws[8]; float4 nws[8];
#pragma unroll
    for (int mt = 0; mt < 8; ++mt) { const int dv = 16 * mt + 4 * quad; gws[mt] = *(const u32x2*)(rowp + C_G + h * 128 + dv); nws[mt] = *(const float4*)(p.mhw + h * 128 + dv); }
    __syncthreads();
    bf16x8 qf[4];
#pragma unroll
    for (int ks = 0; ks < 4; ++ks) qf[ks] = *(const LAS bf16x8*)(lds + ML_Q + (16 * wid + r) * TSTR + ks * 64 + quad * 16);
    const float winter = __expf(ft.x - f0.x + f0.y - ft.y), bt = ft.x - ft.y;
    f32x4 acc[9];
#pragma unroll
    for (int mt = 0; mt < 9; ++mt) acc[mt] = (f32x4){0.f, 0.f, 0.f, 0.f};
#pragma unroll
    for (int ks = 0; ks < 4; ++ks)
#pragma unroll
        for (int mt = 0; mt < 9; ++mt) { const bf16x8 a = *(const LAS bf16x8*)(lds + ML_S + (16 * mt + r) * TSTR + ks * 64 + quad * 16); acc[mt] = mfma16(a, qf[ks], acc[mt]); }
#pragma unroll
    for (int mt = 0; mt < 9; ++mt) acc[mt] *= winter;
    const LAS float* as = (const LAS float*)(lds + ML_AS);
    for (int sp = 0; sp <= (wid >> 1); ++sp) {
        u32x4 pw;
#pragma unroll
        for (int half = 0; half < 2; ++half) { const int st = 2 * sp + half; f32x4 c4 = {0.f, 0.f, 0.f, 0.f};
            if (st <= wid) {
#pragma unroll
                for (int ks = 0; ks < 4; ++ks) { const bf16x8 a = *(const LAS bf16x8*)(lds + ML_K + (16 * st + r) * TSTR + ks * 64 + quad * 16); c4 = mfma16(a, qf[ks], c4); }
                const f32x4 av = *(const LAS f32x4*)(as + 16 * st + 4 * quad);
#pragma unroll
                for (int v = 0; v < 4; ++v) { const int si = 16 * st + 4 * quad + v; c4[v] = (si <= ti) ? c4[v] * __expf(bt + av[v]) : 0.f; } }
            if (half == 0) { pw.x = pk2(c4[0], c4[1]); pw.y = pk2(c4[2], c4[3]); } else { pw.z = pk2(c4[0], c4[1]); pw.w = pk2(c4[2], c4[3]); } }
        const bf16x8 pb = __builtin_bit_cast(bf16x8, pw);
#pragma unroll
        for (int mt = 0; mt < 9; ++mt) { const LAS uchar* vp = lds + ML_V + (16 * mt + r) * TSTR + (32 * sp + 4 * quad) * 2;
            u32x4 aw; const u32x2 lo = *(const LAS u32x2*)vp, hi = *(const LAS u32x2*)(vp + 32); aw.x = lo.x; aw.y = lo.y; aw.z = hi.x; aw.w = hi.y;
            acc[mt] = mfma16(__builtin_bit_cast(bf16x8, aw), pb, acc[mt]); } }
    const float den = __shfl(acc[8][0], r);
    const float inv = __builtin_amdgcn_rcpf(fmaxf(fabsf(den), __expf(-ft.y)));
    float ss = 0.f;
#pragma unroll
    for (int mt = 0; mt < 8; ++mt)
#pragma unroll
        for (int v = 0; v < 4; ++v) { acc[mt][v] *= inv; ss += acc[mt][v] * acc[mt][v]; }
    ss += __shfl_xor(ss, 16); ss += __shfl_xor(ss, 32);
    const float rstd = rsqrtf(ss * (1.0f / 128) + 1e-6f);
#pragma unroll
    for (int mt = 0; mt < 8; ++mt) { const int dv = 16 * mt + 4 * quad; const u32x2 gw = gws[mt];
        const float4 nw = nws[mt];
        const f32x2 h0 = (f32x2){acc[mt][0], acc[mt][1]}, h1 = (f32x2){acc[mt][2], acc[mt][3]};
        const f32x2 y0 = h0 * rstd * (f32x2){nw.x, nw.y} * (f32x2){bflo(gw.x), bfhi(gw.x)}, y1 = h1 * rstd * (f32x2){nw.z, nw.w} * (f32x2){bflo(gw.y), bfhi(gw.y)};
        u32x2 w; w.x = pk2(y0.x, y0.y); w.y = pk2(y1.x, y1.y);
        *(u32x2*)(mixed + dv) = w; }
}

DI void mlstm_sample_item(const Params& p, LAS uchar* lds, int item) {
    const int tid = threadIdx.x, wid = tid >> 6, lane = tid & 63;
    const int h = item & 3, b = item >> 2;
    const bf16_t* proj = (const bf16_t*)(p.ws + WS_PROJ); const float* gates = (const float*)(p.ws + WS_GATES);
    LAS float* qs = (LAS float*)lds;
    LAS float* ks = qs + 512;
    LAS float* vs = ks + 512;
    LAS float* red = vs + 512;
    LAS float* dred = red + 2048;
    LAS float* sred = dred + 8;
    __syncthreads();
    const int dv = tid & 127, dkq = tid >> 7;
    const float* S0 = p.sC + ((size_t)(b * 4 + h) * 128 + dkq * 32) * 128 + dv;
    float S[32];
#pragma unroll
    for (int i = 0; i < 32; ++i) S[i] = S0[(size_t)i * 128];
    float nn = 0.f; if (tid < 128) nn = p.sn[(size_t)(b * 4 + h) * 128 + tid];
    const bf16_t* rowf = proj + (size_t)(NTP + b * 4 + (tid >> 7)) * NPJ;
    const unsigned ggr = rowf[C_G + h * 128 + dv]; const float mhr = p.mhw[h * 128 + dv];
    float cvs[2];
#pragma unroll
    for (int i = tid; i < 1024; i += 512) { const int t = i >> 8, lc = i & 255, ch = (lc < 128 ? 0 : 512) + h * 128 + (lc & 127);
        float y = p.conv_b[ch]; float xx[4], ww[4];
#pragma unroll
        for (int j = 0; j < 4; ++j) { const int tt = t - 3 + j; ww[j] = p.conv_w[j * 1024 + ch];
            if (tt < 0) xx[j] = p.sconv[(size_t)(b * 3 + 3 + tt) * 1024 + ch];
            else xx[j] = __uint_as_float((unsigned)proj[(size_t)(NTP + b * 4 + tt) * NPJ + C_MQ + ch] << 16); }
#pragma unroll
        for (int j = 0; j < 4; ++j) y += ww[j] * xx[j];
        cvs[i >> 9] = xx[3];
        y = silu(y);
        if (lc < 128) qs[t * 128 + lc] = y; else ks[t * 128 + (lc - 128)] = y * 0.08838834764831845f; }
    { const int t = tid >> 7, dv = tid & 127; vs[tid] = __uint_as_float((unsigned)proj[(size_t)(NTP + b * 4 + t) * NPJ + C_MV + h * 128 + dv] << 16); }
    float mt_[4], fd[4], iw[4];
    { float mprev = p.sm[b * 4 + h];
#pragma unroll
      for (int t = 0; t < 4; ++t) { const float* g = gates + (size_t)(NTP + b * 4 + t) * 8; const float li = g[h], lf = g[4 + h];
          const float m = fmaxf(lf + mprev, li); fd[t] = __expf(lf + mprev - m); iw[t] = __expf(li - m); mt_[t] = m; mprev = m; } }
    __syncthreads();
#pragma unroll
    for (int t = 0; t < 4; ++t) { const float vt = vs[t * 128 + dv] * iw[t]; float part = 0.f;
        f32x2 part2 = {0.f, 0.f};
#pragma unroll
        for (int i = 0; i < 32; i += 4) { const f32x4 k4 = *(const LAS f32x4*)(ks + t * 128 + dkq * 32 + i), q4 = *(const LAS f32x4*)(qs + t * 128 + dkq * 32 + i);
            f32x2 s01 = (f32x2){S[i], S[i + 1]}, s23 = (f32x2){S[i + 2], S[i + 3]};
            s01 = s01 * fd[t] + (f32x2){k4[0], k4[1]} * vt; s23 = s23 * fd[t] + (f32x2){k4[2], k4[3]} * vt;
            part2 += (f32x2){q4[0], q4[1]} * s01; part2 += (f32x2){q4[2], q4[3]} * s23;
            S[i] = s01.x; S[i + 1] = s01.y; S[i + 2] = s23.x; S[i + 3] = s23.y; }
        part = part2.x + part2.y;
        red[(dkq * 4 + t) * 128 + dv] = part;
        if (tid < 128) { nn = fd[t] * nn + iw[t] * ks[t * 128 + tid]; const float dp = wsum(qs[t * 128 + tid] * nn); if (lane == 0) dred[t * 2 + wid] = dp; } }
    float* Sout = p.out + O_CS + ((size_t)(b * 4 + h) * 128 + dkq * 32) * 128 + dv;
#pragma unroll
    for (int i = 0; i < 32; ++i) Sout[(size_t)i * 128] = S[i];
#pragma unroll
    for (int q = 0; q < 2; ++q) { const int i = tid + 512 * q, t = i >> 8, lc = i & 255, ch = (lc < 128 ? 0 : 512) + h * 128 + (lc & 127); if (t >= 1) p.out[O_CONVS + (size_t)(b * 3 + t - 1) * 1024 + ch] = cvs[q]; }
    if (tid < 128) p.out[O_NS + (size_t)(b * 4 + h) * 128 + tid] = nn;
    if (tid == 0) p.out[O_MS + b * 4 + h] = mt_[3];
    __syncthreads();
    { const int t = tid >> 7; const float num = red[(0 * 4 + t) * 128 + dv] + red[(1 * 4 + t) * 128 + dv] + red[(2 * 4 + t) * 128 + dv] + red[(3 * 4 + t) * 128 + dv];
      const float den = dred[t * 2] + dred[t * 2 + 1];
      const float mtv = t == 0 ? mt_[0] : t == 1 ? mt_[1] : t == 2 ? mt_[2] : mt_[3];
      const float hv = num / fmaxf(fabsf(den), __expf(-mtv));
      const float sq = wsum(hv * hv); if (lane == 0) sred[t * 2 + (wid & 1)] = sq;
      __syncthreads();
      const float rstd = rsqrtf((sred[t * 2] + sred[t * 2 + 1]) * (1.0f / 128) + 1e-6f);
      const size_t row = (size_t)(NTP + b * 4 + t);
      ((bf16_t*)(p.ws + WS_MIXED))[row * DM + 512 + h * 128 + dv] = f2bf(hv * rstd * mhr * __uint_as_float(ggr << 16)); }
}

DI void phase2(const Params& p, LAS uchar* lds) {
    const int nb = gridDim.x, bid = blockIdx.x, tid = threadIdx.x;
#ifndef REP_AP
#define REP_AP 1
#define REP_MU 1
#define REP_AS 1
#define REP_MS 1
#endif
    const bool late = ((bid >> 3) & 1) == 0;
    if (!late) { for (int it = bid; it < 256; it += nb) attn_sample_item(p, lds, it);
                 for (int it = bid; it < 512; it += nb) mlstm_sample_item(p, lds, it); }
    for (int it = bid; it < 256; it += nb) attn_prompt_item(p, lds, it);
    for (int it = bid; it < 512; it += nb) mlstm_u_item(p, lds, it);
    if (late) { for (int it = bid; it < 256; it += nb) attn_sample_item(p, lds, it);
                for (int it = bid; it < 512; it += nb) mlstm_sample_item(p, lds, it); }
    for (int i = bid * 512 + tid; i < 6144; i += nb * 512) { const int ch = i & 1023, rr = (i >> 10) % 3, b = i / 3072;
        p.out[O_CONVP + i] = __uint_as_float((unsigned)((const bf16_t*)(p.ws + WS_PROJ))[(size_t)(b * SEQ + SEQ - 3 + rr) * NPJ + C_MQ + ch] << 16); }
}
DI void phase4(const Params& p, LAS uchar* lds) {
    const int nb = gridDim.x, bid = blockIdx.x;
    for (int it = bid; it < 512; it += nb) mlstm_out_item(p, lds, it);
}

__global__ __launch_bounds__(512, 2) void hymba_mega(Params p, int ph_lo, int ph_hi) {
    extern __shared__ __attribute__((aligned(16))) unsigned char shm[];
    LAS uchar* lds = (LAS uchar*)shm;
    volatile LAS unsigned* st = (volatile LAS unsigned*)(lds + LDS_MAIN);
    if (threadIdx.x == 0) { st[0] = 0u; st[1] = 0u; }
    __syncthreads();
    const XcdBarrier xb = xcd_barrier_post((unsigned*)(p.ws + WS_BAR), st);
#ifdef PROBE_K
#define STAMP(i) ts[i] = wall_clock64();
    unsigned long long ts[7];
#else
#define STAMP(i)
#endif
#define RUNPH(n, call) if (ph_lo <= n && n < ph_hi) { if (ph_lo < n) xcd_barrier(xb); STAMP(n) call; }
    RUNPH(0, phase0(p, lds)) RUNPH(1, phase1(p, lds)) RUNPH(2, phase2(p, lds)) RUNPH(3, mlstm_scan(p, lds)) RUNPH(4, phase4(p, lds)) RUNPH(5, phase5(p, lds))
#ifdef PROBE_K
    xcd_barrier(xb); STAMP(6)
    if (blockIdx.x == 0 && threadIdx.x == 0) { const unsigned long long dt = (ts[PROBE_K + 1] - ts[PROBE_K]) * 4ull; while (wall_clock64() - ts[6] < dt) __builtin_amdgcn_s_sleep(8); }
#endif
}

#ifndef N_LAUNCHES
#define N_LAUNCHES 1
#endif
extern "C" void kernel_launch(void* const* d_in, const int* in_sizes, int n_in, void* d_out, int out_size, void* d_ws, size_t ws_size, hipStream_t stream) {
    static int grid = 0;
    if (grid == 0) {
        int dev = 0, cus = 0, per_cu = 0;
        hipGetDevice(&dev); hipDeviceGetAttribute(&cus, hipDeviceAttributeMultiprocessorCount, dev);
        if (hipFuncSetAttribute((const void*)hymba_mega, hipFuncAttributeMaxDynamicSharedMemorySize, LDS_BYTES) != hipSuccess) { fprintf(stderr, "hipFuncSetAttribute failed\n"); }
        if (hipOccupancyMaxActiveBlocksPerMultiprocessor(&per_cu, (const void*)hymba_mega, 512, LDS_BYTES) != hipSuccess || per_cu < 1) { fprintf(stderr, "occupancy query: %d\n", per_cu); per_cu = 1; }
        (void)hipGetLastError();
        grid = cus * per_cu;
        if (ws_size < WS_END || n_in != 18) { fprintf(stderr, "bad ws/n_in\n"); grid = -1; }
    }
    if (grid < 0) return;
    if (hipMemsetAsync((char*)d_ws + WS_BAR, 0, XCD_BAR_WORDS * sizeof(unsigned), stream) != hipSuccess) { fprintf(stderr, "memset failed\n"); return; }
    Params p{};
    p.x_p = (const float*)d_in[0]; p.x_s = (const float*)d_in[1]; p.ck = (const float*)d_in[2]; p.cv = (const float*)d_in[3]; p.sconv = (const float*)d_in[4];
    p.sC = (const float*)d_in[5]; p.sn = (const float*)d_in[6]; p.sm = (const float*)d_in[7]; p.norm_w = (const float*)d_in[8]; p.w_in = (const float*)d_in[9];
    p.b_gates = (const float*)d_in[10]; p.conv_w = (const float*)d_in[11]; p.conv_b = (const float*)d_in[12]; p.qnw = (const float*)d_in[13]; p.knw = (const float*)d_in[14];
    p.sinks = (const float*)d_in[15]; p.mhw = (const float*)d_in[16]; p.w_out = (const float*)d_in[17];
    p.out = (float*)d_out; p.ws = (uchar*)d_ws;
    if (N_LAUNCHES == 1) {
#ifdef PLAIN_LAUNCH
        hipLaunchKernelGGL(hymba_mega, dim3(grid), dim3(512), LDS_BYTES, stream, p, 0, 6);
#else
        int lo = 0, hi = 6; void* args[] = {&p, &lo, &hi};
        hipError_t e = hipLaunchCooperativeKernel((const void*)hymba_mega, dim3(grid), dim3(512), args, LDS_BYTES, stream);
        if (e != hipSuccess) fprintf(stderr, "cooperative launch failed: %s (grid %d)\n", hipGetErrorString(e), grid);
#endif
    } else {
#ifndef PHLIST
#define PHLIST {0, 1, 2, 3, 4, 5}
#endif
        const int phl[] = PHLIST;
        for (int i = 0; i < (int)(sizeof(phl) / sizeof(int)); ++i) hipLaunchKernelGGL(hymba_mega, dim3(grid), dim3(512), LDS_BYTES, stream, p, phl[i], phl[i] + 1);
    }
}
```

```cpp
#define N_LAUNCHES 1
#include <hip/hip_runtime.h>
#include <hip/hip_cooperative_groups.h>
#include <cstdio>
namespace cg = cooperative_groups;
#define LAS __attribute__((address_space(3)))
namespace pg8 {
#define PG8_LAS __attribute__((address_space(3)))
typedef unsigned short bf16_t;
typedef short bf16x8 __attribute__((ext_vector_type(8)));
typedef float f32x4 __attribute__((ext_vector_type(4)));
typedef unsigned u32x4 __attribute__((ext_vector_type(4)));
constexpr int BM = 256, BK = 64, HALF = 128, HTB = HALF * BK * 2  , STAGE_BYTES = 8 * HTB, NXCD = 8, WGM = 8;

__host__ __device__ __forceinline__ int lds_byte(int r, int c) { const int st = (r >> 4) * 2 + (c >> 5), rr = r & 15, cc = c & 31, ob = rr * 64 + cc * 2; return st * 1024 + (ob ^ (((ob >> 9) & 1) << 5)); }
__host__ __device__ __forceinline__ void stage_rc(int b, int& R, int& C) { const int st = b / 1024, sb = b % 1024, swz = sb ^ (((sb >> 9) & 1) << 5); R = (st >> 1) * 16 + swz / 64; C = (st & 1) * 32 + (swz % 64) / 2; }
__host__ __device__ __forceinline__ int perm32(int rho) { const int n = rho >> 4, i = rho & 15; return 8 * (i >> 2) + 4 * n + (i & 3); }

struct Unit { int pm, pn; };
struct Gemm { const bf16_t* A; const bf16_t* Bt; int M, N, K; };

struct StaticOrder {
    int nM, nN, nwg, G, c;
    __host__ __device__ void init(int M, int N, int G_, int c_) { nM = M / BM; nN = N / BM; nwg = nM * nN; G = G_; c = c_; }
    __host__ __device__ bool next(int i, Unit& u) const {
        const long L = (long)i * G + c; if (L >= nwg) return false;
        int wgid = (int)L; { const int q = nwg / NXCD, r = nwg % NXCD, xcd = wgid % NXCD, off = wgid / NXCD; wgid = (xcd < r ? xcd * (q + 1) : r * (q + 1) + (xcd - r) * q) + off; }
        const int nig = WGM * nN, gid = wgid / nig, fm = gid * WGM, gsz = (nM - fm) < WGM ? (nM - fm) : WGM;
        u.pm = fm + ((wgid % nig) % gsz); u.pn = (wgid % nig) / gsz; return true;
    }
    __device__ __forceinline__ void a_ready(const Unit&) const {}
    __device__ __forceinline__ void done(const Unit&) const {}
};
__device__ __forceinline__ unsigned cvt_pk_bf16(float lo, float hi) { unsigned r; asm volatile("v_cvt_pk_bf16_f32 %0, %1, %2" : "=v"(r) : "v"(lo), "v"(hi)); return r; }
template <class Epi, class Sched, bool STAMP = false>
__device__ __forceinline__ void gemm_phase(PG8_LAS unsigned char* lds, const Gemm g, const Sched& S, const Epi& E, unsigned long long* stamps) {
    const int tid = threadIdx.x, wid = __builtin_amdgcn_readfirstlane(tid >> 6), lane = tid & 63, wr = wid >> 2, wc = wid & 3, fr = lane & 15, fq = lane >> 4;
    const int K = g.K, nt = K / BK;
    int ts_lo = 0, ts_hi = 0, nts = 0; const unsigned long long rt_entry = STAMP ? (unsigned long long)wall_clock64() : 0ull;
#define PG8_STAMP() do { if (STAMP && wid == 0 && nts < 64) { const unsigned long long _c = (unsigned long long)clock64(); \
        ts_lo = (lane == nts) ? (int)(unsigned)_c : ts_lo; ts_hi = (lane == nts) ? (int)(unsigned)(_c >> 32) : ts_hi; ++nts; } } while (0)
    PG8_STAMP();
    unsigned voffA[2], voffB[2];
#pragma unroll
    for (int i = 0; i < 2; ++i) { int R, C; stage_rc(tid * 16 + i * 8192, R, C); const int Rb = Epi::PERM ? ((R & ~31) + perm32(R & 31)) : R;
        voffA[i] = (unsigned)(R * K + C) * 2u; voffB[i] = (unsigned)(Rb * K + C) * 2u; }
    const size_t kstep = (size_t)(BK * 2);
    const size_t hstep = (size_t)HALF * K * 2;
    const size_t tstep = 2 * hstep;
    const unsigned ldsw = (unsigned)wid * 1024u;
    const int aoff = lds_byte(wr * 64 + fr, fq * 8), boff = lds_byte(wc * 32 + fr, fq * 8);
#define PG8_SA(b, h) (((b) * 2 + (h)) * HTB)
#define PG8_SB(b, h) ((4 + (b) * 2 + (h)) * HTB)
#define PG8_STAGE(bufoff, gbase, voff) do { _Pragma("unroll") for (int _i = 0; _i < 2; ++_i) \
        __builtin_amdgcn_global_load_lds((const unsigned*)((const char*)(gbase) + (voff)[_i]), (PG8_LAS unsigned*)(lds + (bufoff) + ldsw + _i * 8192), 16, 0, 0); } while (0)
#define PG8_LDA(dst, b, h) do { _Pragma("unroll") for (int m = 0; m < 4; ++m) _Pragma("unroll") for (int k = 0; k < 2; ++k) dst[m][k] = *(const PG8_LAS bf16x8*)(lds + PG8_SA(b, h) + aoff + m * 2048 + k * 1024); } while (0)
#define PG8_LDB(dst, b, h) do { _Pragma("unroll") for (int n = 0; n < 2; ++n) _Pragma("unroll") for (int k = 0; k < 2; ++k) dst[n][k] = *(const PG8_LAS bf16x8*)(lds + PG8_SB(b, h) + boff + n * 2048 + k * 1024); } while (0)
#define PG8_MMA(ai, bj, At, Bt) do { __builtin_amdgcn_s_setprio(1); _Pragma("unroll") for (int m = 0; m < 4; ++m) _Pragma("unroll") for (int n = 0; n < 2; ++n) _Pragma("unroll") for (int k = 0; k < 2; ++k) \
        acc[ai][bj][m][n] = __builtin_amdgcn_mfma_f32_16x16x32_bf16(Bt[n][k], At[m][k], acc[ai][bj][m][n], 0, 0, 0); __builtin_amdgcn_s_setprio(0); } while (0)
#define PG8_WAIT_V(n) asm volatile("s_waitcnt vmcnt(" #n ")" ::: "memory")
#define PG8_WAIT_L(n) asm volatile("s_waitcnt lgkmcnt(" #n ")" ::: "memory")
#define PG8_BAR __builtin_amdgcn_s_barrier()
#define PG8_SCHED __builtin_amdgcn_sched_barrier(0)
    Unit cur, nxt; int ui = 0;
    if (!S.next(0, cur)) return;
    f32x4 acc[2][2][4][2];
#pragma unroll
    for (int a = 0; a < 2; ++a)
#pragma unroll
        for (int b = 0; b < 2; ++b)
#pragma unroll
            for (int m = 0; m < 4; ++m)
#pragma unroll
                for (int n = 0; n < 2; ++n) acc[a][b][m][n] = (f32x4){0.f, 0.f, 0.f, 0.f};
    bf16x8 At[4][2], B0[2][2], B1[2][2];
    const char* cA = (const char*)g.A + (size_t)cur.pm * tstep; const char* cB = (const char*)g.Bt + (size_t)cur.pn * tstep;
    S.a_ready(cur);
    PG8_STAGE(PG8_SB(0, 0), cB, voffB); PG8_STAGE(PG8_SA(0, 0), cA, voffA); PG8_STAGE(PG8_SB(0, 1), cB + hstep, voffB); PG8_STAGE(PG8_SA(0, 1), cA + hstep, voffA);
    if (wr == 1) PG8_BAR;
    PG8_WAIT_V(4); PG8_BAR;
    PG8_STAGE(PG8_SB(1, 0), cB + kstep, voffB); PG8_STAGE(PG8_SA(1, 0), cA + kstep, voffA); PG8_STAGE(PG8_SB(1, 1), cB + hstep + kstep, voffB);
    PG8_WAIT_V(6); PG8_BAR;
    PG8_STAMP();
    for (;;) {
        const bool has_next = S.next(ui + 1, nxt);
        const char* nA = has_next ? (const char*)g.A + (size_t)nxt.pm * tstep : cA; const char* nB = has_next ? (const char*)g.Bt + (size_t)nxt.pn * tstep : cB;
        for (int t = 0; t < nt; t += 2) {
            const bool last = (t == nt - 2);
            const char* a1 = cA + (size_t)(t + 1) * kstep;
            const char* a2 = last ? nA : cA + (size_t)(t + 2) * kstep; const char* b2 = last ? nB : cB + (size_t)(t + 2) * kstep;
            const char* a3 = a2 + kstep; const char* b3 = b2 + kstep;
            if (last && has_next) S.a_ready(nxt);
            PG8_LDB(B0, 0, 0); PG8_SCHED; PG8_LDA(At, 0, 0); PG8_STAGE(PG8_SA(1, 1), a1 + hstep, voffA);
            PG8_WAIT_L(8); PG8_BAR; PG8_WAIT_L(0); PG8_MMA(0, 0, At, B0); PG8_BAR; PG8_SCHED;
            PG8_LDB(B1, 0, 1); PG8_STAGE(PG8_SB(0, 0), b2, voffB);
            PG8_BAR; PG8_WAIT_L(0); PG8_MMA(0, 1, At, B1); PG8_BAR;
            PG8_LDA(At, 0, 1); PG8_STAGE(PG8_SA(0, 0), a2, voffA);
            PG8_BAR; PG8_WAIT_L(0); PG8_MMA(1, 0, At, B0); PG8_BAR; PG8_SCHED;
            PG8_STAGE(PG8_SB(0, 1), b2 + hstep, voffB);
            PG8_WAIT_V(6); PG8_BAR; PG8_MMA(1, 1, At, B1); PG8_BAR;
            PG8_LDB(B0, 1, 0); PG8_SCHED; PG8_LDA(At, 1, 0); PG8_STAGE(PG8_SA(0, 1), a2 + hstep, voffA);
            PG8_WAIT_L(8); PG8_BAR; PG8_WAIT_L(0); PG8_MMA(0, 0, At, B0); PG8_BAR; PG8_SCHED;
            PG8_LDB(B1, 1, 1); PG8_STAGE(PG8_SB(1, 0), b3, voffB);
            PG8_BAR; PG8_WAIT_L(0); PG8_MMA(0, 1, At, B1); PG8_BAR;
            PG8_LDA(At, 1, 1); PG8_STAGE(PG8_SA(1, 0), a3, voffA);
            PG8_BAR; PG8_WAIT_L(0); PG8_MMA(1, 0, At, B0); PG8_BAR; PG8_SCHED;
            PG8_STAGE(PG8_SB(1, 1), b3 + hstep, voffB);
            PG8_WAIT_V(6); PG8_BAR; PG8_MMA(1, 1, At, B1); PG8_BAR;
        }
        PG8_STAMP();
        if constexpr (!Epi::AFTER_DRAIN) { E(acc, cur, wr, wc, fr, fq); S.done(cur); }
        PG8_STAMP();
        if (!has_next) break;
#pragma unroll
        for (int a = 0; a < 2; ++a)
#pragma unroll
            for (int b = 0; b < 2; ++b)
#pragma unroll
                for (int m = 0; m < 4; ++m)
#pragma unroll
                    for (int n = 0; n < 2; ++n) acc[a][b][m][n] = (f32x4){0.f, 0.f, 0.f, 0.f};
        cur = nxt; cA = nA; cB = nB; ++ui;
    }
    PG8_WAIT_V(0);
    if (wr == 0) PG8_BAR;
    PG8_BAR;
    if constexpr (Epi::AFTER_DRAIN) { E.fused(acc, cur, wr, wc, fr, fq, lds, wid, lane); S.done(cur); }
    PG8_STAMP();
    if (STAMP && wid == 0) { stamps[lane] = lane < nts ? (((unsigned long long)(unsigned)ts_hi << 32) | (unsigned)ts_lo) : 0ull;
        if (lane == 62) stamps[62] = rt_entry; if (lane == 63) stamps[63] = (unsigned long long)wall_clock64(); }
#undef PG8_STAMP
#undef PG8_SA
#undef PG8_SB
#undef PG8_STAGE
#undef PG8_LDA
#undef PG8_LDB
#undef PG8_MMA
#undef PG8_WAIT_V
#undef PG8_WAIT_L
#undef PG8_BAR
#undef PG8_SCHED
}
}

#define XB_TMO      128
#define XB_XCNT(j)  (256  + 64 * (j))
#define XB_XSUB(j)  (1280 + 64 * (j))
#define XB_XGEN(j)  (2304 + 64 * (j))
#define XB_TOP      3328
#define XB_TOPGEN   3392
#define XCD_BAR_WORDS 3456
#define XB_SPIN_CAP (1u << 18)

__device__ __forceinline__ unsigned xb_ld(unsigned* p)              { return __hip_atomic_load(p, __ATOMIC_RELAXED, __HIP_MEMORY_SCOPE_AGENT); }
__device__ __forceinline__ unsigned xb_add(unsigned* p, unsigned v) { return __hip_atomic_fetch_add(p, v, __ATOMIC_RELAXED, __HIP_MEMORY_SCOPE_AGENT); }
__device__ __forceinline__ unsigned xb_xcc_id() { return (unsigned)__builtin_amdgcn_s_getreg((3 << 11) | 20) & 0xFu; }
#define XB_SPIN(cond, bar) do { unsigned _sp = 0; while (cond) { __builtin_amdgcn_s_sleep(1); \
    if ((++_sp & 255u) == 0u) { if (xb_ld(&(bar)[XB_TMO])) break; if (_sp > XB_SPIN_CAP) { atomicAdd(&(bar)[XB_TMO], 1u); break; } } } } while (0)

struct XcdBarrier {
    unsigned* bar; unsigned x;
    volatile LAS unsigned* st;
};

__device__ __forceinline__ XcdBarrier xcd_barrier_post(unsigned* bar, volatile LAS unsigned* st) {
    XcdBarrier b; b.bar = bar; b.x = xb_xcc_id(); b.st = st;
    if (threadIdx.x == 0) (void)xb_add(&bar[XB_XCNT(b.x)], 1u);
    return b;
}
__device__ __forceinline__ void xcd_barrier_complete(unsigned* bar, unsigned x, unsigned& nloc, unsigned& nx) {
    const unsigned G = gridDim.x * gridDim.y * gridDim.z;
    unsigned sum, cnt, mine, sp = 0u;
    for (;;) {
        sum = 0u; cnt = 0u; mine = 0u;
#pragma unroll
        for (unsigned j = 0; j < 16; ++j) { const unsigned c = xb_ld(&bar[XB_XCNT(j)]); sum += c; cnt += (c > 0u) ? 1u : 0u; mine = (j == x) ? c : mine; }
        if (sum == G) break;
        __builtin_amdgcn_s_sleep(1);
        if ((++sp & 255u) == 0u) { if (xb_ld(&bar[XB_TMO])) break; if (sp > XB_SPIN_CAP) { atomicAdd(&bar[XB_TMO], 1u); break; } }
    }
    nloc = mine > 0u ? mine : 1u; nx = cnt > 0u ? cnt : 1u;
}

__device__ __forceinline__ void xcd_barrier(const XcdBarrier& b) {
    asm volatile("s_waitcnt vmcnt(0)" ::: "memory");
    __syncthreads();
    if (threadIdx.x == 0) {
        unsigned* bar = b.bar;
        __builtin_amdgcn_s_waitcnt(0);
        unsigned nloc = b.st[0], nx = b.st[1];
        if (nloc == 0u) { xcd_barrier_complete(bar, b.x, nloc, nx); b.st[0] = nloc; b.st[1] = nx; }
        const unsigned old = xb_add(&bar[XB_XSUB(b.x)], 1u);
        const unsigned gen = old / nloc;
        if (old + 1u == (gen + 1u) * nloc) {
            __builtin_amdgcn_fence(__ATOMIC_RELEASE, "agent");
            asm volatile("s_waitcnt vmcnt(0)" ::: "memory");
            const unsigned og = xb_add(&bar[XB_TOP], 1u);
            const unsigned tg = og / nx;
            if (og + 1u == (tg + 1u) * nx) xb_add(&bar[XB_TOPGEN], 1u);
            else XB_SPIN(xb_ld(&bar[XB_TOPGEN]) == tg, bar);
            __builtin_amdgcn_fence(__ATOMIC_ACQUIRE, "agent");
            xb_add(&bar[XB_XGEN(b.x)], 1u);
            asm volatile("s_waitcnt vmcnt(0)" ::: "memory");
        } else {
            XB_SPIN(xb_ld(&bar[XB_XGEN(b.x)]) == gen, bar);
            __builtin_amdgcn_fence(__ATOMIC_ACQUIRE, "agent");
            asm volatile("s_waitcnt vmcnt(0)" ::: "memory");
        }
    }
    __syncthreads();
}

using pg8::bf16_t; using pg8::bf16x8; using pg8::f32x4; using pg8::u32x4;
#define DI __device__ __forceinline__
typedef unsigned char uchar;
typedef unsigned u32x2 __attribute__((ext_vector_type(2)));

constexpr int NTP = 16384, NTS = 512, NTOK = 16896, DM = 1024, DIN = 3848, NGE = 3840, NPJ = 3328, SEQ = 8192;
constexpr int C_AQ = 0, C_AK = 512, C_AV = 640, C_AG = 768, C_MQ = 1280, C_MK = 1792, C_MV = 2304, C_G = 2816;
constexpr int NCH = 64, CH = 128, USZ = 129 * 128;
constexpr size_t O_Y = 0, O_KWP = 17301504, O_VWP = 17334272, O_CONVP = 17367040, O_CP = 17373184, O_NP = 17504256, O_MP = 17505280,
                 O_KWS = 17505288, O_VWS = 19602440, O_CONVS = 21699592, O_CS = 22092808, O_NS = 30481416, O_MS = 30546952;
constexpr size_t WS_WTIN = 0, WS_WTOUT = 7864320, WS_H = 9961472, WS_GATES = 44564480, WS_ROPE = 45105152, WS_FM = 45637632,
                 WS_PROJ = 46161920, WS_UST = 175923200, WS_MIXED = 209739776, WS_BAR = 244342784, WS_SB = 244342784 + 16384, WS_END = WS_SB + 16908288;
constexpr int LDS_MAIN = 151552, LDS_BYTES = LDS_MAIN + 16;

struct Params {
    const float *x_p, *x_s, *ck, *cv, *sconv, *sC, *sn, *sm, *norm_w, *w_in, *b_gates, *conv_w, *conv_b, *qnw, *knw, *sinks, *mhw, *w_out;
    float* out; uchar* ws;
};

DI float bflo(unsigned w) { return __uint_as_float(w << 16); }
DI float bfhi(unsigned w) { return __uint_as_float(w & 0xffff0000u); }
DI unsigned pk2(float a, float b) { return pg8::cvt_pk_bf16(a, b); }
DI bf16_t f2bf(float f) { unsigned u = __float_as_uint(f); u += 0x7fffu + ((u >> 16) & 1u); return (bf16_t)(u >> 16); }
DI void unpack8(const u32x4 w, float (&f)[8]) { f[0] = bflo(w.x); f[1] = bfhi(w.x); f[2] = bflo(w.y); f[3] = bfhi(w.y); f[4] = bflo(w.z); f[5] = bfhi(w.z); f[6] = bflo(w.w); f[7] = bfhi(w.w); }
DI u32x4 pack8(const float (&f)[8]) { u32x4 w; w.x = pk2(f[0], f[1]); w.y = pk2(f[2], f[3]); w.z = pk2(f[4], f[5]); w.w = pk2(f[6], f[7]); return w; }
DI float wsum(float v) { for (int o = 32; o; o >>= 1) v += __shfl_xor(v, o); return v; }
DI float silu(float x) { return x * __builtin_amdgcn_rcpf(1.0f + __builtin_amdgcn_exp2f(-1.4426950408889634f * x)); }
DI float sigm(float x) { return __builtin_amdgcn_rcpf(1.0f + __builtin_amdgcn_exp2f(-1.4426950408889634f * x)); }
DI f32x4 mfma16(bf16x8 a, bf16x8 b, f32x4 c) { return __builtin_amdgcn_mfma_f32_16x16x32_bf16(a, b, c, 0, 0, 0); }

typedef float f32x2g __attribute__((ext_vector_type(2)));
DI void norm_row(const Params& p, const LAS float* wg, int row, const float4 (&xv)[4], const float4 (&nw)[4], float bgl, int lane) {
    bf16_t* H = (bf16_t*)(p.ws + WS_H); float* gates = (float*)(p.ws + WS_GATES);
    float ss = 0.f;
#pragma unroll
    for (int i = 0; i < 4; ++i) ss += xv[i].x * xv[i].x + xv[i].y * xv[i].y + xv[i].z * xv[i].z + xv[i].w * xv[i].w;
    ss = wsum(ss); const float rstd = rsqrtf(ss * (1.0f / DM) + 1e-6f);
    f32x2g g2[8];
#pragma unroll
    for (int j = 0; j < 8; ++j) g2[j] = (f32x2g){0.f, 0.f};
    u32x2 hw[4];
#pragma unroll
    for (int i = 0; i < 4; ++i) { const int d0 = i * 256 + lane * 4;
        const f32x2g ha = (f32x2g){xv[i].x, xv[i].y} * rstd * (f32x2g){nw[i].x, nw[i].y}, hb = (f32x2g){xv[i].z, xv[i].w} * rstd * (f32x2g){nw[i].z, nw[i].w};
        hw[i].x = pk2(ha.x, ha.y); hw[i].y = pk2(hb.x, hb.y);
#pragma unroll
        for (int j = 0; j < 8; ++j) { const f32x4 wv = *(const LAS f32x4*)(wg + j * 1024 + d0); g2[j] += ha * (f32x2g){wv[0], wv[1]}; g2[j] += hb * (f32x2g){wv[2], wv[3]}; } }
#pragma unroll
    for (int i = 0; i < 4; ++i) *(u32x2*)(H + (size_t)row * DM + i * 256 + lane * 4) = hw[i];
    float g[8];
#pragma unroll
    for (int j = 0; j < 8; ++j) g[j] = g2[j].x + g2[j].y;
    const bool b5 = lane & 32, b4 = lane & 16, b3 = lane & 8;
    float r1[4], r2[2], r3;
#pragma unroll
    for (int j = 0; j < 4; ++j) { const float mine = b5 ? g[4 + j] : g[j], other = b5 ? g[j] : g[4 + j]; r1[j] = mine + __shfl_xor(other, 32); }
#pragma unroll
    for (int j = 0; j < 2; ++j) { const float mine = b4 ? r1[2 + j] : r1[j], other = b4 ? r1[j] : r1[2 + j]; r2[j] = mine + __shfl_xor(other, 16); }
    { const float mine = b3 ? r2[1] : r2[0], other = b3 ? r2[0] : r2[1]; r3 = mine + __shfl_xor(other, 8); }
    r3 += __shfl_xor(r3, 4); r3 += __shfl_xor(r3, 2); r3 += __shfl_xor(r3, 1);
    const float z = r3 + bgl; const int gi = lane >> 3;
    const float lf = fminf(z, 0.f) - __logf(1.0f + __expf(-fabsf(z)));
    if ((lane & 7) == 0) gates[(size_t)row * 8 + gi] = gi < 4 ? z : lf;
}
DI void transpose_tiles(const Params& p, LAS uchar* lds, int tlo, int thi, int part, int nparts) {
    const int tid = threadIdx.x;
    LAS float* tile = (LAS float*)lds;
    for (int t0 = tlo + part * 2; t0 < thi; t0 += nparts * 2) {
        const float* src[2]; bf16_t* dst[2]; int ld[2], k0[2], n0[2], sc0[2];
#pragma unroll
        for (int q = 0; q < 2; ++q) { const int t = t0 + q;
            if (t < 960) { const int nt = t % 60, kt = t / 60; n0[q] = nt * 64; k0[q] = kt * 64; sc0[q] = n0[q] < 2816 ? n0[q] : (((n0[q] - 2816) & 255) < 128 ? 2816 + ((n0[q] - 2816) >> 8) * 128 + ((n0[q] - 2816) & 255) : 3336 + ((n0[q] - 2816) >> 8) * 128 + ((n0[q] - 2816) & 255) - 128); src[q] = p.w_in; ld[q] = DIN; dst[q] = (bf16_t*)(p.ws + WS_WTIN); }
            else { const int t2 = t - 960, nt = t2 % 16, kt = t2 / 16; n0[q] = nt * 64; k0[q] = kt * 64; sc0[q] = n0[q]; src[q] = p.w_out; ld[q] = DM; dst[q] = (bf16_t*)(p.ws + WS_WTOUT); } }
        float4 v[2][2];
#pragma unroll
        for (int q = 0; q < 2; ++q)
#pragma unroll
            for (int ps = 0; ps < 2; ++ps) { const int kk = (tid >> 4) + 32 * ps, nn4 = (tid & 15) * 4; v[q][ps] = *(const float4*)(src[q] + (size_t)(k0[q] + kk) * ld[q] + sc0[q] + nn4); }
#pragma unroll
        for (int q = 0; q < 2; ++q)
#pragma unroll
            for (int ps = 0; ps < 2; ++ps) { const int kk = (tid >> 4) + 32 * ps, nn4 = (tid & 15) * 4; LAS float* tl = tile + q * 4160 + kk * 65 + nn4; tl[0] = v[q][ps].x; tl[1] = v[q][ps].y; tl[2] = v[q][ps].z; tl[3] = v[q][ps].w; }
        __syncthreads();
#pragma unroll
        for (int q = 0; q < 2; ++q) { const int nn = tid >> 3, kk8 = (tid & 7) * 8; float f[8];
#pragma unroll
          for (int j = 0; j < 8; ++j) f[j] = tile[q * 4160 + (kk8 + j) * 65 + nn];
          *(u32x4*)(dst[q] + (size_t)(n0[q] + nn) * DM + k0[q] + kk8) = pack8(f); }
        __syncthreads();
    }
}
DI void rope_table(const Params& p, int part, int nparts) {
    const int tid = threadIdx.x;
    { float2* rope = (float2*)(p.ws + WS_ROPE);
      for (int idx = part * 512 + tid; idx < 8200 * 8; idx += nparts * 512) { const int pos = idx >> 3, i = idx & 7;
          const float invf = (float)exp(-(double)i * 0.125 * 13.122363377404328);
          const float ang = (float)pos * invf;
          const double q = rint((double)ang * 0.6366197723675814), r = (double)ang - q * 1.5707963267948966, r2 = r * r;
          const double s = r * (1.0 + r2 * (-1.0 / 6 + r2 * (1.0 / 120 + r2 * (-1.0 / 5040 + r2 * (1.0 / 362880 + r2 * (-1.0 / 39916800 + r2 * (1.0 / 6227020800.0)))))));
          const double c = 1.0 + r2 * (-0.5 + r2 * (1.0 / 24 + r2 * (-1.0 / 720 + r2 * (1.0 / 40320 + r2 * (-1.0 / 3628800 + r2 * (1.0 / 479001600.0))))));
          const int qi = ((int)q) & 3; double cs, sn;
          if (qi == 0) { sn = s; cs = c; } else if (qi == 1) { sn = c; cs = -s; } else if (qi == 2) { sn = -s; cs = -c; } else { sn = -c; cs = s; }
          rope[idx] = make_float2((float)cs, (float)sn); } }
}
DI void phase0(const Params& p, LAS uchar* lds) {
    const int tid = threadIdx.x, lane = tid & 63, wid = tid >> 6, nb = gridDim.x, bid = blockIdx.x;
#ifndef REP_TR
#define REP_TR 1
#define REP_ROW 1
#define REP_ROPE 1
#endif
    transpose_tiles(p, lds, 0, 960, bid, nb);
    LAS float* wg = (LAS float*)(lds + 32768);
    for (int d = tid; d < DM; d += 512) { const float4 a = *(const float4*)(p.w_in + (size_t)d * DIN + 3328), b = *(const float4*)(p.w_in + (size_t)d * DIN + 3332);
        wg[d] = a.x; wg[1024 + d] = a.y; wg[2048 + d] = a.z; wg[3072 + d] = a.w; wg[4096 + d] = b.x; wg[5120 + d] = b.y; wg[6144 + d] = b.z; wg[7168 + d] = b.w; }
    __syncthreads();
    float4 nwr[4];
#pragma unroll
    for (int i = 0; i < 4; ++i) nwr[i] = *(const float4*)(p.norm_w + i * 256 + lane * 4);
    const float bgr = p.b_gates[lane >> 3];
    for (int rp = 0; rp < REP_ROW; ++rp)
    for (int row = bid * 8 + wid; row < NTOK; row += nb * 16) {
        const int row2 = row + nb * 8; const bool has2 = row2 < NTOK; const int r2 = has2 ? row2 : row;
        const float* xa = row < NTP ? p.x_p + (size_t)row * DM : p.x_s + (size_t)(row - NTP) * DM;
        const float* xb = r2 < NTP ? p.x_p + (size_t)r2 * DM : p.x_s + (size_t)(r2 - NTP) * DM;
        float4 va[4], vb[4];
#pragma unroll
        for (int i = 0; i < 4; ++i) va[i] = *(const float4*)(xa + i * 256 + lane * 4);
#pragma unroll
        for (int i = 0; i < 4; ++i) vb[i] = *(const float4*)(xb + i * 256 + lane * 4);
        norm_row(p, wg, row, va, nwr, bgr, lane);
        if (has2) norm_row(p, wg, row2, vb, nwr, bgr, lane);
    }
}

DI float block_excl_sum(float v, LAS float* red, int tid) {
    const int lane = tid & 63, wid = tid >> 6; float inc = v;
#pragma unroll
    for (int o = 1; o < 64; o <<= 1) { const float t = __shfl_up(inc, o); if (lane >= o) inc += t; }
    __syncthreads(); if (lane == 63) red[wid] = inc; __syncthreads();
    float base = 0.f;
#pragma unroll
    for (int w = 0; w < 8; ++w) base += (w < wid) ? red[w] : 0.f;
    return base + inc - v;
}
DI float block_excl_max(float v, LAS float* red, int tid) {
    const int lane = tid & 63, wid = tid >> 6; float inc = v;
#pragma unroll
    for (int o = 1; o < 64; o <<= 1) { const float t = __shfl_up(inc, o); if (lane >= o) inc = fmaxf(inc, t); }
    __syncthreads(); if (lane == 63) red[wid] = inc; __syncthreads();
    float base = -INFINITY;
#pragma unroll
    for (int w = 0; w < 8; ++w) base = fmaxf(base, (w < wid) ? red[w] : -INFINITY);
    float ex = __shfl_up(inc, 1); if (lane == 0) ex = -INFINITY;
    return fmaxf(base, ex);
}
DI void gate_scan(const Params& p, LAS uchar* lds, int bh) {
    const int tid = threadIdx.x, b = bh >> 2, h = bh & 3, t0 = tid * 16;
    const float* gates = (const float*)(p.ws + WS_GATES); float2* FM = (float2*)(p.ws + WS_FM) + (size_t)bh * SEQ;
    LAS float* red = (LAS float*)lds;
    float li[16], F[16];
    float run = 0.f;
#pragma unroll
    for (int j = 0; j < 16; ++j) { const float* g = gates + (size_t)(b * SEQ + t0 + j) * 8; li[j] = g[h]; run += g[4 + h]; F[j] = run; }
    const float base = block_excl_sum(run, red, tid);
    float mx = -INFINITY, ml[16];
#pragma unroll
    for (int j = 0; j < 16; ++j) { F[j] += base; mx = fmaxf(mx, li[j] - F[j]); ml[j] = mx; }
    const float mb = fmaxf(block_excl_max(mx, red, tid), 0.0f);
#pragma unroll
    for (int j = 0; j < 16; ++j) FM[t0 + j] = make_float2(F[j], F[j] + fmaxf(ml[j], mb));
    __syncthreads();
}

struct EpiProj {
    static constexpr bool PERM = true, AFTER_DRAIN = false;
    bf16_t* O;
    __device__ __forceinline__ void operator()(const f32x4 (&acc)[2][2][4][2], const pg8::Unit& u, int wr, int wc, int fr, int fq) const {
        const int row0 = u.pm * 256 + wr * 64 + fr;
        if (u.pn < 11) { const int col0 = u.pn * 256 + wc * 32 + 8 * fq; const bool gate = (u.pn == 3) || (u.pn == 4);
#pragma unroll
            for (int ai = 0; ai < 2; ++ai)
#pragma unroll
                for (int m = 0; m < 4; ++m) { bf16_t* rowp = O + (size_t)(row0 + ai * 128 + m * 16) * NPJ + col0;
#pragma unroll
                    for (int bj = 0; bj < 2; ++bj) { f32x4 v0 = acc[ai][bj][m][0], v1 = acc[ai][bj][m][1];
                        if (gate) {
#pragma unroll
                            for (int e = 0; e < 4; ++e) { v0[e] = silu(v0[e]); v1[e] = silu(v1[e]); } }
                        u32x4 w; w.x = pk2(v0[0], v0[1]); w.y = pk2(v0[2], v0[3]); w.z = pk2(v1[0], v1[1]); w.w = pk2(v1[2], v1[3]);
                        *(u32x4*)(rowp + bj * 128) = w; } }
        } else { const int col0 = C_G + (u.pn - 11) * 128 + wc * 32 + 8 * fq;
#pragma unroll
            for (int ai = 0; ai < 2; ++ai)
#pragma unroll
                for (int m = 0; m < 4; ++m) { float g[8];
#pragma unroll
                    for (int n = 0; n < 2; ++n)
#pragma unroll
                        for (int e = 0; e < 4; ++e) { const float o = acc[ai][0][m][n][e], z = acc[ai][1][m][n][e];
                            g[4 * n + e] = z * __builtin_amdgcn_rcpf((1.0f + __builtin_amdgcn_exp2f(-1.4426950408889634f * o)) * (1.0f + __builtin_amdgcn_exp2f(-1.4426950408889634f * z))); }
                    *(u32x4*)(O + (size_t)(row0 + ai * 128 + m * 16) * NPJ + col0) = pack8(g); }
        }
    }
};
struct EpiOut {
    static constexpr bool PERM = false, AFTER_DRAIN = false;
    float* Y; const float* xp;
    __device__ __forceinline__ void operator()(const f32x4 (&acc)[2][2][4][2], const pg8::Unit& u, int wr, int wc, int fr, int fq) const {
        const int row0 = u.pm * 256 + wr * 64 + fr, col0 = u.pn * 256 + wc * 32 + 4 * fq;
#pragma unroll
        for (int ai = 0; ai < 2; ++ai)
#pragma unroll
            for (int mp = 0; mp < 2; ++mp) { f32x4 xv[2][2][2];
#pragma unroll
                for (int mm = 0; mm < 2; ++mm) { const float* xr = xp + (size_t)(row0 + ai * 128 + (mp * 2 + mm) * 16) * DM + col0;
#pragma unroll
                    for (int bj = 0; bj < 2; ++bj)
#pragma unroll
                        for (int n = 0; n < 2; ++n) xv[mm][bj][n] = *(const f32x4*)(xr + bj * 128 + n * 16); }
#pragma unroll
                for (int mm = 0; mm < 2; ++mm) { float* yr = Y + (size_t)(row0 + ai * 128 + (mp * 2 + mm) * 16) * DM + col0;
#pragma unroll
                    for (int bj = 0; bj < 2; ++bj)
#pragma unroll
                        for (int n = 0; n < 2; ++n) *(f32x4*)(yr + bj * 128 + n * 16) = acc[ai][bj][mp * 2 + mm][n] + xv[mm][bj][n]; } }
    }
};
DI void phase1(const Params& p, LAS uchar* lds) {
    const int nb = gridDim.x, bid = blockIdx.x;
    if (bid >= nb - 8) gate_scan(p, lds, bid - (nb - 8));
    {
        const int nun = (NTOK / 256) * (NGE / 256), rounds = (nun + nb - 1) / nb, first_light = nun - (rounds - 1) * nb;
        int part = bid - first_light, nparts = nb - 8 - first_light;
        if (nparts < 8) { part = bid; nparts = nb; }
        if (part >= 0 && part < nparts) { transpose_tiles(p, lds, 960, 960 + 256, part, nparts); rope_table(p, part, nparts); }
    }
    pg8::Gemm g; g.A = (const bf16_t*)(p.ws + WS_H); g.Bt = (const bf16_t*)(p.ws + WS_WTIN); g.M = NTOK; g.N = NGE; g.K = DM;
    pg8::StaticOrder S; S.init(g.M, g.N, nb, bid);
    EpiProj E; E.O = (bf16_t*)(p.ws + WS_PROJ);
    pg8::gemm_phase<EpiProj, pg8::StaticOrder, false>(lds, g, S, E, nullptr);
}
DI void phase5(const Params& p, LAS uchar* lds) {
    const int nb = gridDim.x, bid = blockIdx.x;
    pg8::Gemm g; g.A = (const bf16_t*)(p.ws + WS_MIXED); g.Bt = (const bf16_t*)(p.ws + WS_WTOUT); g.M = NTP; g.N = DM; g.K = DM;
    pg8::StaticOrder S; S.init(g.M, g.N, nb, bid);
    EpiOut E; E.Y = p.out + O_Y; E.xp = p.x_p;
    pg8::gemm_phase<EpiOut, pg8::StaticOrder, false>(lds, g, S, E, nullptr);
}

constexpr int KSTR = 144, VSTR = 560, AT_K = 0, AT_V = 272 * KSTR, AT_R = AT_V + 64 * VSTR;
typedef float f32x2r __attribute__((ext_vector_type(2)));

DI void qk_norm_rope16(float (&x)[16], int pt, const float* nw, const float2* rope_row) {
    float ss = 0.f;
#pragma unroll
    for (int j = 0; j < 16; ++j) ss += x[j] * x[j];
    ss += __shfl_xor(ss, 1); ss += __shfl_xor(ss, 2);
    const float rstd = rsqrtf(ss * (1.0f / 64) + 1e-6f);
#pragma unroll
    for (int j = 0; j < 16; ++j) x[j] = x[j] * rstd * nw[pt * 16 + j];
    if (pt == 0) {
#pragma unroll
        for (int i = 0; i < 8; ++i) { const float2 cs = rope_row[i]; const float a = x[i], b = x[i + 8]; x[i] = a * cs.x - b * cs.y; x[i + 8] = b * cs.x + a * cs.y; } }
}
DI void qk_norm_rope16p(float (&x)[16], int pt, const float* nw, const float2 (&rp)[8]) {
    float ss = 0.f;
#pragma unroll
    for (int j = 0; j < 16; ++j) ss += x[j] * x[j];
    ss += __shfl_xor(ss, 1); ss += __shfl_xor(ss, 2);
    const float rstd = rsqrtf(ss * (1.0f / 64) + 1e-6f);
#pragma unroll
    for (int j = 0; j < 16; ++j) x[j] = x[j] * rstd * nw[pt * 16 + j];
    if (pt == 0) {
#pragma unroll
        for (int i = 0; i < 8; ++i) { const float2 cs = rp[i]; const float a = x[i], b = x[i + 8]; x[i] = a * cs.x - b * cs.y; x[i + 8] = b * cs.x + a * cs.y; } }
}
DI void kv_to_lds(LAS uchar* lds, int ki, int pt, const float (&xk)[16], const float (&xv)[16]) {
    float a[8], b[8];
#pragma unroll
    for (int j = 0; j < 8; ++j) { a[j] = xk[j]; b[j] = xk[8 + j]; }
    *(LAS u32x4*)(lds + AT_K + ki * KSTR + pt * 32) = pack8(a); *(LAS u32x4*)(lds + AT_K + ki * KSTR + pt * 32 + 16) = pack8(b);
#pragma unroll
    for (int j = 0; j < 16; j += 2) { const unsigned w = pk2(xv[j], xv[j + 1]);
        *(LAS bf16_t*)(lds + AT_V + (pt * 16 + j) * VSTR + ki * 2) = (bf16_t)(w & 0xffffu); *(LAS bf16_t*)(lds + AT_V + (pt * 16 + j + 1) * VSTR + ki * 2) = (bf16_t)(w >> 16); }
}
DI void load16bf(const bf16_t* src, float (&x)[16]) { const u32x4 w0 = *(const u32x4*)src, w1 = *(const u32x4*)(src + 8); float a[8], b[8]; unpack8(w0, a); unpack8(w1, b);
#pragma unroll
    for (int j = 0; j < 8; ++j) { x[j] = a[j]; x[8 + j] = b[j]; } }
DI void load16f(const float* src, float (&x)[16]) {
#pragma unroll
    for (int j = 0; j < 4; ++j) { const float4 v = *(const float4*)(src + 4 * j); x[4 * j] = v.x; x[4 * j + 1] = v.y; x[4 * j + 2] = v.z; x[4 * j + 3] = v.w; } }
DI void store16f(float* dst, const float (&x)[16]) {
#pragma unroll
    for (int j = 0; j < 4; ++j) *(float4*)(dst + 4 * j) = make_float4(x[4 * j], x[4 * j + 1], x[4 * j + 2], x[4 * j + 3]); }

struct QRaw { u32x4 q0, q1; u32x2 gw[4]; };
DI void attn_q_load(const Params& p, int row, int hqa, QRaw& qr) {
    const int lane = threadIdx.x & 63, quad = lane >> 4;
    const bf16_t* rowp = (const bf16_t*)(p.ws + WS_PROJ) + (size_t)row * NPJ;
    qr.q0 = *(const u32x4*)(rowp + C_AQ + hqa * 64 + 8 * quad); qr.q1 = *(const u32x4*)(rowp + C_AQ + hqa * 64 + 32 + 8 * quad);
#pragma unroll
    for (int mt = 0; mt < 4; ++mt) qr.gw[mt] = *(const u32x2*)(rowp + C_AG + hqa * 64 + 16 * mt + 4 * quad);
}
template <bool LROPE> DI void attn_q_tile(const Params& p, LAS uchar* lds, const QRaw& qr, const float (&qw0)[8], const float (&qw1)[8], int row, int pos, int hqa, int qi, int kt0, int kmin) {
    const int lane = threadIdx.x & 63, r = lane & 15, quad = lane >> 4;
    const float2* rope = (const float2*)(p.ws + WS_ROPE);
    float x0[8], x1[8];
    unpack8(qr.q0, x0); unpack8(qr.q1, x1);
    float ss = 0.f;
#pragma unroll
    for (int j = 0; j < 8; ++j) ss += x0[j] * x0[j] + x1[j] * x1[j];
    ss += __shfl_xor(ss, 16); ss += __shfl_xor(ss, 32);
    const float rstd = rsqrtf(ss * (1.0f / 64) + 1e-6f) ;
#pragma unroll
    for (int j = 0; j < 8; ++j) { x0[j] = x0[j] * rstd * qw0[j]; x1[j] = x1[j] * rstd * qw1[j]; }
#pragma unroll
    for (int j = 0; j < 8; ++j) { const float pj = __shfl_xor(x0[j], 16); float2 cs; if (LROPE) { const f32x2r c2 = *(const LAS f32x2r*)(lds + AT_R + qi * 64 + j * 8); cs = make_float2(c2.x, c2.y); } else cs = rope[(size_t)pos * 8 + j];
        const float rot = x0[j] * cs.x + (quad == 0 ? -pj : pj) * cs.y; x0[j] = (quad < 2) ? rot : x0[j]; }
#pragma unroll
    for (int j = 0; j < 8; ++j) { x0[j] *= 0.18033688011112042f; x1[j] *= 0.18033688011112042f; }
    const bf16x8 qf0 = __builtin_bit_cast(bf16x8, pack8(x0)), qf1 = __builtin_bit_cast(bf16x8, pack8(x1));
    const float sink = p.sinks[hqa] * 1.4426950408889634f;
    f32x4 s[9];
#pragma unroll
    for (int kt = 0; kt < 9; ++kt) { const int krow = (kt0 + kt) * 16 + r;
        const bf16x8 a0 = *(const LAS bf16x8*)(lds + AT_K + krow * KSTR + quad * 16), a1 = *(const LAS bf16x8*)(lds + AT_K + krow * KSTR + 64 + quad * 16);
        f32x4 acc = {0.f, 0.f, 0.f, 0.f}; acc = mfma16(a0, qf0, acc); acc = mfma16(a1, qf1, acc); s[kt] = acc; }
    float mx = sink;
#pragma unroll
    for (int kt = 0; kt < 9; ++kt) {
        if ((kt0 + kt) * 16 + 15 < kmin) { s[kt] = (f32x4){-INFINITY, -INFINITY, -INFINITY, -INFINITY}; }
        else {
            if (kt == 0) {
#pragma unroll
                for (int v = 0; v < 4; ++v) { const int ki = kt0 * 16 + quad * 4 + v; s[kt][v] = (ki > qi) ? s[kt][v] : -INFINITY; } }
            if (kt == 8) {
#pragma unroll
                for (int v = 0; v < 4; ++v) { const int ki = (kt0 + 8) * 16 + quad * 4 + v; s[kt][v] = (ki <= qi + 128) ? s[kt][v] : -INFINITY; } }
            mx = fmaxf(fmaxf(mx, fmaxf(s[kt][0], s[kt][1])), fmaxf(s[kt][2], s[kt][3])); } }
    mx = fmaxf(mx, __shfl_xor(mx, 16)); mx = fmaxf(mx, __shfl_xor(mx, 32));
    float sum = 0.f;
#pragma unroll
    for (int kt = 0; kt < 9; ++kt)
#pragma unroll
        for (int v = 0; v < 4; ++v) { const float e = __builtin_amdgcn_exp2f(s[kt][v] - mx); s[kt][v] = e; sum += e; }
    sum += __shfl_xor(sum, 16); sum += __shfl_xor(sum, 32);
    sum += __builtin_amdgcn_exp2f(sink - mx);
    const float inv = __builtin_amdgcn_rcpf(sum);
    f32x4 o[4];
#pragma unroll
    for (int mt = 0; mt < 4; ++mt) o[mt] = (f32x4){0.f, 0.f, 0.f, 0.f};
#pragma unroll
    for (int ks = 0; ks < 5; ++ks) {
        u32x4 pw; pw.x = pk2(s[2 * ks][0], s[2 * ks][1]); pw.y = pk2(s[2 * ks][2], s[2 * ks][3]);
        if (ks < 4) { pw.z = pk2(s[2 * ks + 1][0], s[2 * ks + 1][1]); pw.w = pk2(s[2 * ks + 1][2], s[2 * ks + 1][3]); } else { pw.z = 0u; pw.w = 0u; }
        const bf16x8 pb = __builtin_bit_cast(bf16x8, pw);
#pragma unroll
        for (int mt = 0; mt < 4; ++mt) { const int d = 16 * mt + r; const LAS uchar* vp = lds + AT_V + d * VSTR + ((kt0 + 2 * ks) * 16 + 4 * quad) * 2;
            u32x4 aw; const u32x2 lo = *(const LAS u32x2*)vp, hi = *(const LAS u32x2*)(vp + 32); aw.x = lo.x; aw.y = lo.y; aw.z = hi.x; aw.w = hi.y;
            o[mt] = mfma16(__builtin_bit_cast(bf16x8, aw), pb, o[mt]); } }
    bf16_t* mixed = (bf16_t*)(p.ws + WS_MIXED) + (size_t)row * DM;
#pragma unroll
    for (int mt = 0; mt < 4; ++mt) { const int col = hqa * 64 + 16 * mt + 4 * quad; const u32x2 gw = qr.gw[mt];
        u32x2 w; w.x = pk2(o[mt][0] * inv * bflo(gw.x), o[mt][1] * inv * bfhi(gw.x)); w.y = pk2(o[mt][2] * inv * bflo(gw.y), o[mt][3] * inv * bfhi(gw.y));
        *(u32x2*)(mixed + col) = w; }
}

DI void attn_prompt_item(const Params& p, LAS uchar* lds, int item) {
    const int tid = threadIdx.x, wid = tid >> 6, lane = tid & 63, r = lane & 15;
    const int g = item & 1, blk = (item >> 1) & 63, b = item >> 7;
    const bf16_t* proj = (const bf16_t*)(p.ws + WS_PROJ); const float2* rope = (const float2*)(p.ws + WS_ROPE);
    const int hqa = g * 4 + (wid >> 1), qh = wid & 1;
    __syncthreads();
    float qw0[8], qw1[8];
    { const int quad = lane >> 4;
#pragma unroll
      for (int j = 0; j < 8; ++j) { qw0[j] = p.qnw[8 * quad + j]; qw1[j] = p.qnw[32 + 8 * quad + j]; } }
    u32x4 kr[2][2], vr[2][2]; float2 rp[2][8];
#pragma unroll
    for (int it = 0; it < 2; ++it) { const int u = tid + 512 * it, ki = u >> 2, pt = u & 3, tk = (blk - 1) * 128 + ki; const int tkc = tk < 0 ? 0 : tk;
        const bf16_t* rowp = proj + (size_t)(b * SEQ + tkc) * NPJ;
        kr[it][0] = *(const u32x4*)(rowp + C_AK + g * 64 + pt * 16); kr[it][1] = *(const u32x4*)(rowp + C_AK + g * 64 + pt * 16 + 8);
        vr[it][0] = *(const u32x4*)(rowp + C_AV + g * 64 + pt * 16); vr[it][1] = *(const u32x4*)(rowp + C_AV + g * 64 + pt * 16 + 8);
#pragma unroll
        for (int i = 0; i < 8; ++i) rp[it][i] = rope[(size_t)tkc * 8 + i]; }
    if (tid < 128) { u32x4 z; z.x = 0u; z.y = 0u; z.z = 0u; z.w = 0u; *(LAS u32x4*)(lds + AT_V + (tid >> 1) * VSTR + 512 + (tid & 1) * 16) = z; }
    QRaw qr[4];
#pragma unroll
    for (int i = 0; i < 4; ++i) attn_q_load(p, b * SEQ + blk * 128 + (qh * 4 + i) * 16 + r, hqa, qr[i]);
    { const float2 ra = rope[(size_t)blk * 1024 + tid], rb = rope[(size_t)blk * 1024 + 512 + tid];
      *(LAS f32x2r*)(lds + AT_R + tid * 8) = (f32x2r){ra.x, ra.y}; *(LAS f32x2r*)(lds + AT_R + (512 + tid) * 8) = (f32x2r){rb.x, rb.y}; }
#pragma unroll
    for (int it = 0; it < 2; ++it) { const int u = tid + 512 * it, ki = u >> 2, pt = u & 3;
        {
            float xk[16], xv[16]; float a[8], c[8];
            unpack8(kr[it][0], a); unpack8(kr[it][1], c);
#pragma unroll
            for (int j = 0; j < 8; ++j) { xk[j] = a[j]; xk[8 + j] = c[j]; }
            unpack8(vr[it][0], a); unpack8(vr[it][1], c);
#pragma unroll
            for (int j = 0; j < 8; ++j) { xv[j] = a[j]; xv[8 + j] = c[j]; }
            qk_norm_rope16p(xk, pt, p.knw, rp[it]);
            kv_to_lds(lds, ki, pt, xk, xv);
            if (blk == 63 && ki >= 128) { const size_t o = ((size_t)(b * 128 + ki - 128) * 2 + g) * 64 + pt * 16; store16f(p.out + O_KWP + o, xk); store16f(p.out + O_VWP + o, xv); } } }
    __syncthreads();
#pragma unroll 2
    for (int i = 0; i < 4; ++i) { const int qt = qh * 4 + i, qi = qt * 16 + r, tq = blk * 128 + qi;
        attn_q_tile<true>(p, lds, qr[0], qw0, qw1, b * SEQ + tq, tq, hqa, qi, qt, blk == 0 ? 128 : 0);
        qr[0] = qr[1]; qr[1] = qr[2]; qr[2] = qr[3]; }
}
DI void attn_sample_item(const Params& p, LAS uchar* lds, int item) {
    const int tid = threadIdx.x, wid = tid >> 6, lane = tid & 63, r = lane & 15;
    const int g = item & 1, b = item >> 1;
    const bf16_t* proj = (const bf16_t*)(p.ws + WS_PROJ); const float2* rope = (const float2*)(p.ws + WS_ROPE);
    __syncthreads();
    QRaw qrs; if (wid == 0) attn_q_load(p, NTP + b * 4 + (r >> 2), g * 4 + (r & 3), qrs);
    float qw0[8], qw1[8];
    { const int quad = lane >> 4;
#pragma unroll
      for (int j = 0; j < 8; ++j) { qw0[j] = p.qnw[8 * quad + j]; qw1[j] = p.qnw[32 + 8 * quad + j]; } }
    for (int u = tid; u < 640; u += 512) { const int ki = u >> 2, pt = u & 3;
        float xk[16], xv[16];
#pragma unroll
        for (int j = 0; j < 16; ++j) { xk[j] = 0.f; xv[j] = 0.f; }
        if (ki < 128) { const size_t o = ((size_t)(b * 128 + ki) * 2 + g) * 64 + pt * 16; load16f(p.ck + o, xk); load16f(p.cv + o, xv); }
        else { if (ki < 132) { const bf16_t* rowp = proj + (size_t)(NTP + b * 4 + ki - 128) * NPJ; load16bf(rowp + C_AK + g * 64 + pt * 16, xk); load16bf(rowp + C_AV + g * 64 + pt * 16, xv); }
               qk_norm_rope16(xk, pt, p.knw, rope + (size_t)(SEQ + (ki < 132 ? ki - 128 : 0)) * 8); }
        kv_to_lds(lds, ki, pt, xk, xv);
        if (ki >= 4 && ki < 132) { const size_t o = ((size_t)(b * 128 + ki - 4) * 2 + g) * 64 + pt * 16; store16f(p.out + O_KWS + o, xk); store16f(p.out + O_VWS + o, xv); }
    }
    __syncthreads();
    if (wid == 0) { const int t = r >> 2, hqa = g * 4 + (r & 3); attn_q_tile<false>(p, lds, qrs, qw0, qw1, NTP + b * 4 + t, SEQ + t, hqa, t, 0, 0); }
}

constexpr int TSTR = 272;
constexpr int ML_Q = 0, ML_K = 128 * TSTR, ML_V = ML_K + 128 * TSTR, ML_S = ML_V + 144 * TSTR, ML_AS = ML_S + 144 * TSTR, ML_END = ML_AS + 512;
static_assert(ML_END <= LDS_MAIN, "lds");

struct ConvIn { u32x4 row[11]; float4 w[4][2]; float4 bias[2]; };
DI void conv_issue(const Params& p, const bf16_t* proj, int b, int t0, int col, int ch, ConvIn& ci) {
#pragma unroll
    for (int i = 0; i < 11; ++i) { const int tt = t0 - 3 + i; ci.row[i] = *(const u32x4*)(proj + (size_t)(b * SEQ + (tt < 0 ? 0 : tt)) * NPJ + col); }
#pragma unroll
    for (int j = 0; j < 4; ++j) { ci.w[j][0] = *(const float4*)(p.conv_w + j * 1024 + ch); ci.w[j][1] = *(const float4*)(p.conv_w + j * 1024 + ch + 4); }
    ci.bias[0] = *(const float4*)(p.conv_b + ch); ci.bias[1] = *(const float4*)(p.conv_b + ch + 4);
}
typedef float f32x2 __attribute__((ext_vector_type(2)));
DI void conv_compute(const ConvIn& ci, int t0, float (&y)[8][8]) {
    f32x2 w[4][4], yy[8][4];
#pragma unroll
    for (int j = 0; j < 4; ++j) { w[j][0] = (f32x2){ci.w[j][0].x, ci.w[j][0].y}; w[j][1] = (f32x2){ci.w[j][0].z, ci.w[j][0].w}; w[j][2] = (f32x2){ci.w[j][1].x, ci.w[j][1].y}; w[j][3] = (f32x2){ci.w[j][1].z, ci.w[j][1].w}; }
    const f32x2 bs[4] = {(f32x2){ci.bias[0].x, ci.bias[0].y}, (f32x2){ci.bias[0].z, ci.bias[0].w}, (f32x2){ci.bias[1].x, ci.bias[1].y}, (f32x2){ci.bias[1].z, ci.bias[1].w}};
#pragma unroll
    for (int i = 0; i < 8; ++i)
#pragma unroll
        for (int q = 0; q < 4; ++q) yy[i][q] = bs[q];
#pragma unroll
    for (int r = 0; r < 11; ++r) { f32x2 x[4];
        const bool zero = (r < 3) && (t0 - 3 + r < 0);
#pragma unroll
        for (int q = 0; q < 4; ++q) { const unsigned wd = zero ? 0u : ci.row[r][q]; x[q] = (f32x2){bflo(wd), bfhi(wd)}; }
#pragma unroll
        for (int j = 0; j < 4; ++j) { const int i = r - j;
            if (i >= 0 && i < 8) {
#pragma unroll
                for (int q = 0; q < 4; ++q) yy[i][q] += w[j][q] * x[q]; } } }
#pragma unroll
    for (int i = 0; i < 8; ++i)
#pragma unroll
        for (int q = 0; q < 4; ++q) { const f32x2 v = yy[i][q], a = v * -1.4426950408889634f; f32x2 e; e.x = __builtin_amdgcn_exp2f(a.x); e.y = __builtin_amdgcn_exp2f(a.y);
            const f32x2 d = e + 1.0f; f32x2 rc; rc.x = __builtin_amdgcn_rcpf(d.x); rc.y = __builtin_amdgcn_rcpf(d.y); const f32x2 o = v * rc; y[i][2 * q] = o.x; y[i][2 * q + 1] = o.y; }
}
DI void vt_store8(LAS uchar* img, int d0, int s0, const u32x4 (&row)[8]) {
#pragma unroll
    for (int wd = 0; wd < 4; ++wd) { u32x4 ev, od;
        unsigned a[8];
#pragma unroll
        for (int i = 0; i < 8; ++i) a[i] = row[i][wd];
        ev.x = (a[0] & 0xffffu) | (a[1] << 16); ev.y = (a[2] & 0xffffu) | (a[3] << 16); ev.z = (a[4] & 0xffffu) | (a[5] << 16); ev.w = (a[6] & 0xffffu) | (a[7] << 16);
        od.x = (a[0] >> 16) | (a[1] & 0xffff0000u); od.y = (a[2] >> 16) | (a[3] & 0xffff0000u); od.z = (a[4] >> 16) | (a[5] & 0xffff0000u); od.w = (a[6] >> 16) | (a[7] & 0xffff0000u);
        *(LAS u32x4*)(img + (d0 + 2 * wd) * TSTR + s0 * 2) = ev; *(LAS u32x4*)(img + (d0 + 2 * wd + 1) * TSTR + s0 * 2) = od; }
}
DI void vt_aug_rows(LAS uchar* img, int tid) {
    if (tid < 256) { const int rr = tid >> 4, s8 = (tid & 15) * 8; const unsigned v = rr == 0 ? 0x3F803F80u : 0u; u32x4 w; w.x = v; w.y = v; w.z = v; w.w = v;
        *(LAS u32x4*)(img + (128 + rr) * TSTR + s8 * 2) = w; }
}

DI void mlstm_u_item(const Params& p, LAS uchar* lds, int item) {
    const int tid = threadIdx.x, wid = tid >> 6, lane = tid & 63, r = lane & 15, quad = lane >> 4;
    const int c = item & 63, bh = item >> 6, b = bh >> 2, h = bh & 3;
    const bf16_t* proj = (const bf16_t*)(p.ws + WS_PROJ); const float* gates = (const float*)(p.ws + WS_GATES); const float2* FM = (const float2*)(p.ws + WS_FM) + (size_t)bh * SEQ;
    LAS float* wks = (LAS float*)(lds + ML_AS);
    __syncthreads();
    if (tid < 256) {
        const int g8 = (tid & 15) * 8, s0 = (tid >> 4) * 8, t0 = c * CH + s0;
        ConvIn ci; conv_issue(p, proj, b, t0, C_MK + h * 128 + g8, 512 + h * 128 + g8, ci);
        if (tid < 128) { const int t = c * CH + tid; const float2 fe = FM[c * CH + CH - 1], fs = FM[t];
            wks[tid] = __expf(fe.x - fs.x + gates[(size_t)(b * SEQ + t) * 8 + h] - fe.y) * 0.08838834764831845f; }
        vt_aug_rows(lds + ML_V, tid);
        __syncthreads();
        float y[8][8]; conv_compute(ci, t0, y);
        const f32x4 wa = *(const LAS f32x4*)(wks + s0), wb = *(const LAS f32x4*)(wks + s0 + 4);
        const float wk[8] = {wa[0], wa[1], wa[2], wa[3], wb[0], wb[1], wb[2], wb[3]};
#pragma unroll
        for (int e = 0; e < 8; ++e) { float f[8];
#pragma unroll
            for (int i = 0; i < 8; ++i) f[i] = y[i][e] * wk[i];
            *(LAS u32x4*)(lds + ML_K + (g8 + e) * TSTR + s0 * 2) = pack8(f); }
    } else {
        const int vt = tid - 256, d8 = (vt & 15) * 8, s0 = (vt >> 4) * 8, t0 = c * CH + s0;
        u32x4 row[8];
#pragma unroll
        for (int i = 0; i < 8; ++i) row[i] = *(const u32x4*)(proj + (size_t)(b * SEQ + t0 + i) * NPJ + C_MV + h * 128 + d8);
        __syncthreads();
        vt_store8(lds + ML_V, d8, s0, row);
    }
    __syncthreads();
    f32x4 acc[9];
#pragma unroll
    for (int mt = 0; mt < 9; ++mt) acc[mt] = (f32x4){0.f, 0.f, 0.f, 0.f};
#pragma unroll
    for (int ks = 0; ks < 4; ++ks) { const bf16x8 bk = *(const LAS bf16x8*)(lds + ML_K + (16 * wid + r) * TSTR + ks * 64 + quad * 16);
#pragma unroll
        for (int mt = 0; mt < 9; ++mt) { const bf16x8 av = *(const LAS bf16x8*)(lds + ML_V + (16 * mt + r) * TSTR + ks * 64 + quad * 16); acc[mt] = mfma16(av, bk, acc[mt]); } }
    bf16_t* U = (bf16_t*)(p.ws + WS_UST) + (size_t)item * USZ;
#pragma unroll
    for (int mt = 0; mt < 9; ++mt)
#pragma unroll
        for (int v = 0; v < 4; ++v) { const int dv = 16 * mt + 4 * quad + v; if (dv <= 128) U[dv * 128 + 16 * wid + r] = f2bf(acc[mt][v]); }
}

DI void sample_outproj(const Params& p, int unit) {
    const int lane = threadIdx.x & 63, wid = threadIdx.x >> 6, r = lane & 15, quad = lane >> 4;
    const int m0 = (unit >> 4) * 32 + (wid >> 2) * 16, n0 = (unit & 15) * 64 + (wid & 3) * 16;
    const bf16_t* A = (const bf16_t*)(p.ws + WS_WTOUT) + (size_t)(n0 + r) * DM + 8 * quad;
    const bf16_t* B = (const bf16_t*)(p.ws + WS_MIXED) + (size_t)(NTP + m0 + r) * DM + 8 * quad;
    f32x4 acc0 = {0.f, 0.f, 0.f, 0.f}, acc1 = {0.f, 0.f, 0.f, 0.f};
    const f32x4 xres = *(const f32x4*)(p.x_s + (size_t)(m0 + r) * DM + n0 + 4 * quad);
#pragma unroll
    for (int hb = 0; hb < 4; ++hb) { bf16x8 af[8], bfr[8];
#pragma unroll
        for (int ks = 0; ks < 8; ++ks) { af[ks] = *(const bf16x8*)(A + (hb * 8 + ks) * 32); bfr[ks] = *(const bf16x8*)(B + (hb * 8 + ks) * 32); }
#pragma unroll
        for (int ks = 0; ks < 8; ks += 2) { acc0 = mfma16(af[ks], bfr[ks], acc0); acc1 = mfma16(af[ks + 1], bfr[ks + 1], acc1); } }
    const size_t o = (size_t)(m0 + r) * DM + n0 + 4 * quad;
    *(f32x4*)(p.out + O_Y + (size_t)NTP * DM + o) = acc0 + acc1 + xres;
}
DI void mlstm_scan(const Params& p, LAS uchar* lds) {
    const int tid = threadIdx.x, nb = gridDim.x, bid = blockIdx.x;
    const unsigned* U32 = (const unsigned*)(p.ws + WS_UST); unsigned* S32 = (unsigned*)(p.ws + WS_SB);
    LAS float* dcs = (LAS float*)lds;
    for (int it = nb - 1 - bid; it < 256; it += nb) sample_outproj(p, it);
    constexpr int NPAIR = 8 * USZ / 2, HU = USZ / 2;
    const int per = (NPAIR + nb - 1) / nb, base = bid * per, lim = (base + per < NPAIR) ? base + per : NPAIR;
    bool first = true;
    for (int pb = base; pb < lim || first; pb += 512) {
        const int e = pb + tid; const bool has = e < lim; const int ec = has ? e : 0;
        const int bh = (2 * ec) / USZ, idx = 2 * ec - bh * USZ; const unsigned off = (unsigned)((bh * NCH * USZ + idx) >> 1);
        unsigned ua[64];
#pragma unroll
        for (int j = 0; j < 64; ++j) ua[j] = (U32 + (size_t)j * HU)[off];
        if (first) { first = false;
            __syncthreads();
            { const int bh2 = tid >> 6, c = tid & 63; const float2* FM = (const float2*)(p.ws + WS_FM) + (size_t)bh2 * SEQ;
              const float2 fe = FM[c * CH + CH - 1]; float2 pv = make_float2(0.f, 0.f); if (c > 0) pv = FM[c * CH - 1];
              dcs[tid] = __expf(fe.x - pv.x + pv.y - fe.y);
              if (bid == 0 && c == 63) p.out[O_MP + bh2] = fe.y; }
            __syncthreads(); }
        if (has) { float S0 = 0.f, S1 = 0.f;
#pragma unroll
            for (int j = 0; j < 64; ++j) { (S32 + (size_t)j * HU)[off] = pk2(S0, S1); const float d = dcs[bh * 64 + j]; S0 = d * S0 + bflo(ua[j]); S1 = d * S1 + bfhi(ua[j]); }
            if (idx < 16384) { const int dv = idx >> 7, dk = idx & 127; float* o = p.out + O_CP + (size_t)bh * 16384 + dk * 128 + dv; o[0] = S0; o[128] = S1; }
            else { float* o = p.out + O_NP + bh * 128 + idx - 16384; o[0] = S0; o[1] = S1; } }
    }
}

DI void mlstm_out_item(const Params& p, LAS uchar* lds, int item) {
    const int tid = threadIdx.x, wid = tid >> 6, lane = tid & 63, r = lane & 15, quad = lane >> 4;
    const int c = item & 63, bh = item >> 6, b = bh >> 2, h = bh & 3;
    const bf16_t* proj = (const bf16_t*)(p.ws + WS_PROJ); const float* gates = (const float*)(p.ws + WS_GATES); const float2* FM = (const float2*)(p.ws + WS_FM) + (size_t)bh * SEQ;
    __syncthreads();
    {
        const bf16_t* St = (const bf16_t*)(p.ws + WS_SB) + (size_t)item * USZ;
        u32x4 sv[5];
#pragma unroll
        for (int k = 0; k < 5; ++k) { const int u = tid + 512 * k, dv = u >> 4, d8 = (u & 15) * 8; const int dvc = dv <= 128 ? dv : 128;
            sv[k] = *(const u32x4*)(St + dvc * 128 + d8); }
        const int isk = (tid >> 4) & 1, g8 = (tid & 15) * 8, s0 = (tid >> 5) * 8, t0 = c * CH + s0;
        ConvIn ci; conv_issue(p, proj, b, t0, (isk ? C_MK : C_MQ) + h * 128 + g8, isk * 512 + h * 128 + g8, ci);
        const int vd8 = (tid & 15) * 8, vs0 = (tid >> 4) * 4;
        u32x4 vrow[4];
#pragma unroll
        for (int i = 0; i < 4; ++i) vrow[i] = *(const u32x4*)(proj + (size_t)(b * SEQ + c * CH + vs0 + i) * NPJ + C_MV + h * 128 + vd8);
        if (tid < 128) { const int t = c * CH + tid; ((LAS float*)(lds + ML_AS))[tid] = gates[(size_t)(b * SEQ + t) * 8 + h] - FM[t].x; }
        vt_aug_rows(lds + ML_V, tid);
#pragma unroll
        for (int k = 0; k < 5; ++k) { const int u = tid + 512 * k, dv = u >> 4, d8 = (u & 15) * 8;
            if (u < 144 * 16) { u32x4 w = sv[k]; if (dv > 128) { w.x = 0u; w.y = 0u; w.z = 0u; w.w = 0u; }
                *(LAS u32x4*)(lds + ML_S + dv * TSTR + d8 * 2) = w; } }
        float y[8][8]; conv_compute(ci, t0, y);
#pragma unroll
        for (int i = 0; i < 8; ++i) { float f[8];
#pragma unroll
            for (int e = 0; e < 8; ++e) f[e] = isk ? y[i][e] * 0.08838834764831845f : y[i][e];
            *(LAS u32x4*)(lds + (isk ? ML_K : ML_Q) + (s0 + i) * TSTR + g8 * 2) = pack8(f); }
#pragma unroll
        for (int wd = 0; wd < 4; ++wd) { const unsigned a0 = vrow[0][wd], a1 = vrow[1][wd], a2 = vrow[2][wd], a3 = vrow[3][wd]; u32x2 ev, od;
            ev.x = (a0 & 0xffffu) | (a1 << 16); ev.y = (a2 & 0xffffu) | (a3 << 16); od.x = (a0 >> 16) | (a1 & 0xffff0000u); od.y = (a2 >> 16) | (a3 & 0xffff0000u);
            *(LAS u32x2*)(lds + ML_V + (vd8 + 2 * wd) * TSTR + vs0 * 2) = ev; *(LAS u32x2*)(lds + ML_V + (vd8 + 2 * wd + 1) * TSTR + vs0 * 2) = od; }
    }
    const int ti = 16 * wid + r, t = c * CH + ti; const float2 ft = FM[t]; float2 f0 = make_float2(0.f, 0.f); if (c > 0) f0 = FM[c * CH - 1];
    const bf16_t* rowp = proj + (size_t)(b * SEQ + t) * NPJ; bf16_t* mixed = (bf16_t*)(p.ws + WS_MIXED) + (size_t)(b * SEQ + t) * DM + 512 + h * 128;
    u32x2 gws[8]; float4 nws[8];
#pragma unroll
    for (int mt = 0; mt < 8; ++mt) { const int dv = 16 * mt + 4 * quad; gws[mt] = *(const u32x2*)(rowp + C_G + h * 128 + dv); nws[mt] = *(const float4*)(p.mhw + h * 128 + dv); }
    __syncthreads();
    bf16x8 qf[4];
#pragma unroll
    for (int ks = 0; ks < 4; ++ks) qf[ks] = *(const LAS bf16x8*)(lds + ML_Q + (16 * wid + r) * TSTR + ks * 64 + quad * 16);
    const float winter = __expf(ft.x - f0.x + f0.y - ft.y), bt = ft.x - ft.y;
    f32x4 acc[9];
#pragma unroll
    for (int mt = 0; mt < 9; ++mt) acc[mt] = (f32x4){0.f, 0.f, 0.f, 0.f};
#pragma unroll
    for (int ks = 0; ks < 4; ++ks)
#pragma unroll
        for (int mt = 0; mt < 9; ++mt) { const bf16x8 a = *(const LAS bf16x8*)(lds + ML_S + (16 * mt + r) * TSTR + ks * 64 + quad * 16); acc[mt] = mfma16(a, qf[ks], acc[mt]); }
#pragma unroll
    for (int mt = 0; mt < 9; ++mt) acc[mt] *= winter;
    const LAS float* as = (const LAS float*)(lds + ML_AS);
    for (int sp = 0; sp <= (wid >> 1); ++sp) {
        u32x4 pw;
#pragma unroll
        for (int half = 0; half < 2; ++half) { const int st = 2 * sp + half; f32x4 c4 = {0.f, 0.f, 0.f, 0.f};
            if (st <= wid) {
#pragma unroll
                for (int ks = 0; ks < 4; ++ks) { const bf16x8 a = *(const LAS bf16x8*)(lds + ML_K + (16 * st + r) * TSTR + ks * 64 + quad * 16); c4 = mfma16(a, qf[ks], c4); }
                const f32x4 av = *(const LAS f32x4*)(as + 16 * st + 4 * quad);
#pragma unroll
                for (int v = 0; v < 4; ++v) { const int si = 16 * st + 4 * quad + v; c4[v] = (si <= ti) ? c4[v] * __expf(bt + av[v]) : 0.f; } }
            if (half == 0) { pw.x = pk2(c4[0], c4[1]); pw.y = pk2(c4[2], c4[3]); } else { pw.z = pk2(c4[0], c4[1]); pw.w = pk2(c4[2], c4[3]); } }
        const bf16x8 pb = __builtin_bit_cast(bf16x8, pw);
#pragma unroll
        for (int mt = 0; mt < 9; ++mt) { const LAS uchar* vp = lds + ML_V + (16 * mt + r) * TSTR + (32 * sp + 4 * quad) * 2;
            u32x4 aw; const u32x2 lo = *(const LAS u32x2*)vp, hi = *(const LAS u32x2*)(vp + 32); aw.x = lo.x; aw.y = lo.y; aw.z = hi.x; aw.w = hi.y;
            acc[mt] = mfma16(__builtin_bit_cast(bf16x8, aw), pb, acc[mt]); } }
    const float den = __shfl(acc[8][0], r);
    const float inv = __builtin_amdgcn_rcpf(fmaxf(fabsf(den), __expf(-ft.y)));
    float ss = 0.f;
#pragma unroll
    for (int mt = 0; mt < 8; ++mt)
#pragma unroll
        for (int v = 0; v < 4; ++v) { acc[mt][v] *= inv; ss += acc[mt][v] * acc[mt][v]; }
    ss += __shfl_xor(ss, 16); ss += __shfl_xor(ss, 32);
    const float rstd = rsqrtf(ss * (1.0f / 128) + 1e-6f);
#pragma unroll
    for (int mt = 0; mt < 8; ++mt) { const int dv = 16 * mt + 4 * quad; const u32x2 gw = gws[mt];
        const float4 nw = nws[mt];
        const f32x2 h0 = (f32x2){acc[mt][0], acc[mt][1]}, h1 = (f32x2){acc[mt][2], acc[mt][3]};
        const f32x2 y0 = h0 * rstd * (f32x2){nw.x, nw.y} * (f32x2){bflo(gw.x), bfhi(gw.x)}, y1 = h1 * rstd * (f32x2){nw.z, nw.w} * (f32x2){bflo(gw.y), bfhi(gw.y)};
        u32x2 w; w.x = pk2(y0.x, y0.y); w.y = pk2(y1.x, y1.y);
        *(u32x2*)(mixed + dv) = w; }
}

DI void mlstm_sample_item(const Params& p, LAS uchar* lds, int item) {
    const int tid = threadIdx.x, wid = tid >> 6, lane = tid & 63;
    const int h = item & 3, b = item >> 2;
    const bf16_t* proj = (const bf16_t*)(p.ws + WS_PROJ); const float* gates = (const float*)(p.ws + WS_GATES);
    LAS float* qs = (LAS float*)lds;
    LAS float* ks = qs + 512;
    LAS float* vs = ks + 512;
    LAS float* red = vs + 512;
    LAS float* dred = red + 2048;
    LAS float* sred = dred + 8;
    __syncthreads();
    const int dv = tid & 127, dkq = tid >> 7;
    const float* S0 = p.sC + ((size_t)(b * 4 + h) * 128 + dkq * 32) * 128 + dv;
    float S[32];
#pragma unroll
    for (int i = 0; i < 32; ++i) S[i] = S0[(size_t)i * 128];
    float nn = 0.f; if (tid < 128) nn = p.sn[(size_t)(b * 4 + h) * 128 + tid];
    const bf16_t* rowf = proj + (size_t)(NTP + b * 4 + (tid >> 7)) * NPJ;
    const unsigned ggr = rowf[C_G + h * 128 + dv]; const float mhr = p.mhw[h * 128 + dv];
    float cvs[2];
#pragma unroll
    for (int i = tid; i < 1024; i += 512) { const int t = i >> 8, lc = i & 255, ch = (lc < 128 ? 0 : 512) + h * 128 + (lc & 127);
        float y = p.conv_b[ch]; float xx[4], ww[4];
#pragma unroll
        for (int j = 0; j < 4; ++j) { const int tt = t - 3 + j; ww[j] = p.conv_w[j * 1024 + ch];
            if (tt < 0) xx[j] = p.sconv[(size_t)(b * 3 + 3 + tt) * 1024 + ch];
            else xx[j] = __uint_as_float((unsigned)proj[(size_t)(NTP + b * 4 + tt) * NPJ + C_MQ + ch] << 16); }
#pragma unroll
        for (int j = 0; j < 4; ++j) y += ww[j] * xx[j];
        cvs[i >> 9] = xx[3];
        y = silu(y);
        if (lc < 128) qs[t * 128 + lc] = y; else ks[t * 128 + (lc - 128)] = y * 0.08838834764831845f; }
    { const int t = tid >> 7, dv = tid & 127; vs[tid] = __uint_as_float((unsigned)proj[(size_t)(NTP + b * 4 + t) * NPJ + C_MV + h * 128 + dv] << 16); }
    float mt_[4], fd[4], iw[4];
    { float mprev = p.sm[b * 4 + h];
#pragma unroll
      for (int t = 0; t < 4; ++t) { const float* g = gates + (size_t)(NTP + b * 4 + t) * 8; const float li = g[h], lf = g[4 + h];
          const float m = fmaxf(lf + mprev, li); fd[t] = __expf(lf + mprev - m); iw[t] = __expf(li - m); mt_[t] = m; mprev = m; } }
    __syncthreads();
#pragma unroll
    for (int t = 0; t < 4; ++t) { const float vt = vs[t * 128 + dv] * iw[t]; float part = 0.f;
        f32x2 part2 = {0.f, 0.f};
#pragma unroll
        for (int i = 0; i < 32; i += 4) { const f32x4 k4 = *(const LAS f32x4*)(ks + t * 128 + dkq * 32 + i), q4 = *(const LAS f32x4*)(qs + t * 128 + dkq * 32 + i);
            f32x2 s01 = (f32x2){S[i], S[i + 1]}, s23 = (f32x2){S[i + 2], S[i + 3]};
            s01 = s01 * fd[t] + (f32x2){k4[0], k4[1]} * vt; s23 = s23 * fd[t] + (f32x2){k4[2], k4[3]} * vt;
            part2 += (f32x2){q4[0], q4[1]} * s01; part2 += (f32x2){q4[2], q4[3]} * s23;
            S[i] = s01.x; S[i + 1] = s01.y; S[i + 2] = s23.x; S[i + 3] = s23.y; }
        part = part2.x + part2.y;
        red[(dkq * 4 + t) * 128 + dv] = part;
        if (tid < 128) { nn = fd[t] * nn + iw[t] * ks[t * 128 + tid]; const float dp = wsum(qs[t * 128 + tid] * nn); if (lane == 0) dred[t * 2 + wid] = dp; } }
    float* Sout = p.out + O_CS + ((size_t)(b * 4 + h) * 128 + dkq * 32) * 128 + dv;
#pragma unroll
    for (int i = 0; i < 32; ++i) Sout[(size_t)i * 128] = S[i];
#pragma unroll
    for (int q = 0; q < 2; ++q) { const int i = tid + 512 * q, t = i >> 8, lc = i & 255, ch = (lc < 128 ? 0 : 512) + h * 128 + (lc & 127); if (t >= 1) p.out[O_CONVS + (size_t)(b * 3 + t - 1) * 1024 + ch] = cvs[q]; }
    if (tid < 128) p.out[O_NS + (size_t)(b * 4 + h) * 128 + tid] = nn;
    if (tid == 0) p.out[O_MS + b * 4 + h] = mt_[3];
    __syncthreads();
    { const int t = tid >> 7; const float num = red[(0 * 4 + t) * 128 + dv] + red[(1 * 4 + t) * 128 + dv] + red[(2 * 4 + t) * 128 + dv] + red[(3 * 4 + t) * 128 + dv];
      const float den = dred[t * 2] + dred[t * 2 + 1];
      const float mtv = t == 0 ? mt_[0] : t == 1 ? mt_[1] : t == 2 ? mt_[2] : mt_[3];
      const float hv = num / fmaxf(fabsf(den), __expf(-mtv));
      const float sq = wsum(hv * hv); if (lane == 0) sred[t * 2 + (wid & 1)] = sq;
      __syncthreads();
      const float rstd = rsqrtf((sred[t * 2] + sred[t * 2 + 1]) * (1.0f / 128) + 1e-6f);
      const size_t row = (size_t)(NTP + b * 4 + t);
      ((bf16_t*)(p.ws + WS_MIXED))[row * DM + 512 + h * 128 + dv] = f2bf(hv * rstd * mhr * __uint_as_float(ggr << 16)); }
}

DI void phase2(const Params& p, LAS uchar* lds) {
    const int nb = gridDim.x, bid = blockIdx.x, tid = threadIdx.x;
#ifndef REP_AP
#define REP_AP 1
#define REP_MU 1
#define REP_AS 1
#define REP_MS 1
#endif
    const bool late = ((bid >> 3) & 1) == 0;
    if (!late) { for (int it = bid; it < 256; it += nb) attn_sample_item(p, lds, it);
                 for (int it = bid; it < 512; it += nb) mlstm_sample_item(p, lds, it); }
    for (int it = bid; it < 256; it += nb) attn_prompt_item(p, lds, it);
    for (int it = bid; it < 512; it += nb) mlstm_u_item(p, lds, it);
    if (late) { for (int it = bid; it < 256; it += nb) attn_sample_item(p, lds, it);
                for (int it = bid; it < 512; it += nb) mlstm_sample_item(p, lds, it); }
    for (int i = bid * 512 + tid; i < 6144; i += nb * 512) { const int ch = i & 1023, rr = (i >> 10) % 3, b = i / 3072;
        p.out[O_CONVP + i] = __uint_as_float((unsigned)((const bf16_t*)(p.ws + WS_PROJ))[(size_t)(b * SEQ + SEQ - 3 + rr) * NPJ + C_MQ + ch] << 16); }
}
DI void phase4(const Params& p, LAS uchar* lds) {
    const int nb = gridDim.x, bid = blockIdx.x;
    for (int it = bid; it < 512; it += nb) mlstm_out_item(p, lds, it);
}

__global__ __launch_bounds__(512, 2) void hymba_mega(Params p, int ph_lo, int ph_hi) {
    extern __shared__ __attribute__((aligned(16))) unsigned char shm[];
    LAS uchar* lds = (LAS uchar*)shm;
    volatile LAS unsigned* st = (volatile LAS unsigned*)(lds + LDS_MAIN);
    if (threadIdx.x == 0) { st[0] = 0u; st[1] = 0u; }
    __syncthreads();
    const XcdBarrier xb = xcd_barrier_post((unsigned*)(p.ws + WS_BAR), st);
#ifdef PROBE_K
#define STAMP(i) ts[i] = wall_clock64();
    unsigned long long ts[7];
#else
#define STAMP(i)
#endif
#define RUNPH(n, call) if (ph_lo <= n && n < ph_hi) { if (ph_lo < n) xcd_barrier(xb); STAMP(n) call; }
    RUNPH(0, phase0(p, lds)) RUNPH(1, phase1(p, lds)) RUNPH(2, phase2(p, lds)) RUNPH(3, mlstm_scan(p, lds)) RUNPH(4, phase4(p, lds)) RUNPH(5, phase5(p, lds))
#ifdef PROBE_K
    xcd_barrier(xb); STAMP(6)
    if (blockIdx.x == 0 && threadIdx.x == 0) { const unsigned long long dt = (ts[PROBE_K + 1] - ts[PROBE_K]) * 4ull; while (wall_clock64() - ts[6] < dt) __builtin_amdgcn_s_sleep(8); }
#endif
}

#ifndef N_LAUNCHES
#define N_LAUNCHES 1
#endif
extern "C" void kernel_launch(void* const* d_in, const int* in_sizes, int n_in, void* d_out, int out_size, void* d_ws, size_t ws_size, hipStream_t stream) {
    static int grid = 0;
    if (grid == 0) {
        int dev = 0, cus = 0, per_cu = 0;
        hipGetDevice(&dev); hipDeviceGetAttribute(&cus, hipDeviceAttributeMultiprocessorCount, dev);
        if (hipFuncSetAttribute((const void*)hymba_mega, hipFuncAttributeMaxDynamicSharedMemorySize, LDS_BYTES) != hipSuccess) { fprintf(stderr, "hipFuncSetAttribute failed\n"); }
        if (hipOccupancyMaxActiveBlocksPerMultiprocessor(&per_cu, (const void*)hymba_mega, 512, LDS_BYTES) != hipSuccess || per_cu < 1) { fprintf(stderr, "occupancy query: %d\n", per_cu); per_cu = 1; }
        (void)hipGetLastError();
        grid = cus * per_cu;
        if (ws_size < WS_END || n_in != 18) { fprintf(stderr, "bad ws/n_in\n"); grid = -1; }
    }
    if (grid < 0) return;
    if (hipMemsetAsync((char*)d_ws + WS_BAR, 0, XCD_BAR_WORDS * sizeof(unsigned), stream) != hipSuccess) { fprintf(stderr, "memset failed\n"); return; }
    Params p{};
    p.x_p = (const float*)d_in[0]; p.x_s = (const float*)d_in[1]; p.ck = (const float*)d_in[2]; p.cv = (const float*)d_in[3]; p.sconv = (const float*)d_in[4];
    p.sC = (const float*)d_in[5]; p.sn = (const float*)d_in[6]; p.sm = (const float*)d_in[7]; p.norm_w = (const float*)d_in[8]; p.w_in = (const float*)d_in[9];
    p.b_gates = (const float*)d_in[10]; p.conv_w = (const float*)d_in[11]; p.conv_b = (const float*)d_in[12]; p.qnw = (const float*)d_in[13]; p.knw = (const float*)d_in[14];
    p.sinks = (const float*)d_in[15]; p.mhw = (const float*)d_in[16]; p.w_out = (const float*)d_in[17];
    p.out = (float*)d_out; p.ws = (uchar*)d_ws;
    if (N_LAUNCHES == 1) {
#ifdef PLAIN_LAUNCH
        hipLaunchKernelGGL(hymba_mega, dim3(grid), dim3(512), LDS_BYTES, stream, p, 0, 6);
#else
        int lo = 0, hi = 6; void* args[] = {&p, &lo, &hi};
        hipError_t e = hipLaunchCooperativeKernel((const void*)hymba_mega, dim3(grid), dim3(512), args, LDS_BYTES, stream);
        if (e != hipSuccess) fprintf(stderr, "cooperative launch failed: %s (grid %d)\n", hipGetErrorString(e), grid);
#endif
    } else {
#ifndef PHLIST
#define PHLIST {0, 1, 2, 3, 4, 5}
#endif
        const int phl[] = PHLIST;
        for (int i = 0; i < (int)(sizeof(phl) / sizeof(int)); ++i) hipLaunchKernelGGL(hymba_mega, dim3(grid), dim3(512), LDS_BYTES, stream, p, phl[i], phl[i] + 1);
    }
}
```

```cpp
#define N_LAUNCHES 1
#include <hip/hip_runtime.h>
#include <hip/hip_cooperative_groups.h>
#include <cstdio>
namespace cg = cooperative_groups;
#define LAS __attribute__((address_space(3)))
namespace pg8 {
#define PG8_LAS __attribute__((address_space(3)))
typedef unsigned short bf16_t;
typedef short bf16x8 __attribute__((ext_vector_type(8)));
typedef float f32x4 __attribute__((ext_vector_type(4)));
typedef unsigned u32x4 __attribute__((ext_vector_type(4)));
constexpr int BM = 256, BK = 64, HALF = 128, HTB = HALF * BK * 2  , STAGE_BYTES = 8 * HTB, NXCD = 8, WGM = 8;

__host__ __device__ __forceinline__ int lds_byte(int r, int c) { const int st = (r >> 4) * 2 + (c >> 5), rr = r & 15, cc = c & 31, ob = rr * 64 + cc * 2; return st * 1024 + (ob ^ (((ob >> 9) & 1) << 5)); }
__host__ __device__ __forceinline__ void stage_rc(int b, int& R, int& C) { const int st = b / 1024, sb = b % 1024, swz = sb ^ (((sb >> 9) & 1) << 5); R = (st >> 1) * 16 + swz / 64; C = (st & 1) * 32 + (swz % 64) / 2; }
__host__ __device__ __forceinline__ int perm32(int rho) { const int n = rho >> 4, i = rho & 15; return 8 * (i >> 2) + 4 * n + (i & 3); }

struct Unit { int pm, pn; };
struct Gemm { const bf16_t* A; const bf16_t* Bt; int M, N, K; };

struct StaticOrder {
    int nM, nN, nwg, G, c;
    __host__ __device__ void init(int M, int N, int G_, int c_) { nM = M / BM; nN = N / BM; nwg = nM * nN; G = G_; c = c_; }
    __host__ __device__ bool next(int i, Unit& u) const {
        const long L = (long)i * G + c; if (L >= nwg) return false;
        int wgid = (int)L; { const int q = nwg / NXCD, r = nwg % NXCD, xcd = wgid % NXCD, off = wgid / NXCD; wgid = (xcd < r ? xcd * (q + 1) : r * (q + 1) + (xcd - r) * q) + off; }
        const int nig = WGM * nN, gid = wgid / nig, fm = gid * WGM, gsz = (nM - fm) < WGM ? (nM - fm) : WGM;
        u.pm = fm + ((wgid % nig) % gsz); u.pn = (wgid % nig) / gsz; return true;
    }
    __device__ __forceinline__ void a_ready(const Unit&) const {}
    __device__ __forceinline__ void done(const Unit&) const {}
};
__device__ __forceinline__ unsigned cvt_pk_bf16(float lo, float hi) { unsigned r; asm volatile("v_cvt_pk_bf16_f32 %0, %1, %2" : "=v"(r) : "v"(lo), "v"(hi)); return r; }
template <class Epi, class Sched, bool STAMP = false>
__device__ __forceinline__ void gemm_phase(PG8_LAS unsigned char* lds, const Gemm g, const Sched& S, const Epi& E, unsigned long long* stamps) {
    const int tid = threadIdx.x, wid = __builtin_amdgcn_readfirstlane(tid >> 6), lane = tid & 63, wr = wid >> 2, wc = wid & 3, fr = lane & 15, fq = lane >> 4;
    const int K = g.K, nt = K / BK;
    int ts_lo = 0, ts_hi = 0, nts = 0; const unsigned long long rt_entry = STAMP ? (unsigned long long)wall_clock64() : 0ull;
#define PG8_STAMP() do { if (STAMP && wid == 0 && nts < 64) { const unsigned long long _c = (unsigned long long)clock64(); \
        ts_lo = (lane == nts) ? (int)(unsigned)_c : ts_lo; ts_hi = (lane == nts) ? (int)(unsigned)(_c >> 32) : ts_hi; ++nts; } } while (0)
    PG8_STAMP();
    unsigned voffA[2], voffB[2];
#pragma unroll
    for (int i = 0; i < 2; ++i) { int R, C; stage_rc(tid * 16 + i * 8192, R, C); const int Rb = Epi::PERM ? ((R & ~31) + perm32(R & 31)) : R;
        voffA[i] = (unsigned)(R * K + C) * 2u; voffB[i] = (unsigned)(Rb * K + C) * 2u; }
    const size_t kstep = (size_t)(BK * 2);
    const size_t hstep = (size_t)HALF * K * 2;
    const size_t tstep = 2 * hstep;
    const unsigned ldsw = (unsigned)wid * 1024u;
    const int aoff = lds_byte(wr * 64 + fr, fq * 8), boff = lds_byte(wc * 32 + fr, fq * 8);
#define PG8_SA(b, h) (((b) * 2 + (h)) * HTB)
#define PG8_SB(b, h) ((4 + (b) * 2 + (h)) * HTB)
#define PG8_STAGE(bufoff, gbase, voff) do { _Pragma("unroll") for (int _i = 0; _i < 2; ++_i) \
        __builtin_amdgcn_global_load_lds((const unsigned*)((const char*)(gbase) + (voff)[_i]), (PG8_LAS unsigned*)(lds + (bufoff) + ldsw + _i * 8192), 16, 0, 0); } while (0)
#define PG8_LDA(dst, b, h) do { _Pragma("unroll") for (int m = 0; m < 4; ++m) _Pragma("unroll") for (int k = 0; k < 2; ++k) dst[m][k] = *(const PG8_LAS bf16x8*)(lds + PG8_SA(b, h) + aoff + m * 2048 + k * 1024); } while (0)
#define PG8_LDB(dst, b, h) do { _Pragma("unroll") for (int n = 0; n < 2; ++n) _Pragma("unroll") for (int k = 0; k < 2; ++k) dst[n][k] = *(const PG8_LAS bf16x8*)(lds + PG8_SB(b, h) + boff + n * 2048 + k * 1024); } while (0)
#define PG8_MMA(ai, bj, At, Bt) do { __builtin_amdgcn_s_setprio(1); _Pragma("unroll") for (int m = 0; m < 4; ++m) _Pragma("unroll") for (int n = 0; n < 2; ++n) _Pragma("unroll") for (int k = 0; k < 2; ++k) \
        acc[ai][bj][m][n] = __builtin_amdgcn_mfma_f32_16x16x32_bf16(Bt[n][k], At[m][k], acc[ai][bj][m][n], 0, 0, 0); __builtin_amdgcn_s_setprio(0); } while (0)
#define PG8_WAIT_V(n) asm volatile("s_waitcnt vmcnt(" #n ")" ::: "memory")
#define PG8_WAIT_L(n) asm volatile("s_waitcnt lgkmcnt(" #n ")" ::: "memory")
#define PG8_BAR __builtin_amdgcn_s_barrier()
#define PG8_SCHED __builtin_amdgcn_sched_barrier(0)
    Unit cur, nxt; int ui = 0;
    if (!S.next(0, cur)) return;
    f32x4 acc[2][2][4][2];
#pragma unroll
    for (int a = 0; a < 2; ++a)
#pragma unroll
        for (int b = 0; b < 2; ++b)
#pragma unroll
            for (int m = 0; m < 4; ++m)
#pragma unroll
                for (int n = 0; n < 2; ++n) acc[a][b][m][n] = (f32x4){0.f, 0.f, 0.f, 0.f};
    bf16x8 At[4][2], B0[2][2], B1[2][2];
    const char* cA = (const char*)g.A + (size_t)cur.pm * tstep; const char* cB = (const char*)g.Bt + (size_t)cur.pn * tstep;
    S.a_ready(cur);
    PG8_STAGE(PG8_SB(0, 0), cB, voffB); PG8_STAGE(PG8_SA(0, 0), cA, voffA); PG8_STAGE(PG8_SB(0, 1), cB + hstep, voffB); PG8_STAGE(PG8_SA(0, 1), cA + hstep, voffA);
    if (wr == 1) PG8_BAR;
    PG8_WAIT_V(4); PG8_BAR;
    PG8_STAGE(PG8_SB(1, 0), cB + kstep, voffB); PG8_STAGE(PG8_SA(1, 0), cA + kstep, voffA); PG8_STAGE(PG8_SB(1, 1), cB + hstep + kstep, voffB);
    PG8_WAIT_V(6); PG8_BAR;
    PG8_STAMP();
    for (;;) {
        const bool has_next = S.next(ui + 1, nxt);
        const char* nA = has_next ? (const char*)g.A + (size_t)nxt.pm * tstep : cA; const char* nB = has_next ? (const char*)g.Bt + (size_t)nxt.pn * tstep : cB;
        for (int t = 0; t < nt; t += 2) {
            const bool last = (t == nt - 2);
            const char* a1 = cA + (size_t)(t + 1) * kstep;
            const char* a2 = last ? nA : cA + (size_t)(t + 2) * kstep; const char* b2 = last ? nB : cB + (size_t)(t + 2) * kstep;
            const char* a3 = a2 + kstep; const char* b3 = b2 + kstep;
            if (last && has_next) S.a_ready(nxt);
            PG8_LDB(B0, 0, 0); PG8_SCHED; PG8_LDA(At, 0, 0); PG8_STAGE(PG8_SA(1, 1), a1 + hstep, voffA);
            PG8_WAIT_L(8); PG8_BAR; PG8_WAIT_L(0); PG8_MMA(0, 0, At, B0); PG8_BAR; PG8_SCHED;
            PG8_LDB(B1, 0, 1); PG8_STAGE(PG8_SB(0, 0), b2, voffB);
            PG8_BAR; PG8_WAIT_L(0); PG8_MMA(0, 1, At, B1); PG8_BAR;
            PG8_LDA(At, 0, 1); PG8_STAGE(PG8_SA(0, 0), a2, voffA);
            PG8_BAR; PG8_WAIT_L(0); PG8_MMA(1, 0, At, B0); PG8_BAR; PG8_SCHED;
            PG8_STAGE(PG8_SB(0, 1), b2 + hstep, voffB);
            PG8_WAIT_V(6); PG8_BAR; PG8_MMA(1, 1, At, B1); PG8_BAR;
            PG8_LDB(B0, 1, 0); PG8_SCHED; PG8_LDA(At, 1, 0); PG8_STAGE(PG8_SA(0, 1), a2 + hstep, voffA);
            PG8_WAIT_L(8); PG8_BAR; PG8_WAIT_L(0); PG8_MMA(0, 0, At, B0); PG8_BAR; PG8_SCHED;
            PG8_LDB(B1, 1, 1); PG8_STAGE(PG8_SB(1, 0), b3, voffB);
            PG8_BAR; PG8_WAIT_L(0); PG8_MMA(0, 1, At, B1); PG8_BAR;
            PG8_LDA(At, 1, 1); PG8_STAGE(PG8_SA(1, 0), a3, voffA);
            PG8_BAR; PG8_WAIT_L(0); PG8_MMA(1, 0, At, B0); PG8_BAR; PG8_SCHED;
            PG8_STAGE(PG8_SB(1, 1), b3 + hstep, voffB);
            PG8_WAIT_V(6); PG8_BAR; PG8_MMA(1, 1, At, B1); PG8_BAR;
        }
        PG8_STAMP();
        if constexpr (!Epi::AFTER_DRAIN) { E(acc, cur, wr, wc, fr, fq); S.done(cur); }
        PG8_STAMP();
        if (!has_next) break;
#pragma unroll
        for (int a = 0; a < 2; ++a)
#pragma unroll
            for (int b = 0; b < 2; ++b)
#pragma unroll
                for (int m = 0; m < 4; ++m)
#pragma unroll
                    for (int n = 0; n < 2; ++n) acc[a][b][m][n] = (f32x4){0.f, 0.f, 0.f, 0.f};
        cur = nxt; cA = nA; cB = nB; ++ui;
    }
    PG8_WAIT_V(0);
    if (wr == 0) PG8_BAR;
    PG8_BAR;
    if constexpr (Epi::AFTER_DRAIN) { E.fused(acc, cur, wr, wc, fr, fq, lds, wid, lane); S.done(cur); }
    PG8_STAMP();
    if (STAMP && wid == 0) { stamps[lane] = lane < nts ? (((unsigned long long)(unsigned)ts_hi << 32) | (unsigned)ts_lo) : 0ull;
        if (lane == 62) stamps[62] = rt_entry; if (lane == 63) stamps[63] = (unsigned long long)wall_clock64(); }
#undef PG8_STAMP
#undef PG8_SA
#undef PG8_SB
#undef PG8_STAGE
#undef PG8_LDA
#undef PG8_LDB
#undef PG8_MMA
#undef PG8_WAIT_V
#undef PG8_WAIT_L
#undef PG8_BAR
#undef PG8_SCHED
}
}

#define XB_TMO      128
#define XB_XCNT(j)  (256  + 64 * (j))
#define XB_XSUB(j)  (1280 + 64 * (j))
#define XB_XGEN(j)  (2304 + 64 * (j))
#define XB_TOP      3328
#define XB_TOPGEN   3392
#define XCD_BAR_WORDS 3456
#define XB_SPIN_CAP (1u << 18)

__device__ __forceinline__ unsigned xb_ld(unsigned* p)              { return __hip_atomic_load(p, __ATOMIC_RELAXED, __HIP_MEMORY_SCOPE_AGENT); }
__device__ __forceinline__ unsigned xb_add(unsigned* p, unsigned v) { return __hip_atomic_fetch_add(p, v, __ATOMIC_RELAXED, __HIP_MEMORY_SCOPE_AGENT); }
__device__ __forceinline__ unsigned xb_xcc_id() { return (unsigned)__builtin_amdgcn_s_getreg((3 << 11) | 20) & 0xFu; }
#define XB_SPIN(cond, bar) do { unsigned _sp = 0; while (cond) { __builtin_amdgcn_s_sleep(1); \
    if ((++_sp & 255u) == 0u) { if (xb_ld(&(bar)[XB_TMO])) break; if (_sp > XB_SPIN_CAP) { atomicAdd(&(bar)[XB_TMO], 1u); break; } } } } while (0)

struct XcdBarrier {
    unsigned* bar; unsigned x;
    volatile LAS unsigned* st;
};

__device__ __forceinline__ XcdBarrier xcd_barrier_post(unsigned* bar, volatile LAS unsigned* st) {
    XcdBarrier b; b.bar = bar; b.x = xb_xcc_id(); b.st = st;
    if (threadIdx.x == 0) (void)xb_add(&bar[XB_XCNT(b.x)], 1u);
    return b;
}
__device__ __forceinline__ void xcd_barrier_complete(unsigned* bar, unsigned x, unsigned& nloc, unsigned& nx) {
    const unsigned G = gridDim.x * gridDim.y * gridDim.z;
    unsigned sum, cnt, mine, sp = 0u;
    for (;;) {
        sum = 0u; cnt = 0u; mine = 0u;
#pragma unroll
        for (unsigned j = 0; j < 16; ++j) { const unsigned c = xb_ld(&bar[XB_XCNT(j)]); sum += c; cnt += (c > 0u) ? 1u : 0u; mine = (j == x) ? c : mine; }
        if (sum == G) break;
        __builtin_amdgcn_s_sleep(1);
        if ((++sp & 255u) == 0u) { if (xb_ld(&bar[XB_TMO])) break; if (sp > XB_SPIN_CAP) { atomicAdd(&bar[XB_TMO], 1u); break; } }
    }
    nloc = mine > 0u ? mine : 1u; nx = cnt > 0u ? cnt : 1u;
}

__device__ __forceinline__ void xcd_barrier(const XcdBarrier& b) {
    asm volatile("s_waitcnt vmcnt(0)" ::: "memory");
    __syncthreads();
    if (threadIdx.x == 0) {
        unsigned* bar = b.bar;
        __builtin_amdgcn_s_waitcnt(0);
        unsigned nloc = b.st[0], nx = b.st[1];
        if (nloc == 0u) { xcd_barrier_complete(bar, b.x, nloc, nx); b.st[0] = nloc; b.st[1] = nx; }
        const unsigned old = xb_add(&bar[XB_XSUB(b.x)], 1u);
        const unsigned gen = old / nloc;
        if (old + 1u == (gen + 1u) * nloc) {
            __builtin_amdgcn_fence(__ATOMIC_RELEASE, "agent");
            asm volatile("s_waitcnt vmcnt(0)" ::: "memory");
            const unsigned og = xb_add(&bar[XB_TOP], 1u);
            const unsigned tg = og / nx;
            if (og + 1u == (tg + 1u) * nx) xb_add(&bar[XB_TOPGEN], 1u);
            else XB_SPIN(xb_ld(&bar[XB_TOPGEN]) == tg, bar);
            __builtin_amdgcn_fence(__ATOMIC_ACQUIRE, "agent");
            xb_add(&bar[XB_XGEN(b.x)], 1u);
            asm volatile("s_waitcnt vmcnt(0)" ::: "memory");
        } else {
            XB_SPIN(xb_ld(&bar[XB_XGEN(b.x)]) == gen, bar);
            __builtin_amdgcn_fence(__ATOMIC_ACQUIRE, "agent");
            asm volatile("s_waitcnt vmcnt(0)" ::: "memory");
        }
    }
    __syncthreads();
}

using pg8::bf16_t; using pg8::bf16x8; using pg8::f32x4; using pg8::u32x4;
#define DI __device__ __forceinline__
typedef unsigned char uchar;
typedef unsigned u32x2 __attribute__((ext_vector_type(2)));

constexpr int NTP = 16384, NTS = 512, NTOK = 16896, DM = 1024, DIN = 3848, NGE = 3840, NPJ = 3328, SEQ = 8192;
constexpr int C_AQ = 0, C_AK = 512, C_AV = 640, C_AG = 768, C_MQ = 1280, C_MK = 1792, C_MV = 2304, C_G = 2816;
constexpr int NCH = 64, CH = 128, USZ = 129 * 128;
constexpr size_t O_Y = 0, O_KWP = 17301504, O_VWP = 17334272, O_CONVP = 17367040, O_CP = 17373184, O_NP = 17504256, O_MP = 17505280,
                 O_KWS = 17505288, O_VWS = 19602440, O_CONVS = 21699592, O_CS = 22092808, O_NS = 30481416, O_MS = 30546952;
constexpr size_t WS_WTIN = 0, WS_WTOUT = 7864320, WS_H = 9961472, WS_GATES = 44564480, WS_ROPE = 45105152, WS_FM = 45637632,
                 WS_PROJ = 46161920, WS_UST = 175923200, WS_MIXED = 209739776, WS_BAR = 244342784, WS_SB = 244342784 + 16384, WS_END = WS_SB + 16908288;
constexpr int LDS_MAIN = 151552, LDS_BYTES = LDS_MAIN + 16;

struct Params {
    const float *x_p, *x_s, *ck, *cv, *sconv, *sC, *sn, *sm, *norm_w, *w_in, *b_gates, *conv_w, *conv_b, *qnw, *knw, *sinks, *mhw, *w_out;
    float* out; uchar* ws;
};

DI float bflo(unsigned w) { return __uint_as_float(w << 16); }
DI float bfhi(unsigned w) { return __uint_as_float(w & 0xffff0000u); }
DI unsigned pk2(float a, float b) { return pg8::cvt_pk_bf16(a, b); }
DI bf16_t f2bf(float f) { unsigned u = __float_as_uint(f); u += 0x7fffu + ((u >> 16) & 1u); return (bf16_t)(u >> 16); }
DI void unpack8(const u32x4 w, float (&f)[8]) { f[0] = bflo(w.x); f[1] = bfhi(w.x); f[2] = bflo(w.y); f[3] = bfhi(w.y); f[4] = bflo(w.z); f[5] = bfhi(w.z); f[6] = bflo(w.w); f[7] = bfhi(w.w); }
DI u32x4 pack8(const float (&f)[8]) { u32x4 w; w.x = pk2(f[0], f[1]); w.y = pk2(f[2], f[3]); w.z = pk2(f[4], f[5]); w.w = pk2(f[6], f[7]); return w; }
DI float wsum(float v) { for (int o = 32; o; o >>= 1) v += __shfl_xor(v, o); return v; }
DI float silu(float x) { return x * __builtin_amdgcn_rcpf(1.0f + __builtin_amdgcn_exp2f(-1.4426950408889634f * x)); }
DI float sigm(float x) { return __builtin_amdgcn_rcpf(1.0f + __builtin_amdgcn_exp2f(-1.4426950408889634f * x)); }
DI f32x4 mfma16(bf16x8 a, bf16x8 b, f32x4 c) { return __builtin_amdgcn_mfma_f32_16x16x32_bf16(a, b, c, 0, 0, 0); }

typedef float f32x2g __attribute__((ext_vector_type(2)));
DI void norm_row(const Params& p, const LAS float* wg, int row, const float4 (&xv)[4], const float4 (&nw)[4], float bgl, int lane) {
    bf16_t* H = (bf16_t*)(p.ws + WS_H); float* gates = (float*)(p.ws + WS_GATES);
    float ss = 0.f;
#pragma unroll
    for (int i = 0; i < 4; ++i) ss += xv[i].x * xv[i].x + xv[i].y * xv[i].y + xv[i].z * xv[i].z + xv[i].w * xv[i].w;
    ss = wsum(ss); const float rstd = rsqrtf(ss * (1.0f / DM) + 1e-6f);
    f32x2g g2[8];
#pragma unroll
    for (int j = 0; j < 8; ++j) g2[j] = (f32x2g){0.f, 0.f};
    u32x2 hw[4];
#pragma unroll
    for (int i = 0; i < 4; ++i) { const int d0 = i * 256 + lane * 4;
        const f32x2g ha = (f32x2g){xv[i].x, xv[i].y} * rstd * (f32x2g){nw[i].x, nw[i].y}, hb = (f32x2g){xv[i].z, xv[i].w} * rstd * (f32x2g){nw[i].z, nw[i].w};
        hw[i].x = pk2(ha.x, ha.y); hw[i].y = pk2(hb.x, hb.y);
#pragma unroll
        for (int j = 0; j < 8; ++j) { const f32x4 wv = *(const LAS f32x4*)(wg + j * 1024 + d0); g2[j] += ha * (f32x2g){wv[0], wv[1]}; g2[j] += hb * (f32x2g){wv[2], wv[3]}; } }
#pragma unroll
    for (int i = 0; i < 4; ++i) *(u32x2*)(H + (size_t)row * DM + i * 256 + lane * 4) = hw[i];
    float g[8];
#pragma unroll
    for (int j = 0; j < 8; ++j) g[j] = g2[j].x + g2[j].y;
    const bool b5 = lane & 32, b4 = lane & 16, b3 = lane & 8;
    float r1[4], r2[2], r3;
#pragma unroll
    for (int j = 0; j < 4; ++j) { const float mine = b5 ? g[4 + j] : g[j], other = b5 ? g[j] : g[4 + j]; r1[j] = mine + __shfl_xor(other, 32); }
#pragma unroll
    for (int j = 0; j < 2; ++j) { const float mine = b4 ? r1[2 + j] : r1[j], other = b4 ? r1[j] : r1[2 + j]; r2[j] = mine + __shfl_xor(other, 16); }
    { const float mine = b3 ? r2[1] : r2[0], other = b3 ? r2[0] : r2[1]; r3 = mine + __shfl_xor(other, 8); }
    r3 += __shfl_xor(r3, 4); r3 += __shfl_xor(r3, 2); r3 += __shfl_xor(r3, 1);
    const float z = r3 + bgl; const int gi = lane >> 3;
    const float lf = fminf(z, 0.f) - __logf(1.0f + __expf(-fabsf(z)));
    if ((lane & 7) == 0) gates[(size_t)row * 8 + gi] = gi < 4 ? z : lf;
}
DI void transpose_tiles(const Params& p, LAS uchar* lds, int tlo, int thi, int part, int nparts) {
    const int tid = threadIdx.x;
    LAS float* tile = (LAS float*)lds;
    for (int t0 = tlo + part * 2; t0 < thi; t0 += nparts * 2) {
        const float* src[2]; bf16_t* dst[2]; int ld[2], k0[2], n0[2], sc0[2];
#pragma unroll
        for (int q = 0; q < 2; ++q) { const int t = t0 + q;
            if (t < 960) { const int nt = t % 60, kt = t / 60; n0[q] = nt * 64; k0[q] = kt * 64; sc0[q] = n0[q] < 2816 ? n0[q] : (((n0[q] - 2816) & 255) < 128 ? 2816 + ((n0[q] - 2816) >> 8) * 128 + ((n0[q] - 2816) & 255) : 3336 + ((n0[q] - 2816) >> 8) * 128 + ((n0[q] - 2816) & 255) - 128); src[q] = p.w_in; ld[q] = DIN; dst[q] = (bf16_t*)(p.ws + WS_WTIN); }
            else { const int t2 = t - 960, nt = t2 % 16, kt = t2 / 16; n0[q] = nt * 64; k0[q] = kt * 64; sc0[q] = n0[q]; src[q] = p.w_out; ld[q] = DM; dst[q] = (bf16_t*)(p.ws + WS_WTOUT); } }
        float4 v[2][2];
#pragma unroll
        for (int q = 0; q < 2; ++q)
#pragma unroll
            for (int ps = 0; ps < 2; ++ps) { const int kk = (tid >> 4) + 32 * ps, nn4 = (tid & 15) * 4; v[q][ps] = *(const float4*)(src[q] + (size_t)(k0[q] + kk) * ld[q] + sc0[q] + nn4); }
#pragma unroll
        for (int q = 0; q < 2; ++q)
#pragma unroll
            for (int ps = 0; ps < 2; ++ps) { const int kk = (tid >> 4) + 32 * ps, nn4 = (tid & 15) * 4; LAS float* tl = tile + q * 4160 + kk * 65 + nn4; tl[0] = v[q][ps].x; tl[1] = v[q][ps].y; tl[2] = v[q][ps].z; tl[3] = v[q][ps].w; }
        __syncthreads();
#pragma unroll
        for (int q = 0; q < 2; ++q) { const int nn = tid >> 3, kk8 = (tid & 7) * 8; float f[8];
#pragma unroll
          for (int j = 0; j < 8; ++j) f[j] = tile[q * 4160 + (kk8 + j) * 65 + nn];
          *(u32x4*)(dst[q] + (size_t)(n0[q] + nn) * DM + k0[q] + kk8) = pack8(f); }
        __syncthreads();
    }
}
DI void rope_table(const Params& p, int part, int nparts) {
    const int tid = threadIdx.x;
    { float2* rope = (float2*)(p.ws + WS_ROPE);
      for (int idx = part * 512 + tid; idx < 8200 * 8; idx += nparts * 512) { const int pos = idx >> 3, i = idx & 7;
          const float invf = (float)exp(-(double)i * 0.125 * 13.122363377404328);
          const float ang = (float)pos * invf;
          const double q = rint((double)ang * 0.6366197723675814), r = (double)ang - q * 1.5707963267948966, r2 = r * r;
          const double s = r * (1.0 + r2 * (-1.0 / 6 + r2 * (1.0 / 120 + r2 * (-1.0 / 5040 + r2 * (1.0 / 362880 + r2 * (-1.0 / 39916800 + r2 * (1.0 / 6227020800.0)))))));
          const double c = 1.0 + r2 * (-0.5 + r2 * (1.0 / 24 + r2 * (-1.0 / 720 + r2 * (1.0 / 40320 + r2 * (-1.0 / 3628800 + r2 * (1.0 / 479001600.0))))));
          const int qi = ((int)q) & 3; double cs, sn;
          if (qi == 0) { sn = s; cs = c; } else if (qi == 1) { sn = c; cs = -s; } else if (qi == 2) { sn = -s; cs = -c; } else { sn = -c; cs = s; }
          rope[idx] = make_float2((float)cs, (float)sn); } }
}
DI void phase0(const Params& p, LAS uchar* lds) {
    const int tid = threadIdx.x, lane = tid & 63, wid = tid >> 6, nb = gridDim.x, bid = blockIdx.x;
#ifndef REP_TR
#define REP_TR 1
#define REP_ROW 1
#define REP_ROPE 1
#endif
    transpose_tiles(p, lds, 0, 960, bid, nb);
    LAS float* wg = (LAS float*)(lds + 32768);
    for (int d = tid; d < DM; d += 512) { const float4 a = *(const float4*)(p.w_in + (size_t)d * DIN + 3328), b = *(const float4*)(p.w_in + (size_t)d * DIN + 3332);
        wg[d] = a.x; wg[1024 + d] = a.y; wg[2048 + d] = a.z; wg[3072 + d] = a.w; wg[4096 + d] = b.x; wg[5120 + d] = b.y; wg[6144 + d] = b.z; wg[7168 + d] = b.w; }
    __syncthreads();
    float4 nwr[4];
#pragma unroll
    for (int i = 0; i < 4; ++i) nwr[i] = *(const float4*)(p.norm_w + i * 256 + lane * 4);
    const float bgr = p.b_gates[lane >> 3];
    for (int rp = 0; rp < REP_ROW; ++rp)
    for (int row = bid * 8 + wid; row < NTOK; row += nb * 16) {
        const int row2 = row + nb * 8; const bool has2 = row2 < NTOK; const int r2 = has2 ? row2 : row;
        const float* xa = row < NTP ? p.x_p + (size_t)row * DM : p.x_s + (size_t)(row - NTP) * DM;
        const float* xb = r2 < NTP ? p.x_p + (size_t)r2 * DM : p.x_s + (size_t)(r2 - NTP) * DM;
        float4 va[4], vb[4];
#pragma unroll
        for (int i = 0; i < 4; ++i) va[i] = *(const float4*)(xa + i * 256 + lane * 4);
#pragma unroll
        for (int i = 0; i < 4; ++i) vb[i] = *(const float4*)(xb + i * 256 + lane * 4);
        norm_row(p, wg, row, va, nwr, bgr, lane);
        if (has2) norm_row(p, wg, row2, vb, nwr, bgr, lane);
    }
}

DI float block_excl_sum(float v, LAS float* red, int tid) {
    const int lane = tid & 63, wid = tid >> 6; float inc = v;
#pragma unroll
    for (int o = 1; o < 64; o <<= 1) { const float t = __shfl_up(inc, o); if (lane >= o) inc += t; }
    __syncthreads(); if (lane == 63) red[wid] = inc; __syncthreads();
    float base = 0.f;
#pragma unroll
    for (int w = 0; w < 8; ++w) base += (w < wid) ? red[w] : 0.f;
    return base + inc - v;
}
DI float block_excl_max(float v, LAS float* red, int tid) {
    const int lane = tid & 63, wid = tid >> 6; float inc = v;
#pragma unroll
    for (int o = 1; o < 64; o <<= 1) { const float t = __shfl_up(inc, o); if (lane >= o) inc = fmaxf(inc, t); }
    __syncthreads(); if (lane == 63) red[wid] = inc; __syncthreads();
    float base = -INFINITY;
#pragma unroll
    for (int w = 0; w < 8; ++w) base = fmaxf(base, (w < wid) ? red[w] : -INFINITY);
    float ex = __shfl_up(inc, 1); if (lane == 0) ex = -INFINITY;
    return fmaxf(base, ex);
}
DI void gate_scan(const Params& p, LAS uchar* lds, int bh) {
    const int tid = threadIdx.x, b = bh >> 2, h = bh & 3, t0 = tid * 16;
    const float* gates = (const float*)(p.ws + WS_GATES); float2* FM = (float2*)(p.ws + WS_FM) + (size_t)bh * SEQ;
    LAS float* red = (LAS float*)lds;
    float li[16], F[16];
    float run = 0.f;
#pragma unroll
    for (int j = 0; j < 16; ++j) { const float* g = gates + (size_t)(b * SEQ + t0 + j) * 8; li[j] = g[h]; run += g[4 + h]; F[j] = run; }
    const float base = block_excl_sum(run, red, tid);
    float mx = -INFINITY, ml[16];
#pragma unroll
    for (int j = 0; j < 16; ++j) { F[j] += base; mx = fmaxf(mx, li[j] - F[j]); ml[j] = mx; }
    const float mb = fmaxf(block_excl_max(mx, red, tid), 0.0f);
#pragma unroll
    for (int j = 0; j < 16; ++j) FM[t0 + j] = make_float2(F[j], F[j] + fmaxf(ml[j], mb));
    __syncthreads();
}

struct EpiProj {
    static constexpr bool PERM = true, AFTER_DRAIN = false;
    bf16_t* O;
    __device__ __forceinline__ void operator()(const f32x4 (&acc)[2][2][4][2], const pg8::Unit& u, int wr, int wc, int fr, int fq) const {
        const int row0 = u.pm * 256 + wr * 64 + fr;
        if (u.pn < 11) { const int col0 = u.pn * 256 + wc * 32 + 8 * fq; const bool gate = (u.pn == 3) || (u.pn == 4);
#pragma unroll
            for (int ai = 0; ai < 2; ++ai)
#pragma unroll
                for (int m = 0; m < 4; ++m) { bf16_t* rowp = O + (size_t)(row0 + ai * 128 + m * 16) * NPJ + col0;
#pragma unroll
                    for (int bj = 0; bj < 2; ++bj) { f32x4 v0 = acc[ai][bj][m][0], v1 = acc[ai][bj][m][1];
                        if (gate) {
#pragma unroll
                            for (int e = 0; e < 4; ++e) { v0[e] = silu(v0[e]); v1[e] = silu(v1[e]); } }
                        u32x4 w; w.x = pk2(v0[0], v0[1]); w.y = pk2(v0[2], v0[3]); w.z = pk2(v1[0], v1[1]); w.w = pk2(v1[2], v1[3]);
                        *(u32x4*)(rowp + bj * 128) = w; } }
        } else { const int col0 = C_G + (u.pn - 11) * 128 + wc * 32 + 8 * fq;
#pragma unroll
            for (int ai = 0; ai < 2; ++ai)
#pragma unroll
                for (int m = 0; m < 4; ++m) { float g[8];
#pragma unroll
                    for (int n = 0; n < 2; ++n)
#pragma unroll
                        for (int e = 0; e < 4; ++e) { const float o = acc[ai][0][m][n][e], z = acc[ai][1][m][n][e];
                            g[4 * n + e] = z * __builtin_amdgcn_rcpf((1.0f + __builtin_amdgcn_exp2f(-1.4426950408889634f * o)) * (1.0f + __builtin_amdgcn_exp2f(-1.4426950408889634f * z))); }
                    *(u32x4*)(O + (size_t)(row0 + ai * 128 + m * 16) * NPJ + col0) = pack8(g); }
        }
    }
};
struct EpiOut {
    static constexpr bool PERM = false, AFTER_DRAIN = false;
    float* Y; const float* xp;
    __device__ __forceinline__ void operator()(const f32x4 (&acc)[2][2][4][2], const pg8::Unit& u, int wr, int wc, int fr, int fq) const {
        const int row0 = u.pm * 256 + wr * 64 + fr, col0 = u.pn * 256 + wc * 32 + 4 * fq;
#pragma unroll
        for (int ai = 0; ai < 2; ++ai)
#pragma unroll
            for (int mp = 0; mp < 2; ++mp) { f32x4 xv[2][2][2];
#pragma unroll
                for (int mm = 0; mm < 2; ++mm) { const float* xr = xp + (size_t)(row0 + ai * 128 + (mp * 2 + mm) * 16) * DM + col0;
#pragma unroll
                    for (int bj = 0; bj < 2; ++bj)
#pragma unroll
                        for (int n = 0; n < 2; ++n) xv[mm][bj][n] = *(const f32x4*)(xr + bj * 128 + n * 16); }
#pragma unroll
                for (int mm = 0; mm < 2; ++mm) { float* yr = Y + (size_t)(row0 + ai * 128 + (mp * 2 + mm) * 16) * DM + col0;
#pragma unroll
                    for (int bj = 0; bj < 2; ++bj)
#pragma unroll
                        for (int n = 0; n < 2; ++n) *(f32x4*)(yr + bj * 128 + n * 16) = acc[ai][bj][mp * 2 + mm][n] + xv[mm][bj][n]; } }
    }
};
DI void phase1(const Params& p, LAS uchar* lds) {
    const int nb = gridDim.x, bid = blockIdx.x;
    if (bid >= nb - 8) gate_scan(p, lds, bid - (nb - 8));
    {
        const int nun = (NTOK / 256) * (NGE / 256), rounds = (nun + nb - 1) / nb, first_light = nun - (rounds - 1) * nb;
        int part = bid - first_light, nparts = nb - 8 - first_light;
        if (nparts < 8) { part = bid; nparts = nb; }
        if (part >= 0 && part < nparts) { transpose_tiles(p, lds, 960, 960 + 256, part, nparts); rope_table(p, part, nparts); }
    }
    pg8::Gemm g; g.A = (const bf16_t*)(p.ws + WS_H); g.Bt = (const bf16_t*)(p.ws + WS_WTIN); g.M = NTOK; g.N = NGE; g.K = DM;
    pg8::StaticOrder S; S.init(g.M, g.N, nb, bid);
    EpiProj E; E.O = (bf16_t*)(p.ws + WS_PROJ);
    pg8::gemm_phase<EpiProj, pg8::StaticOrder, false>(lds, g, S, E, nullptr);
}
DI void phase5(const Params& p, LAS uchar* lds) {
    const int nb = gridDim.x, bid = blockIdx.x;
    pg8::Gemm g; g.A = (const bf16_t*)(p.ws + WS_MIXED); g.Bt = (const bf16_t*)(p.ws + WS_WTOUT); g.M = NTP; g.N = DM; g.K = DM;
    pg8::StaticOrder S; S.init(g.M, g.N, nb, bid);
    EpiOut E; E.Y = p.out + O_Y; E.xp = p.x_p;
    pg8::gemm_phase<EpiOut, pg8::StaticOrder, false>(lds, g, S, E, nullptr);
}

constexpr int KSTR = 144, VSTR = 560, AT_K = 0, AT_V = 272 * KSTR, AT_R = AT_V + 64 * VSTR;
typedef float f32x2r __attribute__((ext_vector_type(2)));

DI void qk_norm_rope16(float (&x)[16], int pt, const float* nw, const float2* rope_row) {
    float ss = 0.f;
#pragma unroll
    for (int j = 0; j < 16; ++j) ss += x[j] * x[j];
    ss += __shfl_xor(ss, 1); ss += __shfl_xor(ss, 2);
    const float rstd = rsqrtf(ss * (1.0f / 64) + 1e-6f);
#pragma unroll
    for (int j = 0; j < 16; ++j) x[j] = x[j] * rstd * nw[pt * 16 + j];
    if (pt == 0) {
#pragma unroll
        for (int i = 0; i < 8; ++i) { const float2 cs = rope_row[i]; const float a = x[i], b = x[i + 8]; x[i] = a * cs.x - b * cs.y; x[i + 8] = b * cs.x + a * cs.y; } }
}
DI void qk_norm_rope16p(float (&x)[16], int pt, const float* nw, const float2 (&rp)[8]) {
    float ss = 0.f;
#pragma unroll
    for (int j = 0; j < 16; ++j) ss += x[j] * x[j];
    ss += __shfl_xor(ss, 1); ss += __shfl_xor(ss, 2);
    const float rstd = rsqrtf(ss * (1.0f / 64) + 1e-6f);
#pragma unroll
    for (int j = 0; j < 16; ++j) x[j] = x[j] * rstd * nw[pt * 16 + j];
    if (pt == 0) {
#pragma unroll
        for (int i = 0; i < 8; ++i) { const float2 cs = rp[i]; const float a = x[i], b = x[i + 8]; x[i] = a * cs.x - b * cs.y; x[i + 8] = b * cs.x + a * cs.y; } }
}
DI void kv_to_lds(LAS uchar* lds, int ki, int pt, const float (&xk)[16], const float (&xv)[16]) {
    float a[8], b[8];
#pragma unroll
    for (int j = 0; j < 8; ++j) { a[j] = xk[j]; b[j] = xk[8 + j]; }
    *(LAS u32x4*)(lds + AT_K + ki * KSTR + pt * 32) = pack8(a); *(LAS u32x4*)(lds + AT_K + ki * KSTR + pt * 32 + 16) = pack8(b);
#pragma unroll
    for (int j = 0; j < 16; j += 2) { const unsigned w = pk2(xv[j], xv[j + 1]);
        *(LAS bf16_t*)(lds + AT_V + (pt * 16 + j) * VSTR + ki * 2) = (bf16_t)(w & 0xffffu); *(LAS bf16_t*)(lds + AT_V + (pt * 16 + j + 1) * VSTR + ki * 2) = (bf16_t)(w >> 16); }
}
DI void load16bf(const bf16_t* src, float (&x)[16]) { const u32x4 w0 = *(const u32x4*)src, w1 = *(const u32x4*)(src + 8); float a[8], b[8]; unpack8(w0, a); unpack8(w1, b);
#pragma unroll
    for (int j = 0; j < 8; ++j) { x[j] = a[j]; x[8 + j] = b[j]; } }
DI void load16f(const float* src, float (&x)[16]) {
#pragma unroll
    for (int j = 0; j < 4; ++j) { const float4 v = *(const float4*)(src + 4 * j); x[4 * j] = v.x; x[4 * j + 1] = v.y; x[4 * j + 2] = v.z; x[4 * j + 3] = v.w; } }
DI void store16f(float* dst, const float (&x)[16]) {
#pragma unroll
    for (int j = 0; j < 4; ++j) *(float4*)(dst + 4 * j) = make_float4(x[4 * j], x[4 * j + 1], x[4 * j + 2], x[4 * j + 3]); }

struct QRaw { u32x4 q0, q1; u32x2 gw[4]; };
DI void attn_q_load(const Params& p, int row, int hqa, QRaw& qr) {
    const int lane = threadIdx.x & 63, quad = lane >> 4;
    const bf16_t* rowp = (const bf16_t*)(p.ws + WS_PROJ) + (size_t)row * NPJ;
    qr.q0 = *(const u32x4*)(rowp + C_AQ + hqa * 64 + 8 * quad); qr.q1 = *(const u32x4*)(rowp + C_AQ + hqa * 64 + 32 + 8 * quad);
#pragma unroll
    for (int mt = 0; mt < 4; ++mt) qr.gw[mt] = *(const u32x2*)(rowp + C_AG + hqa * 64 + 16 * mt + 4 * quad);
}
template <bool LROPE> DI void attn_q_tile(const Params& p, LAS uchar* lds, const QRaw& qr, const float (&qw0)[8], const float (&qw1)[8], int row, int pos, int hqa, int qi, int kt0, int kmin) {
    const int lane = threadIdx.x & 63, r = lane & 15, quad = lane >> 4;
    const float2* rope = (const float2*)(p.ws + WS_ROPE);
    float x0[8], x1[8];
    unpack8(qr.q0, x0); unpack8(qr.q1, x1);
    float ss = 0.f;
#pragma unroll
    for (int j = 0; j < 8; ++j) ss += x0[j] * x0[j] + x1[j] * x1[j];
    ss += __shfl_xor(ss, 16); ss += __shfl_xor(ss, 32);
    const float rstd = rsqrtf(ss * (1.0f / 64) + 1e-6f) ;
#pragma unroll
    for (int j = 0; j < 8; ++j) { x0[j] = x0[j] * rstd * qw0[j]; x1[j] = x1[j] * rstd * qw1[j]; }
#pragma unroll
    for (int j = 0; j < 8; ++j) { const float pj = __shfl_xor(x0[j], 16); float2 cs; if (LROPE) { const f32x2r c2 = *(const LAS f32x2r*)(lds + AT_R + qi * 64 + j * 8); cs = make_float2(c2.x, c2.y); } else cs = rope[(size_t)pos * 8 + j];
        const float rot = x0[j] * cs.x + (quad == 0 ? -pj : pj) * cs.y; x0[j] = (quad < 2) ? rot : x0[j]; }
#pragma unroll
    for (int j = 0; j < 8; ++j) { x0[j] *= 0.18033688011112042f; x1[j] *= 0.18033688011112042f; }
    const bf16x8 qf0 = __builtin_bit_cast(bf16x8, pack8(x0)), qf1 = __builtin_bit_cast(bf16x8, pack8(x1));
    const float sink = p.sinks[hqa] * 1.4426950408889634f;
    f32x4 s[9];
#pragma unroll
    for (int kt = 0; kt < 9; ++kt) { const int krow = (kt0 + kt) * 16 + r;
        const bf16x8 a0 = *(const LAS bf16x8*)(lds + AT_K + krow * KSTR + quad * 16), a1 = *(const LAS bf16x8*)(lds + AT_K + krow * KSTR + 64 + quad * 16);
        f32x4 acc = {0.f, 0.f, 0.f, 0.f}; acc = mfma16(a0, qf0, acc); acc = mfma16(a1, qf1, acc); s[kt] = acc; }
    float mx = sink;
#pragma unroll
    for (int kt = 0; kt < 9; ++kt) {
        if ((kt0 + kt) * 16 + 15 < kmin) { s[kt] = (f32x4){-INFINITY, -INFINITY, -INFINITY, -INFINITY}; }
        else {
            if (kt == 0) {
#pragma unroll
                for (int v = 0; v < 4; ++v) { const int ki = kt0 * 16 + quad * 4 + v; s[kt][v] = (ki > qi) ? s[kt][v] : -INFINITY; } }
            if (kt == 8) {
#pragma unroll
                for (int v = 0; v < 4; ++v) { const int ki = (kt0 + 8) * 16 + quad * 4 + v; s[kt][v] = (ki <= qi + 128) ? s[kt][v] : -INFINITY; } }
            mx = fmaxf(fmaxf(mx, fmaxf(s[kt][0], s[kt][1])), fmaxf(s[kt][2], s[kt][3])); } }
    mx = fmaxf(mx, __shfl_xor(mx, 16)); mx = fmaxf(mx, __shfl_xor(mx, 32));
    float sum = 0.f;
#pragma unroll
    for (int kt = 0; kt < 9; ++kt)
#pragma unroll
        for (int v = 0; v < 4; ++v) { const float e = __builtin_amdgcn_exp2f(s[kt][v] - mx); s[kt][v] = e; sum += e; }
    sum += __shfl_xor(sum, 16); sum += __shfl_xor(sum, 32);
    sum += __builtin_amdgcn_exp2f(sink - mx);
    const float inv = __builtin_amdgcn_rcpf(sum);
    f32x4 o[4];
#pragma unroll
    for (int mt = 0; mt < 4; ++mt) o[mt] = (f32x4){0.f, 0.f, 0.f, 0.f};
#pragma unroll
    for (int ks = 0; ks < 5; ++ks) {
        u32x4 pw; pw.x = pk2(s[2 * ks][0], s[2 * ks][1]); pw.y = pk2(s[2 * ks][2], s[2 * ks][3]);
        if (ks < 4) { pw.z = pk2(s[2 * ks + 1][0], s[2 * ks + 1][1]); pw.w = pk2(s[2 * ks + 1][2], s[2 * ks + 1][3]); } else { pw.z = 0u; pw.w = 0u; }
        const bf16x8 pb = __builtin_bit_cast(bf16x8, pw);
#pragma unroll
        for (int mt = 0; mt < 4; ++mt) { const int d = 16 * mt + r; const LAS uchar* vp = lds + AT_V + d * VSTR + ((kt0 + 2 * ks) * 16 + 4 * quad) * 2;
            u32x4 aw; const u32x2 lo = *(const LAS u32x2*)vp, hi = *(const LAS u32x2*)(vp + 32); aw.x = lo.x; aw.y = lo.y; aw.z = hi.x; aw.w = hi.y;
            o[mt] = mfma16(__builtin_bit_cast(bf16x8, aw), pb, o[mt]); } }
    bf16_t* mixed = (bf16_t*)(p.ws + WS_MIXED) + (size_t)row * DM;
#pragma unroll
    for (int mt = 0; mt < 4; ++mt) { const int col = hqa * 64 + 16 * mt + 4 * quad; const u32x2 gw = qr.gw[mt];
        u32x2 w; w.x = pk2(o[mt][0] * inv * bflo(gw.x), o[mt][1] * inv * bfhi(gw.x)); w.y = pk2(o[mt][2] * inv * bflo(gw.y), o[mt][3] * inv * bfhi(gw.y));
        *(u32x2*)(mixed + col) = w; }
}

DI void attn_prompt_item(const Params& p, LAS uchar* lds, int item) {
    const int tid = threadIdx.x, wid = tid >> 6, lane = tid & 63, r = lane & 15;
    const int g = item & 1, blk = (item >> 1) & 63, b = item >> 7;
    const bf16_t* proj = (const bf16_t*)(p.ws + WS_PROJ); const float2* rope = (const float2*)(p.ws + WS_ROPE);
    const int hqa = g * 4 + (wid >> 1), qh = wid & 1;
    __syncthreads();
    float qw0[8], qw1[8];
    { const int quad = lane >> 4;
#pragma unroll
      for (int j = 0; j < 8; ++j) { qw0[j] = p.qnw[8 * quad + j]; qw1[j] = p.qnw[32 + 8 * quad + j]; } }
    u32x4 kr[2][2], vr[2][2]; float2 rp[2][8];
#pragma unroll
    for (int it = 0; it < 2; ++it) { const int u = tid + 512 * it, ki = u >> 2, pt = u & 3, tk = (blk - 1) * 128 + ki; const int tkc = tk < 0 ? 0 : tk;
        const bf16_t* rowp = proj + (size_t)(b * SEQ + tkc) * NPJ;
        kr[it][0] = *(const u32x4*)(rowp + C_AK + g * 64 + pt * 16); kr[it][1] = *(const u32x4*)(rowp + C_AK + g * 64 + pt * 16 + 8);
        vr[it][0] = *(const u32x4*)(rowp + C_AV + g * 64 + pt * 16); vr[it][1] = *(const u32x4*)(rowp + C_AV + g * 64 + pt * 16 + 8);
#pragma unroll
        for (int i = 0; i < 8; ++i) rp[it][i] = rope[(size_t)tkc * 8 + i]; }
    if (tid < 128) { u32x4 z; z.x = 0u; z.y = 0u; z.z = 0u; z.w = 0u; *(LAS u32x4*)(lds + AT_V + (tid >> 1) * VSTR + 512 + (tid & 1) * 16) = z; }
    QRaw qr[4];
#pragma unroll
    for (int i = 0; i < 4; ++i) attn_q_load(p, b * SEQ + blk * 128 + (qh * 4 + i) * 16 + r, hqa, qr[i]);
    { const float2 ra = rope[(size_t)blk * 1024 + tid], rb = rope[(size_t)blk * 1024 + 512 + tid];
      *(LAS f32x2r*)(lds + AT_R + tid * 8) = (f32x2r){ra.x, ra.y}; *(LAS f32x2r*)(lds + AT_R + (512 + tid) * 8) = (f32x2r){rb.x, rb.y}; }
#pragma unroll
    for (int it = 0; it < 2; ++it) { const int u = tid + 512 * it, ki = u >> 2, pt = u & 3;
        {
            float xk[16], xv[16]; float a[8], c[8];
            unpack8(kr[it][0], a); unpack8(kr[it][1], c);
#pragma unroll
            for (int j = 0; j < 8; ++j) { xk[j] = a[j]; xk[8 + j] = c[j]; }
            unpack8(vr[it][0], a); unpack8(vr[it][1], c);
#pragma unroll
            for (int j = 0; j < 8; ++j) { xv[j] = a[j]; xv[8 + j] = c[j]; }
            qk_norm_rope16p(xk, pt, p.knw, rp[it]);
            kv_to_lds(lds, ki, pt, xk, xv);
            if (blk == 63 && ki >= 128) { const size_t o = ((size_t)(b * 128 + ki - 128) * 2 + g) * 64 + pt * 16; store16f(p.out + O_KWP + o, xk); store16f(p.out + O_VWP + o, xv); } } }
    __syncthreads();
#pragma unroll 2
    for (int i = 0; i < 4; ++i) { const int qt = qh * 4 + i, qi = qt * 16 + r, tq = blk * 128 + qi;
        attn_q_tile<true>(p, lds, qr[0], qw0, qw1, b * SEQ + tq, tq, hqa, qi, qt, blk == 0 ? 128 : 0);
        qr[0] = qr[1]; qr[1] = qr[2]; qr[2] = qr[3]; }
}
DI void attn_sample_item(const Params& p, LAS uchar* lds, int item) {
    const int tid = threadIdx.x, wid = tid >> 6, lane = tid & 63, r = lane & 15;
    const int g = item & 1, b = item >> 1;
    const bf16_t* proj = (const bf16_t*)(p.ws + WS_PROJ); const float2* rope = (const float2*)(p.ws + WS_ROPE);
    __syncthreads();
    QRaw qrs; if (wid == 0) attn_q_load(p, NTP + b * 4 + (r >> 2), g * 4 + (r & 3), qrs);
    float qw0[8], qw1[8];
    { const int quad = lane >> 4;
#pragma unroll
      for (int j = 0; j < 8; ++j) { qw0[j] = p.qnw[8 * quad + j]; qw1[j] = p.qnw[32 + 8 * quad + j]; } }
    for (int u = tid; u < 640; u += 512) { const int ki = u >> 2, pt = u & 3;
        float xk[16], xv[16];
#pragma unroll
        for (int j = 0; j < 16; ++j) { xk[j] = 0.f; xv[j] = 0.f; }
        if (ki < 128) { const size_t o = ((size_t)(b * 128 + ki) * 2 + g) * 64 + pt * 16; load16f(p.ck + o, xk); load16f(p.cv + o, xv); }
        else { if (ki < 132) { const bf16_t* rowp = proj + (size_t)(NTP + b * 4 + ki - 128) * NPJ; load16bf(rowp + C_AK + g * 64 + pt * 16, xk); load16bf(rowp + C_AV + g * 64 + pt * 16, xv); }
               qk_norm_rope16(xk, pt, p.knw, rope + (size_t)(SEQ + (ki < 132 ? ki - 128 : 0)) * 8); }
        kv_to_lds(lds, ki, pt, xk, xv);
        if (ki >= 4 && ki < 132) { const size_t o = ((size_t)(b * 128 + ki - 4) * 2 + g) * 64 + pt * 16; store16f(p.out + O_KWS + o, xk); store16f(p.out + O_VWS + o, xv); }
    }
    __syncthreads();
    if (wid == 0) { const int t = r >> 2, hqa = g * 4 + (r & 3); attn_q_tile<false>(p, lds, qrs, qw0, qw1, NTP + b * 4 + t, SEQ + t, hqa, t, 0, 0); }
}

constexpr int TSTR = 272;
constexpr int ML_Q = 0, ML_K = 128 * TSTR, ML_V = ML_K + 128 * TSTR, ML_S = ML_V + 144 * TSTR, ML_AS = ML_S + 144 * TSTR, ML_END = ML_AS + 512;
static_assert(ML_END <= LDS_MAIN, "lds");

struct ConvIn { u32x4 row[11]; float4 w[4][2]; float4 bias[2]; };
DI void conv_issue(const Params& p, const bf16_t* proj, int b, int t0, int col, int ch, ConvIn& ci) {
#pragma unroll
    for (int i = 0; i < 11; ++i) { const int tt = t0 - 3 + i; ci.row[i] = *(const u32x4*)(proj + (size_t)(b * SEQ + (tt < 0 ? 0 : tt)) * NPJ + col); }
#pragma unroll
    for (int j = 0; j < 4; ++j) { ci.w[j][0] = *(const float4*)(p.conv_w + j * 1024 + ch); ci.w[j][1] = *(const float4*)(p.conv_w + j * 1024 + ch + 4); }
    ci.bias[0] = *(const float4*)(p.conv_b + ch); ci.bias[1] = *(const float4*)(p.conv_b + ch + 4);
}
DI void conv_rows(const bf16_t* proj, int b, int t0, int col, ConvIn& ci) {
#pragma unroll
    for (int i = 0; i < 11; ++i) { const int tt = t0 - 3 + i; ci.row[i] = *(const u32x4*)(proj + (size_t)(b * SEQ + (tt < 0 ? 0 : tt)) * NPJ + col); }
}
DI void conv_weights(const Params& p, int ch, ConvIn& ci) {
#pragma unroll
    for (int j = 0; j < 4; ++j) { ci.w[j][0] = *(const float4*)(p.conv_w + j * 1024 + ch); ci.w[j][1] = *(const float4*)(p.conv_w + j * 1024 + ch + 4); }
    ci.bias[0] = *(const float4*)(p.conv_b + ch); ci.bias[1] = *(const float4*)(p.conv_b + ch + 4);
}
typedef float f32x2 __attribute__((ext_vector_type(2)));
DI void conv_compute(const ConvIn& ci, int t0, float (&y)[8][8]) {
    f32x2 w[4][4], yy[8][4];
#pragma unroll
    for (int j = 0; j < 4; ++j) { w[j][0] = (f32x2){ci.w[j][0].x, ci.w[j][0].y}; w[j][1] = (f32x2){ci.w[j][0].z, ci.w[j][0].w}; w[j][2] = (f32x2){ci.w[j][1].x, ci.w[j][1].y}; w[j][3] = (f32x2){ci.w[j][1].z, ci.w[j][1].w}; }
    const f32x2 bs[4] = {(f32x2){ci.bias[0].x, ci.bias[0].y}, (f32x2){ci.bias[0].z, ci.bias[0].w}, (f32x2){ci.bias[1].x, ci.bias[1].y}, (f32x2){ci.bias[1].z, ci.bias[1].w}};
#pragma unroll
    for (int i = 0; i < 8; ++i)
#pragma unroll
        for (int q = 0; q < 4; ++q) yy[i][q] = bs[q];
#pragma unroll
    for (int r = 0; r < 11; ++r) { f32x2 x[4];
        const bool zero = (r < 3) && (t0 - 3 + r < 0);
#pragma unroll
        for (int q = 0; q < 4; ++q) { const unsigned wd = zero ? 0u : ci.row[r][q]; x[q] = (f32x2){bflo(wd), bfhi(wd)}; }
#pragma unroll
        for (int j = 0; j < 4; ++j) { const int i = r - j;
            if (i >= 0 && i < 8) {
#pragma unroll
                for (int q = 0; q < 4; ++q) yy[i][q] += w[j][q] * x[q]; } } }
#pragma unroll
    for (int i = 0; i < 8; ++i)
#pragma unroll
        for (int q = 0; q < 4; ++q) { const f32x2 v = yy[i][q], a = v * -1.4426950408889634f; f32x2 e; e.x = __builtin_amdgcn_exp2f(a.x); e.y = __builtin_amdgcn_exp2f(a.y);
            const f32x2 d = e + 1.0f; f32x2 rc; rc.x = __builtin_amdgcn_rcpf(d.x); rc.y = __builtin_amdgcn_rcpf(d.y); const f32x2 o = v * rc; y[i][2 * q] = o.x; y[i][2 * q + 1] = o.y; }
}
DI void vt_store8(LAS uchar* img, int d0, int s0, const u32x4 (&row)[8]) {
#pragma unroll
    for (int wd = 0; wd < 4; ++wd) { u32x4 ev, od;
        unsigned a[8];
#pragma unroll
        for (int i = 0; i < 8; ++i) a[i] = row[i][wd];
        ev.x = (a[0] & 0xffffu) | (a[1] << 16); ev.y = (a[2] & 0xffffu) | (a[3] << 16); ev.z = (a[4] & 0xffffu) | (a[5] << 16); ev.w = (a[6] & 0xffffu) | (a[7] << 16);
        od.x = (a[0] >> 16) | (a[1] & 0xffff0000u); od.y = (a[2] >> 16) | (a[3] & 0xffff0000u); od.z = (a[4] >> 16) | (a[5] & 0xffff0000u); od.w = (a[6] >> 16) | (a[7] & 0xffff0000u);
        *(LAS u32x4*)(img + (d0 + 2 * wd) * TSTR + s0 * 2) = ev; *(LAS u32x4*)(img + (d0 + 2 * wd + 1) * TSTR + s0 * 2) = od; }
}
DI void vt_aug_rows(LAS uchar* img, int tid) {
    if (tid < 256) { const int rr = tid >> 4, s8 = (tid & 15) * 8; const unsigned v = rr == 0 ? 0x3F803F80u : 0u; u32x4 w; w.x = v; w.y = v; w.z = v; w.w = v;
        *(LAS u32x4*)(img + (128 + rr) * TSTR + s8 * 2) = w; }
}

DI void mlstm_u_item(const Params& p, LAS uchar* lds, int item) {
    const int tid = threadIdx.x, wid = tid >> 6, lane = tid & 63, r = lane & 15, quad = lane >> 4;
    const int c = item & 63, bh = item >> 6, b = bh >> 2, h = bh & 3;
    const bf16_t* proj = (const bf16_t*)(p.ws + WS_PROJ); const float* gates = (const float*)(p.ws + WS_GATES); const float2* FM = (const float2*)(p.ws + WS_FM) + (size_t)bh * SEQ;
    LAS float* wks = (LAS float*)(lds + ML_AS);
    __syncthreads();
    if (tid < 256) {
        const int g8 = (tid & 15) * 8, s0 = (tid >> 4) * 8, t0 = c * CH + s0;
        ConvIn ci; conv_issue(p, proj, b, t0, C_MK + h * 128 + g8, 512 + h * 128 + g8, ci);
        if (tid < 128) { const int t = c * CH + tid; const float2 fe = FM[c * CH + CH - 1], fs = FM[t];
            wks[tid] = __expf(fe.x - fs.x + gates[(size_t)(b * SEQ + t) * 8 + h] - fe.y) * 0.08838834764831845f; }
        vt_aug_rows(lds + ML_V, tid);
        __syncthreads();
        float y[8][8]; conv_compute(ci, t0, y);
        const f32x4 wa = *(const LAS f32x4*)(wks + s0), wb = *(const LAS f32x4*)(wks + s0 + 4);
        const float wk[8] = {wa[0], wa[1], wa[2], wa[3], wb[0], wb[1], wb[2], wb[3]};
#pragma unroll
        for (int e = 0; e < 8; ++e) { float f[8];
#pragma unroll
            for (int i = 0; i < 8; ++i) f[i] = y[i][e] * wk[i];
            *(LAS u32x4*)(lds + ML_K + (g8 + e) * TSTR + s0 * 2) = pack8(f); }
    } else {
        const int vt = tid - 256, d8 = (vt & 15) * 8, s0 = (vt >> 4) * 8, t0 = c * CH + s0;
        u32x4 row[8];
#pragma unroll
        for (int i = 0; i < 8; ++i) row[i] = *(const u32x4*)(proj + (size_t)(b * SEQ + t0 + i) * NPJ + C_MV + h * 128 + d8);
        __syncthreads();
        vt_store8(lds + ML_V, d8, s0, row);
    }
    __syncthreads();
    f32x4 acc[9];
#pragma unroll
    for (int mt = 0; mt < 9; ++mt) acc[mt] = (f32x4){0.f, 0.f, 0.f, 0.f};
#pragma unroll
    for (int ks = 0; ks < 4; ++ks) { const bf16x8 bk = *(const LAS bf16x8*)(lds + ML_K + (16 * wid + r) * TSTR + ks * 64 + quad * 16);
#pragma unroll
        for (int mt = 0; mt < 9; ++mt) { const bf16x8 av = *(const LAS bf16x8*)(lds + ML_V + (16 * mt + r) * TSTR + ks * 64 + quad * 16); acc[mt] = mfma16(av, bk, acc[mt]); } }
    bf16_t* U = (bf16_t*)(p.ws + WS_UST) + (size_t)item * USZ;
#pragma unroll
    for (int mt = 0; mt < 9; ++mt)
#pragma unroll
        for (int v = 0; v < 4; ++v) { const int dv = 16 * mt + 4 * quad + v; if (dv <= 128) U[dv * 128 + 16 * wid + r] = f2bf(acc[mt][v]); }
}

DI void sample_outproj(const Params& p, int unit) {
    const int lane = threadIdx.x & 63, wid = threadIdx.x >> 6, r = lane & 15, quad = lane >> 4;
    const int m0 = (unit >> 4) * 32 + (wid >> 2) * 16, n0 = (unit & 15) * 64 + (wid & 3) * 16;
    const bf16_t* A = (const bf16_t*)(p.ws + WS_WTOUT) + (size_t)(n0 + r) * DM + 8 * quad;
    const bf16_t* B = (const bf16_t*)(p.ws + WS_MIXED) + (size_t)(NTP + m0 + r) * DM + 8 * quad;
    f32x4 acc0 = {0.f, 0.f, 0.f, 0.f}, acc1 = {0.f, 0.f, 0.f, 0.f};
    const f32x4 xres = *(const f32x4*)(p.x_s + (size_t)(m0 + r) * DM + n0 + 4 * quad);
#pragma unroll
    for (int hb = 0; hb < 4; ++hb) { bf16x8 af[8], bfr[8];
#pragma unroll
        for (int ks = 0; ks < 8; ++ks) { af[ks] = *(const bf16x8*)(A + (hb * 8 + ks) * 32); bfr[ks] = *(const bf16x8*)(B + (hb * 8 + ks) * 32); }
#pragma unroll
        for (int ks = 0; ks < 8; ks += 2) { acc0 = mfma16(af[ks], bfr[ks], acc0); acc1 = mfma16(af[ks + 1], bfr[ks + 1], acc1); } }
    const size_t o = (size_t)(m0 + r) * DM + n0 + 4 * quad;
    *(f32x4*)(p.out + O_Y + (size_t)NTP * DM + o) = acc0 + acc1 + xres;
}
DI void mlstm_scan(const Params& p, LAS uchar* lds) {
    const int tid = threadIdx.x, nb = gridDim.x, bid = blockIdx.x;
    const unsigned* U32 = (const unsigned*)(p.ws + WS_UST); unsigned* S32 = (unsigned*)(p.ws + WS_SB);
    LAS float* dcs = (LAS float*)lds;
    for (int it = nb - 1 - bid; it < 256; it += nb) sample_outproj(p, it);
    constexpr int NPAIR = 8 * USZ / 2, HU = USZ / 2;
    const int per = (NPAIR + nb - 1) / nb, base = bid * per, lim = (base + per < NPAIR) ? base + per : NPAIR;
    bool first = true;
    for (int pb = base; pb < lim || first; pb += 512) {
        const int e = pb + tid; const bool has = e < lim; const int ec = has ? e : 0;
        const int bh = (2 * ec) / USZ, idx = 2 * ec - bh * USZ; const unsigned off = (unsigned)((bh * NCH * USZ + idx) >> 1);
        unsigned ua[64];
#pragma unroll
        for (int j = 0; j < 64; ++j) ua[j] = (U32 + (size_t)j * HU)[off];
        if (first) { first = false;
            __syncthreads();
            { const int bh2 = tid >> 6, c = tid & 63; const float2* FM = (const float2*)(p.ws + WS_FM) + (size_t)bh2 * SEQ;
              const float2 fe = FM[c * CH + CH - 1]; float2 pv = make_float2(0.f, 0.f); if (c > 0) pv = FM[c * CH - 1];
              dcs[tid] = __expf(fe.x - pv.x + pv.y - fe.y);
              if (bid == 0 && c == 63) p.out[O_MP + bh2] = fe.y; }
            __syncthreads(); }
        if (has) { float S0 = 0.f, S1 = 0.f;
#pragma unroll
            for (int j = 0; j < 64; ++j) { (S32 + (size_t)j * HU)[off] = pk2(S0, S1); const float d = dcs[bh * 64 + j]; S0 = d * S0 + bflo(ua[j]); S1 = d * S1 + bfhi(ua[j]); }
            if (idx < 16384) { const int dv = idx >> 7, dk = idx & 127; float* o = p.out + O_CP + (size_t)bh * 16384 + dk * 128 + dv; o[0] = S0; o[128] = S1; }
            else { float* o = p.out + O_NP + bh * 128 + idx - 16384; o[0] = S0; o[1] = S1; } }
    }
}

struct MoRaw { u32x4 sv[5]; ConvIn ci; u32x4 vrow[4]; float ga, fx; };
DI void mo_issue(const Params& p, int item, MoRaw& rw) {
    const int tid = threadIdx.x;
    const int c = item & 63, bh = item >> 6, b = bh >> 2, h = bh & 3;
    const bf16_t* proj = (const bf16_t*)(p.ws + WS_PROJ); const float* gates = (const float*)(p.ws + WS_GATES); const float2* FM = (const float2*)(p.ws + WS_FM) + (size_t)bh * SEQ;
    const int isk = (tid >> 4) & 1, g8 = (tid & 15) * 8, s0 = (tid >> 5) * 8, t0 = c * CH + s0;
    conv_rows(proj, b, t0, (isk ? C_MK : C_MQ) + h * 128 + g8, rw.ci);
    const int vd8 = (tid & 15) * 8, vs0 = (tid >> 4) * 4;
#pragma unroll
    for (int i = 0; i < 4; ++i) rw.vrow[i] = *(const u32x4*)(proj + (size_t)(b * SEQ + c * CH + vs0 + i) * NPJ + C_MV + h * 128 + vd8);
    rw.ga = 0.f; rw.fx = 0.f;
    if (tid < 128) { const int t = c * CH + tid; rw.ga = gates[(size_t)(b * SEQ + t) * 8 + h]; rw.fx = FM[t].x; }
}
DI void mlstm_out_item(const Params& p, LAS uchar* lds, int item, MoRaw& rw, bool has_next, int next_item, MoRaw& nx) {
    const int tid = threadIdx.x, wid = tid >> 6, lane = tid & 63, r = lane & 15, quad = lane >> 4;
    const int c = item & 63, bh = item >> 6, b = bh >> 2, h = bh & 3;
    const bf16_t* proj = (const bf16_t*)(p.ws + WS_PROJ); const float2* FM = (const float2*)(p.ws + WS_FM) + (size_t)bh * SEQ;
    {
        const int isk = (tid >> 4) & 1, g8 = (tid & 15) * 8, s0 = (tid >> 5) * 8, t0 = c * CH + s0;
        conv_weights(p, isk * 512 + h * 128 + g8, rw.ci);
        { const bf16_t* St = (const bf16_t*)(p.ws + WS_SB) + (size_t)item * USZ;
#pragma unroll
          for (int k = 0; k < 5; ++k) { const int u = tid + 512 * k, dv = u >> 4, d8 = (u & 15) * 8; const int dvc = dv <= 128 ? dv : 128;
              rw.sv[k] = *(const u32x4*)(St + dvc * 128 + d8); } }
        const int vd8 = (tid & 15) * 8, vs0 = (tid >> 4) * 4;
        if (tid < 128) ((LAS float*)(lds + ML_AS))[tid] = rw.ga - rw.fx;
        vt_aug_rows(lds + ML_V, tid);
#pragma unroll
        for (int k = 0; k < 5; ++k) { const int u = tid + 512 * k, dv = u >> 4, d8 = (u & 15) * 8;
            if (u < 144 * 16) { u32x4 w = rw.sv[k]; if (dv > 128) { w.x = 0u; w.y = 0u; w.z = 0u; w.w = 0u; }
                *(LAS u32x4*)(lds + ML_S + dv * TSTR + d8 * 2) = w; } }
        float y[8][8]; conv_compute(rw.ci, t0, y);
#pragma unroll
        for (int i = 0; i < 8; ++i) { float f[8];
#pragma unroll
            for (int e = 0; e < 8; ++e) f[e] = isk ? y[i][e] * 0.08838834764831845f : y[i][e];
            *(LAS u32x4*)(lds + (isk ? ML_K : ML_Q) + (s0 + i) * TSTR + g8 * 2) = pack8(f); }
#pragma unroll
        for (int wd = 0; wd < 4; ++wd) { const unsigned a0 = rw.vrow[0][wd], a1 = rw.vrow[1][wd], a2 = rw.vrow[2][wd], a3 = rw.vrow[3][wd]; u32x2 ev, od;
            ev.x = (a0 & 0xffffu) | (a1 << 16); ev.y = (a2 & 0xffffu) | (a3 << 16); od.x = (a0 >> 16) | (a1 & 0xffff0000u); od.y = (a2 >> 16) | (a3 & 0xffff0000u);
            *(LAS u32x2*)(lds + ML_V + (vd8 + 2 * wd) * TSTR + vs0 * 2) = ev; *(LAS u32x2*)(lds + ML_V + (vd8 + 2 * wd + 1) * TSTR + vs0 * 2) = od; }
    }
    const int ti = 16 * wid + r, t = c * CH + ti; const float2 ft = FM[t]; float2 f0 = make_float2(0.f, 0.f); if (c > 0) f0 = FM[c * CH - 1];
    const bf16_t* rowp = proj + (size_t)(b * SEQ + t) * NPJ; bf16_t* mixed = (bf16_t*)(p.ws + WS_MIXED) + (size_t)(b * SEQ + t) * DM + 512 + h * 128;
    u32x2 gws[8];
#pragma unroll
    for (int mt = 0; mt < 8; ++mt) { const int dv = 16 * mt + 4 * quad; gws[mt] = *(const u32x2*)(rowp + C_G + h * 128 + dv); }
    if (has_next) mo_issue(p, next_item, nx);
    __syncthreads();
    bf16x8 qf[4];
#pragma unroll
    for (int ks = 0; ks < 4; ++ks) qf[ks] = *(const LAS bf16x8*)(lds + ML_Q + (16 * wid + r) * TSTR + ks * 64 + quad * 16);
    const float winter = __expf(ft.x - f0.x + f0.y - ft.y), bt = ft.x - ft.y;
    f32x4 acc[9];
#pragma unroll
    for (int mt = 0; mt < 9; ++mt) acc[mt] = (f32x4){0.f, 0.f, 0.f, 0.f};
#pragma unroll
    for (int ks = 0; ks < 4; ++ks)
#pragma unroll
        for (int mt = 0; mt < 9; ++mt) { const bf16x8 a = *(const LAS bf16x8*)(lds + ML_S + (16 * mt + r) * TSTR + ks * 64 + quad * 16); acc[mt] = mfma16(a, qf[ks], acc[mt]); }
#pragma unroll
    for (int mt = 0; mt < 9; ++mt) acc[mt] *= winter;
    const LAS float* as = (const LAS float*)(lds + ML_AS);
    for (int sp = 0; sp <= (wid >> 1); ++sp) {
        u32x4 pw;
#pragma unroll
        for (int half = 0; half < 2; ++half) { const int st = 2 * sp + half; f32x4 c4 = {0.f, 0.f, 0.f, 0.f};
            if (st <= wid) {
#pragma unroll
                for (int ks = 0; ks < 4; ++ks) { const bf16x8 a = *(const LAS bf16x8*)(lds + ML_K + (16 * st + r) * TSTR + ks * 64 + quad * 16); c4 = mfma16(a, qf[ks], c4); }
                const f32x4 av = *(const LAS f32x4*)(as + 16 * st + 4 * quad);
#pragma unroll
                for (int v = 0; v < 4; ++v) { const int si = 16 * st + 4 * quad + v; c4[v] = (si <= ti) ? c4[v] * __expf(bt + av[v]) : 0.f; } }
            if (half == 0) { pw.x = pk2(c4[0], c4[1]); pw.y = pk2(c4[2], c4[3]); } else { pw.z = pk2(c4[0], c4[1]); pw.w = pk2(c4[2], c4[3]); } }
        const bf16x8 pb = __builtin_bit_cast(bf16x8, pw);
#pragma unroll
        for (int mt = 0; mt < 9; ++mt) { const LAS uchar* vp = lds + ML_V + (16 * mt + r) * TSTR + (32 * sp + 4 * quad) * 2;
            u32x4 aw; const u32x2 lo = *(const LAS u32x2*)vp, hi = *(const LAS u32x2*)(vp + 32); aw.x = lo.x; aw.y = lo.y; aw.z = hi.x; aw.w = hi.y;
            acc[mt] = mfma16(__builtin_bit_cast(bf16x8, aw), pb, acc[mt]); } }
    const float den = __shfl(acc[8][0], r);
    const float inv = __builtin_amdgcn_rcpf(fmaxf(fabsf(den), __expf(-ft.y)));
    float ss = 0.f;
#pragma unroll
    for (int mt = 0; mt < 8; ++mt)
#pragma unroll
        for (int v = 0; v < 4; ++v) { acc[mt][v] *= inv; ss += acc[mt][v] * acc[mt][v]; }
    ss += __shfl_xor(ss, 16); ss += __shfl_xor(ss, 32);
    const float rstd = rsqrtf(ss * (1.0f / 128) + 1e-6f);
    float4 nws[8];
#pragma unroll
    for (int mt = 0; mt < 8; ++mt) nws[mt] = *(const float4*)(p.mhw + h * 128 + 16 * mt + 4 * quad);
#pragma unroll
    for (int mt = 0; mt < 8; ++mt) { const int dv = 16 * mt + 4 * quad; const u32x2 gw = gws[mt];
        const float4 nw = nws[mt];
        const f32x2 h0 = (f32x2){acc[mt][0], acc[mt][1]}, h1 = (f32x2){acc[mt][2], acc[mt][3]};
        const f32x2 y0 = h0 * rstd * (f32x2){nw.x, nw.y} * (f32x2){bflo(gw.x), bfhi(gw.x)}, y1 = h1 * rstd * (f32x2){nw.z, nw.w} * (f32x2){bflo(gw.y), bfhi(gw.y)};
        u32x2 w; w.x = pk2(y0.x, y0.y); w.y = pk2(y1.x, y1.y);
        *(u32x2*)(mixed + dv) = w; }
}

DI void mlstm_sample_item(const Params& p, LAS uchar* lds, int item) {
    const int tid = threadIdx.x, wid = tid >> 6, lane = tid & 63;
    const int h = item & 3, b = item >> 2;
    const bf16_t* proj = (const bf16_t*)(p.ws + WS_PROJ); const float* gates = (const float*)(p.ws + WS_GATES);
    LAS float* qs = (LAS float*)lds;
    LAS float* ks = qs + 512;
    LAS float* vs = ks + 512;
    LAS float* red = vs + 512;
    LAS float* dred = red + 2048;
    LAS float* sred = dred + 8;
    __syncthreads();
    const int dv = tid & 127, dkq = tid >> 7;
    const float* S0 = p.sC + ((size_t)(b * 4 + h) * 128 + dkq * 32) * 128 + dv;
    float S[32];
#pragma unroll
    for (int i = 0; i < 32; ++i) S[i] = S0[(size_t)i * 128];
    float nn = 0.f; if (tid < 128) nn = p.sn[(size_t)(b * 4 + h) * 128 + tid];
    const bf16_t* rowf = proj + (size_t)(NTP + b * 4 + (tid >> 7)) * NPJ;
    const unsigned ggr = rowf[C_G + h * 128 + dv]; const float mhr = p.mhw[h * 128 + dv];
    float cvs[2];
#pragma unroll
    for (int i = tid; i < 1024; i += 512) { const int t = i >> 8, lc = i & 255, ch = (lc < 128 ? 0 : 512) + h * 128 + (lc & 127);
        float y = p.conv_b[ch]; float xx[4], ww[4];
#pragma unroll
        for (int j = 0; j < 4; ++j) { const int tt = t - 3 + j; ww[j] = p.conv_w[j * 1024 + ch];
            if (tt < 0) xx[j] = p.sconv[(size_t)(b * 3 + 3 + tt) * 1024 + ch];
            else xx[j] = __uint_as_float((unsigned)proj[(size_t)(NTP + b * 4 + tt) * NPJ + C_MQ + ch] << 16); }
#pragma unroll
        for (int j = 0; j < 4; ++j) y += ww[j] * xx[j];
        cvs[i >> 9] = xx[3];
        y = silu(y);
        if (lc < 128) qs[t * 128 + lc] = y; else ks[t * 128 + (lc - 128)] = y * 0.08838834764831845f; }
    { const int t = tid >> 7, dv = tid & 127; vs[tid] = __uint_as_float((unsigned)proj[(size_t)(NTP + b * 4 + t) * NPJ + C_MV + h * 128 + dv] << 16); }
    float mt_[4], fd[4], iw[4];
    { float mprev = p.sm[b * 4 + h];
#pragma unroll
      for (int t = 0; t < 4; ++t) { const float* g = gates + (size_t)(NTP + b * 4 + t) * 8; const float li = g[h], lf = g[4 + h];
          const float m = fmaxf(lf + mprev, li); fd[t] = __expf(lf + mprev - m); iw[t] = __expf(li - m); mt_[t] = m; mprev = m; } }
    __syncthreads();
#pragma unroll
    for (int t = 0; t < 4; ++t) { const float vt = vs[t * 128 + dv] * iw[t]; float part = 0.f;
        f32x2 part2 = {0.f, 0.f};
#pragma unroll
        for (int i = 0; i < 32; i += 4) { const f32x4 k4 = *(const LAS f32x4*)(ks + t * 128 + dkq * 32 + i), q4 = *(const LAS f32x4*)(qs + t * 128 + dkq * 32 + i);
            f32x2 s01 = (f32x2){S[i], S[i + 1]}, s23 = (f32x2){S[i + 2], S[i + 3]};
            s01 = s01 * fd[t] + (f32x2){k4[0], k4[1]} * vt; s23 = s23 * fd[t] + (f32x2){k4[2], k4[3]} * vt;
            part2 += (f32x2){q4[0], q4[1]} * s01; part2 += (f32x2){q4[2], q4[3]} * s23;
            S[i] = s01.x; S[i + 1] = s01.y; S[i + 2] = s23.x; S[i + 3] = s23.y; }
        part = part2.x + part2.y;
        red[(dkq * 4 + t) * 128 + dv] = part;
        if (tid < 128) { nn = fd[t] * nn + iw[t] * ks[t * 128 + tid]; const float dp = wsum(qs[t * 128 + tid] * nn); if (lane == 0) dred[t * 2 + wid] = dp; } }
    float* Sout = p.out + O_CS + ((size_t)(b * 4 + h) * 128 + dkq * 32) * 128 + dv;
#pragma unroll
    for (int i = 0; i < 32; ++i) Sout[(size_t)i * 128] = S[i];
#pragma unroll
    for (int q = 0; q < 2; ++q) { const int i = tid + 512 * q, t = i >> 8, lc = i & 255, ch = (lc < 128 ? 0 : 512) + h * 128 + (lc & 127); if (t >= 1) p.out[O_CONVS + (size_t)(b * 3 + t - 1) * 1024 + ch] = cvs[q]; }
    if (tid < 128) p.out[O_NS + (size_t)(b * 4 + h) * 128 + tid] = nn;
    if (tid == 0) p.out[O_MS + b * 4 + h] = mt_[3];
    __syncthreads();
    { const int t = tid >> 7; const float num = red[(0 * 4 + t) * 128 + dv] + red[(1 * 4 + t) * 128 + dv] + red[(2 * 4 + t) * 128 + dv] + red[(3 * 4 + t) * 128 + dv];
      const float den = dred[t * 2] + dred[t * 2 + 1];
      const float mtv = t == 0 ? mt_[0] : t == 1 ? mt_[1] : t == 2 ? mt_[2] : mt_[3];
      const float hv = num / fmaxf(fabsf(den), __expf(-mtv));
      const float sq = wsum(hv * hv); if (lane == 0) sred[t * 2 + (wid & 1)] = sq;
      __syncthreads();
      const float rstd = rsqrtf((sred[t * 2] + sred[t * 2 + 1]) * (1.0f / 128) + 1e-6f);
      const size_t row = (size_t)(NTP + b * 4 + t);
      ((bf16_t*)(p.ws + WS_MIXED))[row * DM + 512 + h * 128 + dv] = f2bf(hv * rstd * mhr * __uint_as_float(ggr << 16)); }
}

DI void phase2(const Params& p, LAS uchar* lds) {
    const int nb = gridDim.x, bid = blockIdx.x, tid = threadIdx.x;
#ifndef REP_AP
#define REP_AP 1
#define REP_MU 1
#define REP_AS 1
#define REP_MS 1
#endif
    const bool late = ((bid >> 3) & 1) == 0;
    if (!late) { for (int it = bid; it < 256; it += nb) attn_sample_item(p, lds, it);
                 for (int it = bid; it < 512; it += nb) mlstm_sample_item(p, lds, it); }
    for (int it = bid; it < 256; it += nb) attn_prompt_item(p, lds, it);
    for (int it = bid; it < 512; it += nb) mlstm_u_item(p, lds, it);
    if (late) { for (int it = bid; it < 256; it += nb) attn_sample_item(p, lds, it);
                for (int it = bid; it < 512; it += nb) mlstm_sample_item(p, lds, it); }
    for (int i = bid * 512 + tid; i < 6144; i += nb * 512) { const int ch = i & 1023, rr = (i >> 10) % 3, b = i / 3072;
        p.out[O_CONVP + i] = __uint_as_float((unsigned)((const bf16_t*)(p.ws + WS_PROJ))[(size_t)(b * SEQ + SEQ - 3 + rr) * NPJ + C_MQ + ch] << 16); }
}
DI void phase4(const Params& p, LAS uchar* lds) {
    const int nb = gridDim.x, bid = blockIdx.x;
    for (int it = bid; it < 512; it += 2 * nb) { const int it1 = it + nb; const bool has1 = it1 < 512;
        MoRaw ra, rb2;
        __syncthreads(); mo_issue(p, it, ra);
        mlstm_out_item(p, lds, it, ra, has1, it1, rb2);
        if (has1) { __syncthreads(); mlstm_out_item(p, lds, it1, rb2, false, 0, ra); } }
}

__global__ __launch_bounds__(512, 2) void hymba_mega(Params p, int ph_lo, int ph_hi) {
    extern __shared__ __attribute__((aligned(16))) unsigned char shm[];
    LAS uchar* lds = (LAS uchar*)shm;
    volatile LAS unsigned* st = (volatile LAS unsigned*)(lds + LDS_MAIN);
    if (threadIdx.x == 0) { st[0] = 0u; st[1] = 0u; }
    __syncthreads();
    const XcdBarrier xb = xcd_barrier_post((unsigned*)(p.ws + WS_BAR), st);
#ifdef PROBE_K
#define STAMP(i) ts[i] = wall_clock64();
    unsigned long long ts[7];
#else
#define STAMP(i)
#endif
#define RUNPH(n, call) if (ph_lo <= n && n < ph_hi) { if (ph_lo < n) xcd_barrier(xb); STAMP(n) call; }
    RUNPH(0, phase0(p, lds)) RUNPH(1, phase1(p, lds)) RUNPH(2, phase2(p, lds)) RUNPH(3, mlstm_scan(p, lds)) RUNPH(4, phase4(p, lds)) RUNPH(5, phase5(p, lds))
#ifdef PROBE_K
    xcd_barrier(xb); STAMP(6)
    if (blockIdx.x == 0 && threadIdx.x == 0) { const unsigned long long dt = (ts[PROBE_K + 1] - ts[PROBE_K]) * 4ull; while (wall_clock64() - ts[6] < dt) __builtin_amdgcn_s_sleep(8); }
#endif
}

#ifndef N_LAUNCHES
#define N_LAUNCHES 1
#endif
extern "C" void kernel_launch(void* const* d_in, const int* in_sizes, int n_in, void* d_out, int out_size, void* d_ws, size_t ws_size, hipStream_t stream) {
    static int grid = 0;
    if (grid == 0) {
        int dev = 0, cus = 0, per_cu = 0;
        hipGetDevice(&dev); hipDeviceGetAttribute(&cus, hipDeviceAttributeMultiprocessorCount, dev);
        if (hipFuncSetAttribute((const void*)hymba_mega, hipFuncAttributeMaxDynamicSharedMemorySize, LDS_BYTES) != hipSuccess) { fprintf(stderr, "hipFuncSetAttribute failed\n"); }
        if (hipOccupancyMaxActiveBlocksPerMultiprocessor(&per_cu, (const void*)hymba_mega, 512, LDS_BYTES) != hipSuccess || per_cu < 1) { fprintf(stderr, "occupancy query: %d\n", per_cu); per_cu = 1; }
        (void)hipGetLastError();
        grid = cus * per_cu;
        if (ws_size < WS_END || n_in != 18) { fprintf(stderr, "bad ws/n_in\n"); grid = -1; }
    }
    if (grid < 0) return;
    if (hipMemsetAsync((char*)d_ws + WS_BAR, 0, XCD_BAR_WORDS * sizeof(unsigned), stream) != hipSuccess) { fprintf(stderr, "memset failed\n"); return; }
    Params p{};
    p.x_p = (const float*)d_in[0]; p.x_s = (const float*)d_in[1]; p.ck = (const float*)d_in[2]; p.cv = (const float*)d_in[3]; p.sconv = (const float*)d_in[4];
    p.sC = (const float*)d_in[5]; p.sn = (const float*)d_in[6]; p.sm = (const float*)d_in[7]; p.norm_w = (const float*)d_in[8]; p.w_in = (const float*)d_in[9];
    p.b_gates = (const float*)d_in[10]; p.conv_w = (const float*)d_in[11]; p.conv_b = (const float*)d_in[12]; p.qnw = (const float*)d_in[13]; p.knw = (const float*)d_in[14];
    p.sinks = (const float*)d_in[15]; p.mhw = (const float*)d_in[16]; p.w_out = (const float*)d_in[17];
    p.out = (float*)d_out; p.ws = (uchar*)d_ws;
    if (N_LAUNCHES == 1) {
#ifdef PLAIN_LAUNCH
        hipLaunchKernelGGL(hymba_mega, dim3(grid), dim3(512), LDS_BYTES, stream, p, 0, 6);
#else
        int lo = 0, hi = 6; void* args[] = {&p, &lo, &hi};
        hipError_t e = hipLaunchCooperativeKernel((const void*)hymba_mega, dim3(grid), dim3(512), args, LDS_BYTES, stream);
        if (e != hipSuccess) fprintf(stderr, "cooperative launch failed: %s (grid %d)\n", hipGetErrorString(e), grid);
#endif
    } else {
#ifndef PHLIST
#define PHLIST {0, 1, 2, 3, 4, 5}
#endif
        const int phl[] = PHLIST;
        for (int i = 0; i < (int)(sizeof(phl) / sizeof(int)); ++i) hipLaunchKernelGGL(hymba_mega, dim3(grid), dim3(512), LDS_BYTES, stream, p, phl[i], phl[i] + 1);
    }
}
```
